# Optimizing an MI355X kernel written in HIP

```python
import math
import jax, jax.numpy as jnp
from jax import lax
import numpy as np

D_MODEL = 1024
BATCH = 2
SEQ = 16384
DEPTH = 4

GRID_W = 64
CTX_LEN = 256
N_MIXERS = 3
EPS = 1e-6
FFN_RES = 0.5

D_FF = 2816
D_RNN = 1536
LRU_BLOCKS = 12
LRU_BW = D_RNN // LRU_BLOCKS
CONV_W = 4
LRU_C = 8.0
A_MIN = 0.9
A_MAX = 0.999

HEAD_DIM = 64
B_HEADS = 16
B_KV_HEADS = 4
WINDOW = 128
Q_BLOCK = 128
ROPE_BASE = 10000.0

C_HEADS = 16
WIN_H = 8
WIN_W = 16

NEG = -1e30

kernel_name = "hybrid_rglru_swa_nat_prefix_dit"


def rms_norm(x, g):
    xf = x.astype(jnp.float32)
    y = xf * lax.rsqrt(jnp.mean(xf * xf, axis=-1, keepdims=True) + EPS)
    return (y * g.astype(jnp.float32)).astype(x.dtype)


def adaln_in(h, g, shift, scale):
    return rms_norm(h, g) * (1.0 + scale) + shift


def swiglu(h, w_gu, w_dn):
    g, u = jnp.split(h @ w_gu, 2, axis=-1)
    return (jax.nn.silu(g) * u) @ w_dn


def ffn_residual(h, g, shift, scale, gate, w_gu, w_dn):
    return h + FFN_RES * gate * swiglu(adaln_in(h, g, shift, scale), w_gu, w_dn)


def joint_softmax(logits):
    p = jax.nn.softmax(jnp.concatenate(logits, axis=-1).astype(jnp.float32), axis=-1)
    cuts = [int(n) for n in np.cumsum([l.shape[-1] for l in logits[:-1]])]
    return jnp.split(p, cuts, axis=-1)


def axial_rope(t):
    L = t.shape[1]
    pos = jnp.arange(L)
    half = HEAD_DIM // 2
    quarter = half // 2
    inv = ROPE_BASE ** (-jnp.arange(quarter, dtype=jnp.float32) / quarter)
    tf = t.astype(jnp.float32)
    bshape = (L,) + (1,) * (t.ndim - 3) + (quarter,)
    outs = []
    for axis_pos, part in ((pos // GRID_W, tf[..., :half]), (pos % GRID_W, tf[..., half:])):
        ang = axis_pos.astype(jnp.float32)[:, None] * inv
        cos = jnp.cos(ang).reshape(bshape)
        sin = jnp.sin(ang).reshape(bshape)
        x1, x2 = part[..., :quarter], part[..., quarter:]
        outs += [x1 * cos - x2 * sin, x2 * cos + x1 * sin]
    return jnp.concatenate(outs, axis=-1).astype(t.dtype)


def dw_conv_centred(x, w, b):
    L = x.shape[1]
    left = (CONV_W - 1) // 2
    xp = jnp.pad(x, ((0, 0), (left, CONV_W - 1 - left), (0, 0)))
    y = b
    for k in range(CONV_W):
        y = y + xp[:, k:k + L] * w[k]
    return y


def block_diag(x, w, b):
    xb = x.reshape(x.shape[:-1] + (LRU_BLOCKS, LRU_BW))
    return jnp.einsum('blnk,nkj->blnj', xb, w).reshape(x.shape) + b


def _lin_combine(e1, e2):
    a1, b1 = e1
    a2, b2 = e2
    return a1 * a2, a2 * b1 + b2


def rglru_scan(xc, w_g, b_g, lam, h0, reverse):
    xf = xc.astype(jnp.float32)
    r = jax.nn.sigmoid(block_diag(xf, w_g[0], b_g[0]))
    i = jax.nn.sigmoid(block_diag(xf, w_g[1], b_g[1]))
    log_a = -LRU_C * r * jax.nn.softplus(-lam.astype(jnp.float32))
    a = jnp.exp(log_a)
    b = jnp.sqrt(-jnp.expm1(2.0 * log_a)) * (i * xf)
    edge = -1 if reverse else 0
    b = b.at[:, edge].add(a[:, edge] * h0)
    _, h = lax.associative_scan(_lin_combine, (a, b), axis=1, reverse=reverse)
    return h


def mixer_rglru(hx, hc, w_in, conv_w, conv_b, gate_w, gate_b, lam, w_out, need_ctx):
    def split_in(h):
        g, xr = jnp.split(h @ w_in, 2, axis=-1)
        return g, dw_conv_centred(xr, conv_w, conv_b)
    g_x, xc_x = split_in(hx)
    g_c, xc_c = split_in(hc)
    h0 = jnp.zeros((hx.shape[0], D_RNN), jnp.float32)
    hf_c = rglru_scan(xc_c, gate_w[0], gate_b[0], lam[0], h0, reverse=False)
    hb_c = rglru_scan(xc_c, gate_w[1], gate_b[1], lam[1], h0, reverse=True)
    hf_x = rglru_scan(xc_x, gate_w[0], gate_b[0], lam[0], hf_c[:, -1], reverse=False)
    hb_x = rglru_scan(xc_x, gate_w[1], gate_b[1], lam[1], hb_c[:, 0], reverse=True)
    y_x = ((hf_x + hb_x).astype(hx.dtype) * jax.nn.gelu(g_x)) @ w_out
    y_c = None
    if need_ctx:
        y_c = ((hf_c + hb_c).astype(hc.dtype) * jax.nn.gelu(g_c)) @ w_out
    return y_x, y_c


def mixer_swa(hx, hc, w_qkv, sinks, w_o, need_ctx):
    bsz, S, _ = hx.shape
    G, R = B_KV_HEADS, B_HEADS // B_KV_HEADS
    scale = HEAD_DIM ** -0.5

    def proj(h):
        L = h.shape[1]
        q, k, v = jnp.split(h @ w_qkv, [B_HEADS * HEAD_DIM, (B_HEADS + B_KV_HEADS) * HEAD_DIM], axis=-1)
        return (q.reshape(bsz, L, G, R, HEAD_DIM), k.reshape(bsz, L, G, HEAD_DIM),
                v.reshape(bsz, L, G, HEAD_DIM))

    qx, kx, vx = proj(hx)
    qc, kc, vc = proj(hc)
    qx = axial_rope(qx) * scale
    kx = axial_rope(kx)
    qc = qc * scale
    sink = sinks.astype(jnp.float32).reshape(G, R, 1, 1)

    nb = S // Q_BLOCK
    span = Q_BLOCK + 2 * WINDOW
    kp = jnp.pad(kx, ((0, 0), (WINDOW, WINDOW), (0, 0), (0, 0)))
    vp = jnp.pad(vx, ((0, 0), (WINDOW, WINDOW), (0, 0), (0, 0)))
    qb = jnp.moveaxis(qx.reshape(bsz, nb, Q_BLOCK, G, R, HEAD_DIM), 1, 0)

    def block(args):
        jb, q = args
        start = jb * Q_BLOCK
        k = lax.dynamic_slice_in_dim(kp, start, span, axis=1)
        v = lax.dynamic_slice_in_dim(vp, start, span, axis=1)
        q_pos = start + jnp.arange(Q_BLOCK)
        k_pos = start - WINDOW + jnp.arange(span)
        valid = ((jnp.abs(q_pos[:, None] - k_pos[None, :]) <= WINDOW)
                 & (k_pos >= 0)[None, :] & (k_pos < S)[None, :])
        s_loc = jnp.where(valid, jnp.einsum('bqgrd,bkgd->bgrqk', q, k).astype(jnp.float32), NEG)
        s_ctx = jnp.einsum('bqgrd,bkgd->bgrqk', q, kc).astype(jnp.float32)
        s_sink = jnp.broadcast_to(sink, s_ctx.shape[:-1] + (1,))
        _, p_ctx, p_loc = joint_softmax([s_sink, s_ctx, s_loc])
        return (jnp.einsum('bgrqk,bkgd->bqgrd', p_loc.astype(v.dtype), v)
                + jnp.einsum('bgrqk,bkgd->bqgrd', p_ctx.astype(vc.dtype), vc))

    o = lax.map(block, (jnp.arange(nb), qb))
    y_x = jnp.moveaxis(o, 0, 1).reshape(bsz, S, B_HEADS * HEAD_DIM) @ w_o
    y_c = None
    if need_ctx:
        s_cc = jnp.einsum('bqgrd,bkgd->bgrqk', qc, kc).astype(jnp.float32)
        _, p_cc = joint_softmax([jnp.broadcast_to(sink, s_cc.shape[:-1] + (1,)), s_cc])
        o_c = jnp.einsum('bgrqk,bkgd->bqgrd', p_cc.astype(vc.dtype), vc)
        y_c = o_c.reshape(bsz, hc.shape[1], B_HEADS * HEAD_DIM) @ w_o
    return y_x, y_c


def mixer_nat(hx, hc, w_qkv, rpb, w_o, need_ctx):
    bsz, S, _ = hx.shape
    H = C_HEADS
    rows = S // GRID_W
    kh = min(WIN_H, rows)
    kw = WIN_W
    scale = HEAD_DIM ** -0.5

    def proj(h):
        L = h.shape[1]
        q, k, v = jnp.split(h @ w_qkv, 3, axis=-1)
        return (q.reshape(bsz, L, H, HEAD_DIM) * scale, k.reshape(bsz, L, H, HEAD_DIM),
                v.reshape(bsz, L, H, HEAD_DIM))

    qx, kx, vx = proj(hx)
    qc, kc, vc = proj(hc)
    qg = jnp.moveaxis(qx.reshape(bsz, rows, GRID_W, H, HEAD_DIM), 1, 0)
    kg = kx.reshape(bsz, rows, GRID_W, H, HEAD_DIM)
    vg = vx.reshape(bsz, rows, GRID_W, H, HEAD_DIM)
    col = np.arange(GRID_W)
    col_start = np.clip(col - kw // 2, 0, GRID_W - kw)
    col_idx = col_start[:, None] + np.arange(kw)
    col_off = col_idx - col[:, None] + (WIN_W - 1)
    rpb_cols = rpb[:, :, col_off]

    def row_block(args):
        r, q = args
        rs = jnp.clip(r - kh // 2, 0, rows - kh)
        k_rows = lax.dynamic_slice_in_dim(kg, rs, kh, axis=1)
        v_rows = lax.dynamic_slice_in_dim(vg, rs, kh, axis=1)
        k_nb = jnp.moveaxis(k_rows[:, :, col_idx], 2, 1).reshape(bsz, GRID_W, kh * kw, H, HEAD_DIM)
        v_nb = jnp.moveaxis(v_rows[:, :, col_idx], 2, 1).reshape(bsz, GRID_W, kh * kw, H, HEAD_DIM)
        row_off = rs + jnp.arange(kh) - r + (WIN_H - 1)
        bias = jnp.moveaxis(jnp.take(rpb_cols, row_off, axis=1), 1, 2).reshape(H, GRID_W, kh * kw)
        s_nb = jnp.einsum('bqhd,bqkhd->bhqk', q, k_nb).astype(jnp.float32) + bias.astype(jnp.float32)
        s_ctx = jnp.einsum('bqhd,bkhd->bhqk', q, kc).astype(jnp.float32)
        p_ctx, p_nb = joint_softmax([s_ctx, s_nb])
        return (jnp.einsum('bhqk,bqkhd->bqhd', p_nb.astype(v_nb.dtype), v_nb)
                + jnp.einsum('bhqk,bkhd->bqhd', p_ctx.astype(vc.dtype), vc))

    o = lax.map(row_block, (jnp.arange(rows), qg))
    y_x = jnp.moveaxis(o, 0, 1).reshape(bsz, S, H * HEAD_DIM) @ w_o
    y_c = None
    if need_ctx:
        s_cc = jnp.einsum('bqhd,bkhd->bhqk', qc, kc).astype(jnp.float32)
        p_cc = jax.nn.softmax(s_cc, axis=-1)
        o_c = jnp.einsum('bhqk,bkhd->bqhd', p_cc.astype(vc.dtype), vc)
        y_c = o_c.reshape(bsz, hc.shape[1], H * HEAD_DIM) @ w_o
    return y_x, y_c


def setup_inputs(seed: int = 0) -> dict:
    key = jax.random.key(seed)
    ks = jax.random.split(key, 24)
    D = D_MODEL
    n_a = len(range(0, DEPTH, N_MIXERS))
    n_b = len(range(1, DEPTH, N_MIXERS))
    n_c = len(range(2, DEPTH, N_MIXERS))

    def nrm(k, shape, s):
        return jax.random.normal(k, shape, jnp.float32) * s

    u = jax.random.uniform(ks[13], (n_a, 2, D_RNN), jnp.float32, A_MIN, A_MAX)
    a_base = u ** (1.0 / LRU_C)
    lam = jnp.log(a_base) - jnp.log1p(-a_base)
    return {
        "x": nrm(ks[0], (BATCH, SEQ, D), 1.0),
        "c": nrm(ks[1], (BATCH, D), 1.0),
        "ctx": nrm(ks[2], (BATCH, CTX_LEN, D), 1.0),
        "c_ctx": nrm(ks[3], (D,), 1.0),
        "w_ada": nrm(ks[4], (DEPTH, D, 9 * D), 0.5 * D ** -0.5),
        "b_ada": nrm(ks[5], (DEPTH, 9 * D), 0.02),
        "norm_g": 1.0 + nrm(ks[6], (DEPTH, 3, D), 0.1),
        "w_ffn_gu": nrm(ks[7], (DEPTH, 2, D, 2 * D_FF), D ** -0.5),
        "w_ffn_down": nrm(ks[8], (DEPTH, 2, D_FF, D), D_FF ** -0.5),
        "a_w_in": nrm(ks[9], (n_a, D, 2 * D_RNN), D ** -0.5),
        "a_conv_w": nrm(ks[10], (n_a, CONV_W, D_RNN), CONV_W ** -0.5),
        "a_conv_b": nrm(ks[11], (n_a, D_RNN), 0.02),
        "a_gate_w": nrm(ks[12], (n_a, 2, 2, LRU_BLOCKS, LRU_BW, LRU_BW), LRU_BW ** -0.5),
        "a_gate_b": nrm(ks[14], (n_a, 2, 2, D_RNN), 0.1),
        "a_lambda": lam,
        "a_w_out": nrm(ks[15], (n_a, D_RNN, D), D_RNN ** -0.5),
        "b_w_qkv": nrm(ks[16], (n_b, D, (B_HEADS + 2 * B_KV_HEADS) * HEAD_DIM), D ** -0.5),
        "b_sinks": nrm(ks[17], (n_b, B_HEADS), 1.0),
        "b_w_o": nrm(ks[18], (n_b, B_HEADS * HEAD_DIM, D), (B_HEADS * HEAD_DIM) ** -0.5),
        "c_w_qkv": nrm(ks[19], (n_c, D, 3 * C_HEADS * HEAD_DIM), D ** -0.5),
        "c_rpb": nrm(ks[20], (n_c, C_HEADS, 2 * WIN_H - 1, 2 * WIN_W - 1), 0.5),
        "c_w_o": nrm(ks[21], (n_c, C_HEADS * HEAD_DIM, D), (C_HEADS * HEAD_DIM) ** -0.5),
        "final_g": 1.0 + nrm(ks[22], (D,), 0.1),
    }


def reference(x, c, ctx, c_ctx, w_ada, b_ada, norm_g, w_ffn_gu, w_ffn_down,
              a_w_in, a_conv_w, a_conv_b, a_gate_w, a_gate_b, a_lambda, a_w_out,
              b_w_qkv, b_sinks, b_w_o, c_w_qkv, c_rpb, c_w_o, final_g):
    bsz = x.shape[0]
    sc = jax.nn.silu(c)
    scc = jax.nn.silu(c_ctx)
    for i in range(DEPTH):
        kind, j = i % N_MIXERS, i // N_MIXERS
        need_ctx = i < DEPTH - 1
        mx = (sc @ w_ada[i] + b_ada[i]).reshape(bsz, 3, 3, 1, D_MODEL)
        mc = (scc @ w_ada[i] + b_ada[i]).reshape(3, 3, D_MODEL)
        x = ffn_residual(x, norm_g[i, 0], mx[:, 0, 0], mx[:, 0, 1], mx[:, 0, 2], w_ffn_gu[i, 0], w_ffn_down[i, 0])
        ctx = ffn_residual(ctx, norm_g[i, 0], mc[0, 0], mc[0, 1], mc[0, 2], w_ffn_gu[i, 0], w_ffn_down[i, 0])
        hx = adaln_in(x, norm_g[i, 1], mx[:, 1, 0], mx[:, 1, 1])
        hc = adaln_in(ctx, norm_g[i, 1], mc[1, 0], mc[1, 1])
        if kind == 0:
            y_x, y_c = mixer_rglru(hx, hc, a_w_in[j], a_conv_w[j], a_conv_b[j], a_gate_w[j],
                                   a_gate_b[j], a_lambda[j], a_w_out[j], need_ctx)
        elif kind == 1:
            y_x, y_c = mixer_swa(hx, hc, b_w_qkv[j], b_sinks[j], b_w_o[j], need_ctx)
        else:
            y_x, y_c = mixer_nat(hx, hc, c_w_qkv[j], c_rpb[j], c_w_o[j], need_ctx)
        x = x + mx[:, 1, 2] * y_x
        x = ffn_residual(x, norm_g[i, 2], mx[:, 2, 0], mx[:, 2, 1], mx[:, 2, 2], w_ffn_gu[i, 1], w_ffn_down[i, 1])
        if need_ctx:
            ctx = ctx + mc[1, 2] * y_c
            ctx = ffn_residual(ctx, norm_g[i, 2], mc[2, 0], mc[2, 1], mc[2, 2], w_ffn_gu[i, 1], w_ffn_down[i, 1])
    return rms_norm(x, final_g)
```

```cpp
#include <hip/hip_runtime.h>
#include <hip/hip_cooperative_groups.h>
#include <cstdio>
#include <cstdint>
namespace cg = cooperative_groups;

#define LAS __attribute__((address_space(3)))
typedef unsigned short bf16_t;
typedef short bf16x8 __attribute__((ext_vector_type(8)));
typedef short bf16x4 __attribute__((ext_vector_type(4)));
typedef float f32x4 __attribute__((ext_vector_type(4)));
typedef unsigned u32x4 __attribute__((ext_vector_type(4)));
typedef unsigned u32x2 __attribute__((ext_vector_type(2)));

constexpr int D = 1024, SEQ = 16384, CTXL = 256, MX = 32768, MCTX = 512, MT = MX + MCTX;
constexpr int DFF = 2816, DRNN = 1536, NLAYER = 4;
constexpr int NCHUNK = 130;
constexpr int LDS_XB = 137216;
constexpr int LDS_BYTES = LDS_XB + 256;

#define XCD_BAR_WORDS 3456
constexpr size_t al256(size_t x) { return (x + 255) & ~(size_t)255; }
constexpr size_t WS_WGU = 0;
constexpr size_t WS_WDN = al256(WS_WGU + (size_t)8 * 5632 * 1024 * 2);
constexpr size_t WS_WAIN = al256(WS_WDN + (size_t)8 * 1024 * 2816 * 2);
constexpr size_t WS_WAOUT = al256(WS_WAIN + (size_t)2 * 3072 * 1024 * 2);
constexpr size_t WS_WAG = al256(WS_WAOUT + (size_t)2 * 1024 * 1536 * 2);
constexpr size_t WS_WBQKV = al256(WS_WAG + (size_t)96 * 128 * 128 * 2);
constexpr size_t WS_WBO = al256(WS_WBQKV + (size_t)1536 * 1024 * 2);
constexpr size_t WS_WCQKV = al256(WS_WBO + (size_t)1024 * 1024 * 2);
constexpr size_t WS_WCO = al256(WS_WCQKV + (size_t)3072 * 1024 * 2);
constexpr size_t WS_MOD = al256(WS_WCO + (size_t)1024 * 1024 * 2);
constexpr size_t WS_ROPE = al256(WS_MOD + (size_t)4 * 3 * 9216 * 4);
constexpr size_t WS_PE = al256(WS_ROPE + (size_t)2 * 256 * 16 * 4);
constexpr size_t PE_HALF = (size_t)2 * 2 * NCHUNK * DRNN;
constexpr size_t WS_CIN = al256(WS_PE + 2 * PE_HALF * 4);
constexpr size_t WS_XS = al256(WS_CIN + PE_HALF * 4);
constexpr size_t WS_HN = al256(WS_XS + (size_t)MT * D * 4);
constexpr size_t WS_ACT = al256(WS_HN + (size_t)MT * 1536 * 2);
constexpr size_t WS_EXTRA = al256(WS_ACT + (size_t)MT * 3072 * 2);
constexpr size_t WS_SLAB = al256(WS_EXTRA + (size_t)MT * 1024 * 2);
constexpr size_t WS_BAR = al256(WS_EXTRA + (size_t)MT * 1536 * 2);
static_assert(WS_SLAB + (size_t)11 * MCTX * D * 4 <= WS_BAR, "slabs must fit in EXTRA's tail");
constexpr size_t WS_END = al256(WS_BAR + (size_t)XCD_BAR_WORDS * 4);

__device__ __forceinline__ int opaque_tid() { int t = threadIdx.x; asm volatile("" : "+v"(t)); return t; }
template <class T> __device__ __forceinline__ T* opaque_ptr(T* p) { asm volatile("" : "+s"(p)); return p; }
__device__ __forceinline__ unsigned cvt_pk_bf16(float lo, float hi) { unsigned r; asm("v_cvt_pk_bf16_f32 %0, %1, %2" : "=v"(r) : "v"(lo), "v"(hi)); return r; }
__device__ __forceinline__ float bf2f(bf16_t b) { return __uint_as_float(((unsigned)b) << 16); }
__device__ __forceinline__ float bflo(unsigned u) { return __uint_as_float(u << 16); }
__device__ __forceinline__ float bfhi(unsigned u) { return __uint_as_float(u & 0xffff0000u); }
__device__ __forceinline__ float sigmoidf_(float z) { return __builtin_amdgcn_rcpf(1.0f + __expf(-z)); }
__device__ __forceinline__ float siluf_(float z) { return z * sigmoidf_(z); }
__device__ __forceinline__ float gelu_tanh(float x) { const float u = 0.7978845608028654f * (x + 0.044715f * x * x * x); return x * sigmoidf_(2.0f * u); }
__device__ __forceinline__ float wave_sum(float v) {
#pragma unroll
    for (int o = 1; o < 64; o <<= 1) v += __shfl_xor(v, o);
    return v;
}

#define XB_TMO      128
#define XB_XCNT(j)  (256  + 64 * (j))
#define XB_XSUB(j)  (1280 + 64 * (j))
#define XB_XGEN(j)  (2304 + 64 * (j))
#define XB_TOP      3328
#define XB_TOPGEN   3392
#define XB_SPIN_CAP (1u << 20)
__device__ __forceinline__ unsigned xb_ld(unsigned* p)              { return __hip_atomic_load(p, __ATOMIC_RELAXED, __HIP_MEMORY_SCOPE_AGENT); }
__device__ __forceinline__ unsigned xb_add(unsigned* p, unsigned v) { return __hip_atomic_fetch_add(p, v, __ATOMIC_RELAXED, __HIP_MEMORY_SCOPE_AGENT); }
__device__ __forceinline__ unsigned xb_xcc_id() { return (unsigned)__builtin_amdgcn_s_getreg((3 << 11) | 20) & 0xFu; }
#define XB_SPIN(cond, bar) do { unsigned _sp = 0; while (cond) { __builtin_amdgcn_s_sleep(1); \
    if ((++_sp & 255u) == 0u) { if (xb_ld(&(bar)[XB_TMO])) break; if (_sp > XB_SPIN_CAP) { atomicAdd(&(bar)[XB_TMO], 1u); break; } } } } while (0)
struct XcdBarrier { unsigned* bar; unsigned x; volatile LAS unsigned* st; };
__device__ __forceinline__ XcdBarrier xcd_barrier_post(unsigned* bar, volatile LAS unsigned* st) {
    XcdBarrier b; b.bar = bar; b.x = xb_xcc_id(); b.st = st;
    if (threadIdx.x == 0) (void)xb_add(&bar[XB_XCNT(b.x)], 1u);
    return b;
}
__device__ __forceinline__ void xcd_barrier_complete(unsigned* bar, unsigned x, unsigned& nloc, unsigned& nx) {
    const unsigned G = gridDim.x * gridDim.y * gridDim.z;
    unsigned sum, cnt, mine, sp = 0u;
    for (;;) {
        sum = 0u; cnt = 0u; mine = 0u;
#pragma unroll
        for (unsigned j = 0; j < 16; ++j) { const unsigned c = xb_ld(&bar[XB_XCNT(j)]); sum += c; cnt += (c > 0u) ? 1u : 0u; mine = (j == x) ? c : mine; }
        if (sum == G) break;
        __builtin_amdgcn_s_sleep(1);
        if ((++sp & 255u) == 0u) { if (xb_ld(&bar[XB_TMO])) break; if (sp > XB_SPIN_CAP) { atomicAdd(&bar[XB_TMO], 1u); break; } }
    }
    nloc = mine > 0u ? mine : 1u; nx = cnt > 0u ? cnt : 1u;
}
__device__ __forceinline__ void xcd_barrier(const XcdBarrier& b) {
    asm volatile("s_waitcnt vmcnt(0)" ::: "memory");
    __syncthreads();
    if (threadIdx.x == 0) {
        unsigned* bar = b.bar;
        __builtin_amdgcn_s_waitcnt(0);
        unsigned nloc = b.st[0], nx = b.st[1];
        if (nloc == 0u) { xcd_barrier_complete(bar, b.x, nloc, nx); b.st[0] = nloc; b.st[1] = nx; }
        const unsigned old = xb_add(&bar[XB_XSUB(b.x)], 1u);
        const unsigned gen = old / nloc;
        if (old + 1u == (gen + 1u) * nloc) {
            __builtin_amdgcn_fence(__ATOMIC_RELEASE, "agent");
            asm volatile("s_waitcnt vmcnt(0)" ::: "memory");
            const unsigned og = xb_add(&bar[XB_TOP], 1u);
            const unsigned tg = og / nx;
            if (og + 1u == (tg + 1u) * nx) xb_add(&bar[XB_TOPGEN], 1u);
            else XB_SPIN(xb_ld(&bar[XB_TOPGEN]) == tg, bar);
            __builtin_amdgcn_fence(__ATOMIC_ACQUIRE, "agent");
            xb_add(&bar[XB_XGEN(b.x)], 1u);
            asm volatile("s_waitcnt vmcnt(0)" ::: "memory");
        } else {
            XB_SPIN(xb_ld(&bar[XB_XGEN(b.x)]) == gen, bar);
            __builtin_amdgcn_fence(__ATOMIC_ACQUIRE, "agent");
            asm volatile("s_waitcnt vmcnt(0)" ::: "memory");
        }
    }
    __syncthreads();
}

namespace pg8 {
constexpr int BM = 256, BK = 64, HALF = 128, HTB = HALF * BK * 2, STAGE_BYTES = 8 * HTB, NXCD = 8, WGM = 8;
__device__ __forceinline__ int lds_byte(int r, int c) { const int st = (r >> 4) * 2 + (c >> 5), rr = r & 15, cc = c & 31, ob = rr * 64 + cc * 2; return st * 1024 + (ob ^ (((ob >> 9) & 1) << 5)); }
__device__ __forceinline__ void stage_rc(int b, int& R, int& C) { const int st = b / 1024, sb = b % 1024, swz = sb ^ (((sb >> 9) & 1) << 5); R = (st >> 1) * 16 + swz / 64; C = (st & 1) * 32 + (swz % 64) / 2; }
__device__ __forceinline__ int perm32(int rho) { const int n = rho >> 4, i = rho & 15; return 8 * (i >> 2) + 4 * n + (i & 3); }
struct Unit { int pm, pn, ks, nt, at; };
struct Gemm { const bf16_t* A; const bf16_t* Bt; int M, N, K; };
struct StaticOrder {
    int nM, nN, nwg, G, c, nctx, main_nt;
    __device__ void init(int M, int N, int K, int G_, int c_, bool splitctx) {
        nN = N / BM; G = G_; c = c_; main_nt = K / BK;
        if (splitctx && M == MT) { nM = MX / BM; nctx = 2 * nN * (K / 256); } else { nM = M / BM; nctx = 0; }
        nwg = nM * nN;
    }
    __device__ bool next(int i, Unit& u) const {
        long L = (long)i * G + c;
        if (L >= nwg) {
            L -= nwg; if (L >= nctx) return false;
            const int rem = (int)L % (2 * nN);
            u.ks = (int)L / (2 * nN); u.pm = 128 + (rem & 1); u.pn = rem >> 1; u.nt = 4; u.at = 1; return true;
        }
        int wgid = (int)L; { const int q = nwg / NXCD, r = nwg % NXCD, xcd = wgid % NXCD, off = wgid / NXCD; wgid = (xcd < r ? xcd * (q + 1) : r * (q + 1) + (xcd - r) * q) + off; }
        const int nig = WGM * nN, gid = wgid / nig, fm = gid * WGM, gsz = (nM - fm) < WGM ? (nM - fm) : WGM;
        u.pm = fm + ((wgid % nig) % gsz); u.pn = (wgid % nig) / gsz; u.ks = 0; u.nt = main_nt; u.at = 0; return true;
    }
};
template <class Epi>
__device__ __forceinline__ void gemm_phase(LAS unsigned char* lds, const Gemm g, const StaticOrder& S, const Epi& E) {
    const int tid = opaque_tid(), wid = __builtin_amdgcn_readfirstlane(tid >> 6), lane = tid & 63, wr = wid >> 2, wc = wid & 3, fr = lane & 15, fq = lane >> 4;
    const int K = g.K;
    unsigned voffA[2], voffB[2];
#pragma unroll
    for (int i = 0; i < 2; ++i) { int R, C; stage_rc(tid * 16 + i * 8192, R, C); const int Rb = E.perm() ? ((R & ~31) + perm32(R & 31)) : R;
        voffA[i] = (unsigned)(R * K + C) * 2u; voffB[i] = (unsigned)(Rb * K + C) * 2u; }
    const size_t kstep = (size_t)(BK * 2);
    const size_t hstep = (size_t)HALF * K * 2;
    const size_t tstep = 2 * hstep;
    const unsigned ldsw = (unsigned)wid * 1024u;
    const int aoff = lds_byte(wr * 64 + fr, fq * 8), boff = lds_byte(wc * 32 + fr, fq * 8);
#define PG8_SA(b, h) (((b) * 2 + (h)) * HTB)
#define PG8_SB(b, h) ((4 + (b) * 2 + (h)) * HTB)
#define PG8_STAGE(bufoff, gbase, voff) do { _Pragma("unroll") for (int _i = 0; _i < 2; ++_i) \
        __builtin_amdgcn_global_load_lds((const unsigned*)((const char*)(gbase) + (voff)[_i]), (LAS unsigned*)(lds + (bufoff) + ldsw + _i * 8192), 16, 0, 0); } while (0)
#define PG8_LDA(dst, b, h) do { _Pragma("unroll") for (int m = 0; m < 4; ++m) _Pragma("unroll") for (int k = 0; k < 2; ++k) dst[m][k] = *(const LAS bf16x8*)(lds + PG8_SA(b, h) + aoff + m * 2048 + k * 1024); } while (0)
#define PG8_LDB(dst, b, h) do { _Pragma("unroll") for (int n = 0; n < 2; ++n) _Pragma("unroll") for (int k = 0; k < 2; ++k) dst[n][k] = *(const LAS bf16x8*)(lds + PG8_SB(b, h) + boff + n * 2048 + k * 1024); } while (0)
#define PG8_MMA(ai, bj, At, Bt) do { __builtin_amdgcn_s_setprio(1); _Pragma("unroll") for (int m = 0; m < 4; ++m) _Pragma("unroll") for (int n = 0; n < 2; ++n) _Pragma("unroll") for (int k = 0; k < 2; ++k) \
        acc[ai][bj][m][n] = __builtin_amdgcn_mfma_f32_16x16x32_bf16(Bt[n][k], At[m][k], acc[ai][bj][m][n], 0, 0, 0); __builtin_amdgcn_s_setprio(0); } while (0)
#define PG8_WAIT_V(n) asm volatile("s_waitcnt vmcnt(" #n ")" ::: "memory")
#define PG8_WAIT_L(n) asm volatile("s_waitcnt lgkmcnt(" #n ")" ::: "memory")
#define PG8_BAR __builtin_amdgcn_s_barrier()
#define PG8_SCHED __builtin_amdgcn_sched_barrier(0)
    Unit cur, nxt; int ui = 0;
    if (!S.next(0, cur)) return;
    f32x4 acc[2][2][4][2];
#pragma unroll
    for (int a = 0; a < 2; ++a)
#pragma unroll
        for (int b = 0; b < 2; ++b)
#pragma unroll
            for (int m = 0; m < 4; ++m)
#pragma unroll
                for (int n = 0; n < 2; ++n) acc[a][b][m][n] = (f32x4){0.f, 0.f, 0.f, 0.f};
    bf16x8 At[4][2], B0[2][2], B1[2][2];
    const char* cA = (const char*)g.A + (size_t)cur.pm * tstep + (size_t)cur.ks * 512; const char* cB = (const char*)g.Bt + (size_t)cur.pn * tstep + (size_t)cur.ks * 512;
    PG8_STAGE(PG8_SB(0, 0), cB, voffB); PG8_STAGE(PG8_SA(0, 0), cA, voffA); PG8_STAGE(PG8_SB(0, 1), cB + hstep, voffB); PG8_STAGE(PG8_SA(0, 1), cA + hstep, voffA);
    if (wr == 1) PG8_BAR;
    PG8_WAIT_V(4); PG8_BAR;
    PG8_STAGE(PG8_SB(1, 0), cB + kstep, voffB); PG8_STAGE(PG8_SA(1, 0), cA + kstep, voffA); PG8_STAGE(PG8_SB(1, 1), cB + hstep + kstep, voffB);
    PG8_WAIT_V(6); PG8_BAR;
    for (;;) {
        const bool has_next = S.next(ui + 1, nxt);
        const char* nA = has_next ? (const char*)g.A + (size_t)nxt.pm * tstep + (size_t)nxt.ks * 512 : cA; const char* nB = has_next ? (const char*)g.Bt + (size_t)nxt.pn * tstep + (size_t)nxt.ks * 512 : cB;
        const int nt = cur.nt;
        for (int t = 0; t < nt; t += 2) {
            const bool last = (t == nt - 2);
            const char* a1 = cA + (size_t)(t + 1) * kstep;
            const char* a2 = last ? nA : cA + (size_t)(t + 2) * kstep; const char* b2 = last ? nB : cB + (size_t)(t + 2) * kstep;
            const char* a3 = a2 + kstep; const char* b3 = b2 + kstep;
            PG8_LDB(B0, 0, 0); PG8_SCHED; PG8_LDA(At, 0, 0); PG8_STAGE(PG8_SA(1, 1), a1 + hstep, voffA);
            PG8_WAIT_L(8); PG8_BAR; PG8_WAIT_L(0); PG8_MMA(0, 0, At, B0); PG8_BAR; PG8_SCHED;
            PG8_LDB(B1, 0, 1); PG8_STAGE(PG8_SB(0, 0), b2, voffB);
            PG8_BAR; PG8_WAIT_L(0); PG8_MMA(0, 1, At, B1); PG8_BAR;
            PG8_LDA(At, 0, 1); PG8_STAGE(PG8_SA(0, 0), a2, voffA);
            PG8_BAR; PG8_WAIT_L(0); PG8_MMA(1, 0, At, B0); PG8_BAR; PG8_SCHED;
            PG8_STAGE(PG8_SB(0, 1), b2 + hstep, voffB);
            PG8_WAIT_V(6); PG8_BAR; PG8_MMA(1, 1, At, B1); PG8_BAR;
            PG8_LDB(B0, 1, 0); PG8_SCHED; PG8_LDA(At, 1, 0); PG8_STAGE(PG8_SA(0, 1), a2 + hstep, voffA);
            PG8_WAIT_L(8); PG8_BAR; PG8_WAIT_L(0); PG8_MMA(0, 0, At, B0); PG8_BAR; PG8_SCHED;
            PG8_LDB(B1, 1, 1); PG8_STAGE(PG8_SB(1, 0), b3, voffB);
            PG8_BAR; PG8_WAIT_L(0); PG8_MMA(0, 1, At, B1); PG8_BAR;
            PG8_LDA(At, 1, 1); PG8_STAGE(PG8_SA(1, 0), a3, voffA);
            PG8_BAR; PG8_WAIT_L(0); PG8_MMA(1, 0, At, B0); PG8_BAR; PG8_SCHED;
            PG8_STAGE(PG8_SB(1, 1), b3 + hstep, voffB);
            PG8_WAIT_V(6); PG8_BAR; PG8_MMA(1, 1, At, B1); PG8_BAR;
        }
        if (wr == 0) PG8_BAR;
        E(acc, cur, wr, wc, fr, fq);
        if (!has_next) break;
#pragma unroll
        for (int a = 0; a < 2; ++a)
#pragma unroll
            for (int b = 0; b < 2; ++b)
#pragma unroll
                for (int m = 0; m < 4; ++m)
#pragma unroll
                    for (int n = 0; n < 2; ++n) acc[a][b][m][n] = (f32x4){0.f, 0.f, 0.f, 0.f};
        cur = nxt; cA = nA; cB = nB; ++ui;
        if (wr == 1) PG8_BAR;
    }
    PG8_WAIT_V(0);
    PG8_BAR;
#undef PG8_SA
#undef PG8_SB
#undef PG8_STAGE
#undef PG8_LDA
#undef PG8_LDB
#undef PG8_MMA
#undef PG8_WAIT_V
#undef PG8_WAIT_L
#undef PG8_BAR
#undef PG8_SCHED
}
}
using pg8::Unit;
typedef f32x4 AccT[2][2][4][2];

struct EpiSwiGLU {
    static constexpr bool PERM = true;
    bf16_t* out;
    __device__ __forceinline__ void operator()(const AccT& acc, const Unit& u, int wr, int wc, int fr, int fq) const {
        const int row0 = u.pm * 256 + wr * 64 + fr, col0 = u.pn * 128 + wc * 32 + 8 * fq;
#pragma unroll
        for (int ai = 0; ai < 2; ++ai)
#pragma unroll
            for (int m = 0; m < 4; ++m) {
                const f32x4 g0 = acc[ai][0][m][0], g1 = acc[ai][0][m][1], u0 = acc[ai][1][m][0], u1 = acc[ai][1][m][1];
                u32x4 o;
                o.x = cvt_pk_bf16(siluf_(g0[0]) * u0[0], siluf_(g0[1]) * u0[1]); o.y = cvt_pk_bf16(siluf_(g0[2]) * u0[2], siluf_(g0[3]) * u0[3]);
                o.z = cvt_pk_bf16(siluf_(g1[0]) * u1[0], siluf_(g1[1]) * u1[1]); o.w = cvt_pk_bf16(siluf_(g1[2]) * u1[2], siluf_(g1[3]) * u1[3]);
                *(u32x4*)(out + (size_t)(row0 + ai * 128 + m * 16) * DFF + col0) = o;
            }
    }
};
struct EpiResid {
    static constexpr bool PERM = true;
    float* slab; bf16_t* y; const float* gate; float coef;
    __device__ __forceinline__ void operator()(const AccT& acc, const Unit& u, int wr, int wc, int fr, int fq) const {
        const int mb = (u.pm >= 128) ? 2 : (u.pm >= 64 ? 1 : 0);
        const float* gp = gate + mb * 9216;
        const int row0 = u.pm * 256 + wr * 64 + fr, col0 = u.pn * 256 + wc * 32 + 8 * fq;
        f32x4 gv[2][2];
#pragma unroll
        for (int bj = 0; bj < 2; ++bj)
#pragma unroll
            for (int n = 0; n < 2; ++n) gv[bj][n] = *(const f32x4*)(gp + col0 + bj * 128 + 4 * n) * coef;
#pragma unroll
        for (int ai = 0; ai < 2; ++ai)
#pragma unroll
            for (int m = 0; m < 4; ++m) {
                const size_t ro = (size_t)(row0 + ai * 128 + m * 16) * D + col0;
#pragma unroll
                for (int bj = 0; bj < 2; ++bj) {
                    const f32x4 v0 = gv[bj][0] * acc[ai][bj][m][0], v1 = gv[bj][1] * acc[ai][bj][m][1];
                    if (u.at) {
                        float* pf = slab + (size_t)u.ks * MCTX * D + (ro - (size_t)MX * D) + bj * 128;
                        *(f32x4*)pf = v0; *(f32x4*)(pf + 4) = v1;
                    } else {
                        u32x4 o; o.x = cvt_pk_bf16(v0[0], v0[1]); o.y = cvt_pk_bf16(v0[2], v0[3]); o.z = cvt_pk_bf16(v1[0], v1[1]); o.w = cvt_pk_bf16(v1[2], v1[3]);
                        *(u32x4*)(y + ro + bj * 128) = o;
                    }
                }
            }
    }
};
struct EpiBf16 {
    static constexpr bool PERM = true;
    bf16_t* out; int ldc; int qcols; float qscale; bf16_t* vt;
    __device__ __forceinline__ void operator()(const AccT& acc, const Unit& u, int wr, int wc, int fr, int fq) const {
        const int row0 = u.pm * 256 + wr * 64 + fr, col0 = u.pn * 256 + wc * 32 + 8 * fq;
        const float sc = (u.pn * 256 < qcols) ? qscale : 1.0f;
        if (vt != nullptr && u.pn >= 8) {
            const bool isx = u.pm < 128;
            const int bb = isx ? (u.pm >> 6) : ((u.pm - 128));
            const size_t tstride = isx ? (size_t)SEQ : (size_t)CTXL;
            bf16_t* base = vt + (isx ? (size_t)0 : (size_t)2 * 16 * 64 * SEQ) + (size_t)bb * 16 * 64 * tstride;
            const int tok0 = (isx ? ((u.pm & 63) * 256) : 0) + wr * 64 + fr;
#pragma unroll
            for (int ai = 0; ai < 2; ++ai)
#pragma unroll
                for (int m = 0; m < 4; ++m) {
                    const int tok = tok0 + ai * 128 + m * 16;
#pragma unroll
                    for (int bj = 0; bj < 2; ++bj) {
                        const int hd = col0 - 2048 + bj * 128;
                        bf16_t* p = base + (size_t)hd * tstride + tok;
                        const f32x4 v0 = acc[ai][bj][m][0], v1 = acc[ai][bj][m][1];
                        const unsigned a0 = cvt_pk_bf16(v0[0], v0[1]), a1 = cvt_pk_bf16(v0[2], v0[3]), a2 = cvt_pk_bf16(v1[0], v1[1]), a3 = cvt_pk_bf16(v1[2], v1[3]);
                        p[0 * tstride] = (bf16_t)(a0 & 0xffff); p[1 * tstride] = (bf16_t)(a0 >> 16); p[2 * tstride] = (bf16_t)(a1 & 0xffff); p[3 * tstride] = (bf16_t)(a1 >> 16);
                        p[4 * tstride] = (bf16_t)(a2 & 0xffff); p[5 * tstride] = (bf16_t)(a2 >> 16); p[6 * tstride] = (bf16_t)(a3 & 0xffff); p[7 * tstride] = (bf16_t)(a3 >> 16);
                    }
                }
            return;
        }
#pragma unroll
        for (int ai = 0; ai < 2; ++ai)
#pragma unroll
            for (int m = 0; m < 4; ++m) {
                bf16_t* rowp = out + (size_t)(row0 + ai * 128 + m * 16) * ldc + col0;
#pragma unroll
                for (int bj = 0; bj < 2; ++bj) {
                    const f32x4 v0 = acc[ai][bj][m][0] * sc, v1 = acc[ai][bj][m][1] * sc;
                    u32x4 o; o.x = cvt_pk_bf16(v0[0], v0[1]); o.y = cvt_pk_bf16(v0[2], v0[3]); o.z = cvt_pk_bf16(v1[0], v1[1]); o.w = cvt_pk_bf16(v1[2], v1[3]);
                    *(u32x4*)(rowp + bj * 128) = o;
                }
            }
    }
};
struct EpiRope {
    static constexpr bool PERM = false;
    bf16_t* out; const float* rope;
    __device__ __forceinline__ void operator()(const AccT& acc, const Unit& u, int wr, int wc, int fr, int fq) const {
        const int row0 = u.pm * 256 + wr * 64 + fr, col0 = u.pn * 256 + wc * 32 + 4 * fq;
        const bool is_q = u.pn < 4, is_v = u.pn == 5, do_rope = (!is_v) && (u.pm < 128);
        const float sc = is_q ? 0.125f * 1.4426950408889634f : 1.0f;
#pragma unroll
        for (int ai = 0; ai < 2; ++ai)
#pragma unroll
            for (int m = 0; m < 4; ++m) {
                const int row = row0 + ai * 128 + m * 16;
                const int t = row & (SEQ - 1);
                const int pos = (wc & 1) ? (t & 63) : (t >> 6);
                f32x4 cs = (f32x4){1.f, 1.f, 1.f, 1.f}, sn = (f32x4){0.f, 0.f, 0.f, 0.f};
                if (do_rope) { cs = *(const f32x4*)(rope + pos * 16 + 4 * fq); sn = *(const f32x4*)(rope + 4096 + pos * 16 + 4 * fq); }
                bf16_t* rowp = out + (size_t)row * 1536 + col0;
#pragma unroll
                for (int bj = 0; bj < 2; ++bj) {
                    const f32x4 x1 = acc[ai][bj][m][0], x2 = acc[ai][bj][m][1];
                    const f32x4 o1 = (x1 * cs - x2 * sn) * sc, o2 = (x2 * cs + x1 * sn) * sc;
                    u32x2 a, b; a.x = cvt_pk_bf16(o1[0], o1[1]); a.y = cvt_pk_bf16(o1[2], o1[3]); b.x = cvt_pk_bf16(o2[0], o2[1]); b.y = cvt_pk_bf16(o2[2], o2[3]);
                    *(u32x2*)(rowp + bj * 128) = a; *(u32x2*)(rowp + bj * 128 + 16) = b;
                }
            }
    }
};

struct EpiAny {
    int mode;
    EpiSwiGLU e0; EpiResid e1; EpiBf16 e2; EpiRope e3;
    __device__ __forceinline__ bool perm() const { return mode != 3; }
    __device__ __forceinline__ void operator()(const AccT& acc, const Unit& u, int wr, int wc, int fr, int fq) const {
        if (mode == 0) e0(acc, u, wr, wc, fr, fq);
        else if (mode == 1) e1(acc, u, wr, wc, fr, fq);
        else if (mode == 2) e2(acc, u, wr, wc, fr, fq);
        else e3(acc, u, wr, wc, fr, fq);
    }
};

struct Args {
    const float* in[23];
    float* out;
    unsigned char* ws;
};
enum { I_X = 0, I_C, I_CTX, I_CCTX, I_WADA, I_BADA, I_NORMG, I_WGU, I_WDN, I_AWIN, I_ACONVW, I_ACONVB, I_AGATEW, I_AGATEB, I_ALAM, I_AWOUT,
       I_BWQKV, I_BSINKS, I_BWO, I_CWQKV, I_CRPB, I_CWO, I_FINALG };

__device__ __forceinline__ void transpose_item(const float* W, int K, int N, bf16_t* WT, int k0, int n0, int drow0, LAS float* scr, int lane) {
    f32x4 wv[8];
#pragma unroll
    for (int i = 0; i < 8; ++i) wv[i] = __builtin_nontemporal_load((const f32x4*)(W + (size_t)(k0 + (lane >> 3) + 8 * i) * N + n0 + 4 * (lane & 7)));
#pragma unroll
    for (int i = 0; i < 8; ++i) { LAS float* sp = scr + ((lane >> 3) + 8 * i) * 33 + 4 * (lane & 7); sp[0] = wv[i][0]; sp[1] = wv[i][1]; sp[2] = wv[i][2]; sp[3] = wv[i][3]; }
    asm volatile("s_waitcnt lgkmcnt(0)" ::: "memory");
    const int c = lane & 7;
#pragma unroll
    for (int j = 0; j < 4; ++j) { const int n = (lane >> 3) + 8 * j; const LAS float* s = scr + (8 * c) * 33 + n;
        u32x4 o; o.x = cvt_pk_bf16(s[0 * 33], s[1 * 33]); o.y = cvt_pk_bf16(s[2 * 33], s[3 * 33]); o.z = cvt_pk_bf16(s[4 * 33], s[5 * 33]); o.w = cvt_pk_bf16(s[6 * 33], s[7 * 33]);
        *(u32x4*)(WT + (size_t)(drow0 + n) * K + k0 + 8 * c) = o; }
    asm volatile("s_waitcnt lgkmcnt(0)" ::: "memory");
}
__device__ __forceinline__ bool transpose_family(int& it, const float* W, int cnt, int K, int N, bf16_t* WT, bool gu, LAS float* scr, int lane) {
    const int nblk = N / 32, kblk = K / 64, per = nblk * kblk, tot = per * cnt;
    if (it >= tot) { it -= tot; return false; }
    const int mi = it / per, r = it % per, kb = r / nblk, nb = r % nblk;
    const int n0 = 32 * nb; int drow0 = n0;
    if (gu) { const int half = n0 >= DFF ? 1 : 0, nn = n0 - half * DFF; drow0 = (nn >> 7) * 256 + half * 128 + (nn & 127); }
    transpose_item(W + (size_t)mi * K * N, K, N, WT + (size_t)mi * K * N, 64 * kb, n0, drow0, scr, lane);
    return true;
}
__device__ __forceinline__ void phase_prep(const Args& a, LAS unsigned char* lds) {
    const int tid = opaque_tid(), lane = tid & 63, wave = tid >> 6;
    unsigned char* ws = a.ws;
    {
        const int idx = blockIdx.x * 512 + tid;
        if (idx < 4096) {
            const int pos = idx >> 4, j = idx & 15;
            double inv = (j & 3) == 0 ? 1.0 : ((j & 3) == 1 ? 0.5623413251903491 : ((j & 3) == 2 ? 0.31622776601683794 : 0.1778279410038923));
            const int dec = j >> 2; inv *= (dec == 0 ? 1.0 : dec == 1 ? 0.1 : dec == 2 ? 0.01 : 0.001);
            double rev = (double)pos * inv * 0.15915494309189535; rev -= floor(rev);
            float* rope = (float*)(ws + WS_ROPE);
            rope[idx] = __builtin_amdgcn_cosf((float)rev); rope[4096 + idx] = __builtin_amdgcn_sinf((float)rev);
        }
    }
    {
        LAS float* sv = (LAS float*)lds;
        LAS float* red = sv + 3 * 1024;
        for (int e = tid; e < 3 * 1024; e += 512) { const int v = e >> 10, k = e & 1023; const float cv = v < 2 ? a.in[I_C][v * 1024 + k] : a.in[I_CCTX][k]; sv[e] = siluf_(cv); }
        __syncthreads();
        float* mod = (float*)(ws + WS_MOD);
        for (int task = blockIdx.x; task < 4 * 72; task += gridDim.x) {
            const int i = task / 72, col0 = (task % 72) * 128;
            const int cg4 = tid & 31, kg = tid >> 5;
            const float* wp = a.in[I_WADA] + ((size_t)i * 1024 + kg * 64) * 9216 + col0 + 4 * cg4;
            f32x4 s0 = (f32x4){0, 0, 0, 0}, s1 = s0, s2 = s0;
#pragma unroll 8
            for (int k = 0; k < 64; ++k) { const f32x4 w = *(const f32x4*)(wp + (size_t)k * 9216); const int kk = kg * 64 + k; s0 += w * sv[kk]; s1 += w * sv[1024 + kk]; s2 += w * sv[2048 + kk]; }
#pragma unroll
            for (int e = 0; e < 4; ++e) { red[(kg * 3 + 0) * 128 + 4 * cg4 + e] = s0[e]; red[(kg * 3 + 1) * 128 + 4 * cg4 + e] = s1[e]; red[(kg * 3 + 2) * 128 + 4 * cg4 + e] = s2[e]; }
            __syncthreads();
            if (tid < 384) { const int v = tid >> 7, cc = tid & 127; float s = 0.f;
#pragma unroll
                for (int q = 0; q < 16; ++q) s += red[(q * 3 + v) * 128 + cc];
                mod[((size_t)i * 3 + v) * 9216 + col0 + cc] = s + a.in[I_BADA][(size_t)i * 9216 + col0 + cc]; }
            __syncthreads();
        }
    }
    {
        LAS float* scr = (LAS float*)(lds + wave * 8448);
        const int gw = blockIdx.x * 8 + wave, NGW = gridDim.x * 8;
        constexpr int TOT = 8 * 16 * 176 + 8 * 44 * 32 + 2 * 16 * 96 + 2 * 24 * 32 + 96 * 2 * 4 + 16 * 48 + 16 * 32 + 16 * 96 + 16 * 32;
        for (int item = gw; item < TOT; item += NGW) {
            int it = item;
            if (transpose_family(it, a.in[I_WGU], 8, 1024, 5632, (bf16_t*)(ws + WS_WGU), true, scr, lane)) continue;
            if (transpose_family(it, a.in[I_WDN], 8, 2816, 1024, (bf16_t*)(ws + WS_WDN), false, scr, lane)) continue;
            if (transpose_family(it, a.in[I_AWIN], 2, 1024, 3072, (bf16_t*)(ws + WS_WAIN), false, scr, lane)) continue;
            if (transpose_family(it, a.in[I_AWOUT], 2, 1536, 1024, (bf16_t*)(ws + WS_WAOUT), false, scr, lane)) continue;
            if (transpose_family(it, a.in[I_AGATEW], 96, 128, 128, (bf16_t*)(ws + WS_WAG), false, scr, lane)) continue;
            if (transpose_family(it, a.in[I_BWQKV], 1, 1024, 1536, (bf16_t*)(ws + WS_WBQKV), false, scr, lane)) continue;
            if (transpose_family(it, a.in[I_BWO], 1, 1024, 1024, (bf16_t*)(ws + WS_WBO), false, scr, lane)) continue;
            if (transpose_family(it, a.in[I_CWQKV], 1, 1024, 3072, (bf16_t*)(ws + WS_WCQKV), false, scr, lane)) continue;
            transpose_family(it, a.in[I_CWO], 1, 1024, 1024, (bf16_t*)(ws + WS_WCO), false, scr, lane);
        }
    }
}

__device__ __forceinline__ void phase_norm(const Args& a, int layer, int sub, bool first, int nrows, bool addy, int nsplit) {
    const int tid_ = opaque_tid(), lane = tid_ & 63, gw = blockIdx.x * 8 + (tid_ >> 6), NGW = gridDim.x * 8;
    bf16_t* xs = (bf16_t*)(a.ws + WS_XS); bf16_t* hn = (bf16_t*)(a.ws + WS_HN);
    const float* mod = (const float*)(a.ws + WS_MOD) + (size_t)layer * 3 * 9216;
    const float* ng = a.in[I_NORMG] + ((size_t)layer * 3 + sub) * 1024;
    const bf16_t* yb = (const bf16_t*)(a.ws + WS_EXTRA);
    f32x4 gv[4];
#pragma unroll
    for (int j = 0; j < 4; ++j) gv[j] = *(const f32x4*)(ng + 4 * lane + 256 * j);
    constexpr int R = 4;
    for (int r0 = gw; r0 < MX; r0 += R * NGW) {
        f32x4 v[R][4]; u32x2 xx[R][4], yy[R][4]; int rowq[R]; bool okq[R];
#pragma unroll
        for (int q = 0; q < R; ++q) {
            okq[q] = r0 + q * NGW < MX; rowq[q] = okq[q] ? r0 + q * NGW : r0;
            if (first) {
#pragma unroll
                for (int j = 0; j < 4; ++j) v[q][j] = __builtin_nontemporal_load((const f32x4*)(a.in[I_X] + (size_t)rowq[q] * D + 4 * lane + 256 * j));
            } else {
#pragma unroll
                for (int j = 0; j < 4; ++j) xx[q][j] = __builtin_nontemporal_load((const u32x2*)(xs + (size_t)rowq[q] * D + 4 * lane + 256 * j));
            }
            if (addy) {
#pragma unroll
                for (int j = 0; j < 4; ++j) yy[q][j] = __builtin_nontemporal_load((const u32x2*)(yb + (size_t)rowq[q] * D + 4 * lane + 256 * j));
            }
        }
#pragma unroll
        for (int q = 0; q < R; ++q) {
            const int row = rowq[q];
            float s = 0.f;
#pragma unroll
            for (int j = 0; j < 4; ++j) {
                if (!first) { v[q][j][0] = bflo(xx[q][j].x); v[q][j][1] = bfhi(xx[q][j].x); v[q][j][2] = bflo(xx[q][j].y); v[q][j][3] = bfhi(xx[q][j].y); }
                if (addy) { v[q][j][0] += bflo(yy[q][j].x); v[q][j][1] += bfhi(yy[q][j].x); v[q][j][2] += bflo(yy[q][j].y); v[q][j][3] += bfhi(yy[q][j].y); }
                s += (v[q][j][0] * v[q][j][0] + v[q][j][1] * v[q][j][1]) + (v[q][j][2] * v[q][j][2] + v[q][j][3] * v[q][j][3]);
            }
            if ((first || addy) && okq[q]) {
#pragma unroll
                for (int j = 0; j < 4; ++j) { u32x2 o; o.x = cvt_pk_bf16(v[q][j][0], v[q][j][1]); o.y = cvt_pk_bf16(v[q][j][2], v[q][j][3]); __builtin_nontemporal_store(o, (u32x2*)(xs + (size_t)row * D + 4 * lane + 256 * j)); }
            }
            const float rstd = rsqrtf(wave_sum(s) * (1.0f / D) + 1e-6f);
            const float* shp = mod + (row >= SEQ ? 1 : 0) * 9216 + (sub * 3 + 0) * 1024; const float* scp = shp + 1024;
            if (okq[q]) {
#pragma unroll
                for (int j = 0; j < 4; ++j) {
                    const f32x4 sh = *(const f32x4*)(shp + 4 * lane + 256 * j), sc = *(const f32x4*)(scp + 4 * lane + 256 * j);
                    const f32x4 y = v[q][j] * rstd * gv[j] * (sc + 1.0f) + sh;
                    u32x2 o; o.x = cvt_pk_bf16(y[0], y[1]); o.y = cvt_pk_bf16(y[2], y[3]);
                    __builtin_nontemporal_store(o, (u32x2*)(hn + (size_t)row * D + 4 * lane + 256 * j));
                }
            }
        }
    }
    for (int row = MX + gw; row < nrows; row += NGW) {
        f32x4 v[4]; float s = 0.f;
        if (first) {
#pragma unroll
            for (int j = 0; j < 4; ++j) v[j] = *(const f32x4*)(a.in[I_CTX] + (size_t)(row - MX) * D + 4 * lane + 256 * j);
        } else {
#pragma unroll
            for (int j = 0; j < 4; ++j) { const u32x2 x2 = *(const u32x2*)(xs + (size_t)row * D + 4 * lane + 256 * j); v[j][0] = bflo(x2.x); v[j][1] = bfhi(x2.x); v[j][2] = bflo(x2.y); v[j][3] = bfhi(x2.y); }
        }
        if (addy) {
            const float* sr = (const float*)(a.ws + WS_SLAB) + (size_t)(row - MX) * D;
#pragma unroll 1
            for (int ks = 0; ks < nsplit; ++ks) {
#pragma unroll
                for (int j = 0; j < 4; ++j) v[j] += *(const f32x4*)(sr + (size_t)ks * MCTX * D + 4 * lane + 256 * j);
            }
        }
#pragma unroll
        for (int j = 0; j < 4; ++j) s += (v[j][0] * v[j][0] + v[j][1] * v[j][1]) + (v[j][2] * v[j][2] + v[j][3] * v[j][3]);
        if (first || addy) {
#pragma unroll
            for (int j = 0; j < 4; ++j) { u32x2 o; o.x = cvt_pk_bf16(v[j][0], v[j][1]); o.y = cvt_pk_bf16(v[j][2], v[j][3]); *(u32x2*)(xs + (size_t)row * D + 4 * lane + 256 * j) = o; }
        }
        const float rstd = rsqrtf(wave_sum(s) * (1.0f / D) + 1e-6f);
        const float* shp = mod + 2 * 9216 + (sub * 3 + 0) * 1024; const float* scp = shp + 1024;
#pragma unroll
        for (int j = 0; j < 4; ++j) {
            const f32x4 sh = *(const f32x4*)(shp + 4 * lane + 256 * j), sc = *(const f32x4*)(scp + 4 * lane + 256 * j);
            const f32x4 y = v[j] * rstd * gv[j] * (sc + 1.0f) + sh;
            u32x2 o; o.x = cvt_pk_bf16(y[0], y[1]); o.y = cvt_pk_bf16(y[2], y[3]);
            *(u32x2*)(hn + (size_t)row * D + 4 * lane + 256 * j) = o;
        }
    }
}
__device__ __forceinline__ void phase_final(const Args& a) {
    const int tid_ = opaque_tid(), lane = tid_ & 63, gw = blockIdx.x * 8 + (tid_ >> 6), NGW = gridDim.x * 8;
    const bf16_t* xs = (const bf16_t*)(a.ws + WS_XS);
    const bf16_t* yb = (const bf16_t*)(a.ws + WS_EXTRA);
    f32x4 gv[4];
#pragma unroll
    for (int j = 0; j < 4; ++j) gv[j] = *(const f32x4*)(a.in[I_FINALG] + 4 * lane + 256 * j);
    constexpr int R = 4;
    for (int r0 = gw; r0 < MX; r0 += R * NGW) {
        u32x2 xx[R][4], yy[R][4]; int rowq[R]; bool okq[R];
#pragma unroll
        for (int q = 0; q < R; ++q) {
            okq[q] = r0 + q * NGW < MX; rowq[q] = okq[q] ? r0 + q * NGW : r0;
#pragma unroll
            for (int j = 0; j < 4; ++j) { xx[q][j] = *(const u32x2*)(xs + (size_t)rowq[q] * D + 4 * lane + 256 * j); yy[q][j] = *(const u32x2*)(yb + (size_t)rowq[q] * D + 4 * lane + 256 * j); }
        }
#pragma unroll
        for (int q = 0; q < R; ++q) {
            float s = 0.f; f32x4 v[4];
#pragma unroll
            for (int j = 0; j < 4; ++j) {
                v[j][0] = bflo(xx[q][j].x) + bflo(yy[q][j].x); v[j][1] = bfhi(xx[q][j].x) + bfhi(yy[q][j].x); v[j][2] = bflo(xx[q][j].y) + bflo(yy[q][j].y); v[j][3] = bfhi(xx[q][j].y) + bfhi(yy[q][j].y);
                s += (v[j][0] * v[j][0] + v[j][1] * v[j][1]) + (v[j][2] * v[j][2] + v[j][3] * v[j][3]);
            }
            const float rstd = rsqrtf(wave_sum(s) * (1.0f / D) + 1e-6f);
            if (okq[q]) {
#pragma unroll
                for (int j = 0; j < 4; ++j) *(f32x4*)(a.out + (size_t)rowq[q] * D + 4 * lane + 256 * j) = v[j] * rstd * gv[j];
            }
        }
    }
}

__device__ __forceinline__ void phase_swa(LAS unsigned char* lds, const bf16_t* QKV, bf16_t* O, const float* sinks, bool need_ctx) {
    constexpr int LDQ = 1536, KS = 72, VS = 72;
    LAS bf16_t* Ks = (LAS bf16_t*)lds;
    LAS bf16_t* Vt = Ks + 64 * KS;
    const int tid = opaque_tid(), w = tid >> 6, lane = tid & 63, fr = lane & 15, fq = lane >> 4;
    const int lrow = tid >> 3, lcg = tid & 7;
    const int n_items = 2048 + (need_ctx ? 32 : 0);
    for (int item = blockIdx.x; item < n_items; item += gridDim.x) {
        const bool cq = item >= 2048;
        int b, hp, g, jb;
        if (!cq) { hp = item & 1; g = (item >> 1) & 3; jb = (item >> 3) & 127; b = item >> 10; }
        else { const int it = item - 2048; hp = it & 1; g = (it >> 1) & 3; jb = (it >> 3) & 1; b = it >> 4; }
        const int h = 4 * g + 2 * hp + (w >> 2), qsub = (w & 3) * 32;
        const int qrow0 = cq ? (MX + b * CTXL + jb * 128 + qsub) : (b * SEQ + jb * 128 + qsub);
        const int kcol0 = 1024 + g * 64, vcol0 = 1280 + g * 64;
        bf16x8 Qf[2][2];
#pragma unroll
        for (int qt = 0; qt < 2; ++qt)
#pragma unroll
            for (int k2 = 0; k2 < 2; ++k2) Qf[qt][k2] = *(const bf16x8*)(QKV + (size_t)(qrow0 + 16 * qt + fr) * LDQ + h * 64 + 32 * k2 + 8 * fq);
        f32x4 Oa[4][2];
#pragma unroll
        for (int dt = 0; dt < 4; ++dt)
#pragma unroll
            for (int qt = 0; qt < 2; ++qt) Oa[dt][qt] = (f32x4){0.f, 0.f, 0.f, 0.f};
        float mrun[2], lrun[2];
        { const float sk = sinks[h] * 1.4426950408889634f; mrun[0] = mrun[1] = sk; lrun[0] = lrun[1] = (fq == 0) ? 1.0f : 0.0f; }
        const int ntiles = cq ? 4 : 10;
#define SWA_KPOS(t_) (jb * 128 - 128 + 64 * ((t_) - 4))
#define SWA_VALID(t_) ((t_) < 4 || (SWA_KPOS(t_) >= 0 && SWA_KPOS(t_) < SEQ))
#define SWA_KROW(t_) ((t_) < 4 ? (MX + b * CTXL + 64 * (t_)) : (b * SEQ + SWA_KPOS(t_)))
        u32x4 kreg, vreg;
        int ti = 0;
        { const size_t ro = (size_t)(SWA_KROW(0) + lrow) * LDQ + 8 * lcg; kreg = *(const u32x4*)(QKV + ro + kcol0); vreg = *(const u32x4*)(QKV + ro + vcol0); }
        while (ti < ntiles) {
            __syncthreads();
            *(LAS u32x4*)(Ks + lrow * KS + 8 * lcg) = kreg;
            { LAS bf16_t* vp = Vt + (8 * lcg) * VS + lrow;
              vp[0 * VS] = (bf16_t)(vreg.x & 0xffff); vp[1 * VS] = (bf16_t)(vreg.x >> 16); vp[2 * VS] = (bf16_t)(vreg.y & 0xffff); vp[3 * VS] = (bf16_t)(vreg.y >> 16);
              vp[4 * VS] = (bf16_t)(vreg.z & 0xffff); vp[5 * VS] = (bf16_t)(vreg.z >> 16); vp[6 * VS] = (bf16_t)(vreg.w & 0xffff); vp[7 * VS] = (bf16_t)(vreg.w >> 16); }
            __syncthreads();
            int tn = ti + 1;
            while (tn < ntiles && !SWA_VALID(tn)) ++tn;
            if (tn < ntiles) { const size_t ro = (size_t)(SWA_KROW(tn) + lrow) * LDQ + 8 * lcg; kreg = *(const u32x4*)(QKV + ro + kcol0); vreg = *(const u32x4*)(QKV + ro + vcol0); }
            const int kpos0 = SWA_KPOS(ti);
            f32x4 s[4][2];
#pragma unroll
            for (int kt = 0; kt < 4; ++kt) {
                const bf16x8 k0 = *(const LAS bf16x8*)(Ks + (16 * kt + fr) * KS + 8 * fq);
                const bf16x8 k1 = *(const LAS bf16x8*)(Ks + (16 * kt + fr) * KS + 32 + 8 * fq);
#pragma unroll
                for (int qt = 0; qt < 2; ++qt) {
                    f32x4 z = (f32x4){0.f, 0.f, 0.f, 0.f};
                    z = __builtin_amdgcn_mfma_f32_16x16x32_bf16(k0, Qf[qt][0], z, 0, 0, 0);
                    s[kt][qt] = __builtin_amdgcn_mfma_f32_16x16x32_bf16(k1, Qf[qt][1], z, 0, 0, 0);
                }
            }
            if (ti >= 4) {
#pragma unroll
                for (int qt = 0; qt < 2; ++qt) {
                    const int qpos = jb * 128 + qsub + 16 * qt + fr;
#pragma unroll
                    for (int kt = 0; kt < 4; ++kt)
#pragma unroll
                        for (int j = 0; j < 4; ++j) { const int dlt = qpos - (kpos0 + 16 * kt + 4 * fq + j); if (dlt > 128 || dlt < -128) s[kt][qt][j] = -INFINITY; }
                }
            }
            bf16x8 Pf[2][2];
#pragma unroll
            for (int qt = 0; qt < 2; ++qt) {
                float mx = -INFINITY;
#pragma unroll
                for (int kt = 0; kt < 4; ++kt)
#pragma unroll
                    for (int j = 0; j < 4; ++j) mx = fmaxf(mx, s[kt][qt][j]);
                mx = fmaxf(mx, __shfl_xor(mx, 16)); mx = fmaxf(mx, __shfl_xor(mx, 32));
                const float mnew = fmaxf(mrun[qt], mx);
                const float alpha = __builtin_amdgcn_exp2f(mrun[qt] - mnew);
                mrun[qt] = mnew;
                float ls = 0.f;
                float p[4][4];
#pragma unroll
                for (int kt = 0; kt < 4; ++kt)
#pragma unroll
                    for (int j = 0; j < 4; ++j) { p[kt][j] = __builtin_amdgcn_exp2f(s[kt][qt][j] - mnew); ls += p[kt][j]; }
                lrun[qt] = lrun[qt] * alpha + ls;
#pragma unroll
                for (int dt = 0; dt < 4; ++dt) Oa[dt][qt] = Oa[dt][qt] * alpha;
#pragma unroll
                for (int k2 = 0; k2 < 2; ++k2) {
                    u32x4 pk; pk.x = cvt_pk_bf16(p[2 * k2][0], p[2 * k2][1]); pk.y = cvt_pk_bf16(p[2 * k2][2], p[2 * k2][3]);
                    pk.z = cvt_pk_bf16(p[2 * k2 + 1][0], p[2 * k2 + 1][1]); pk.w = cvt_pk_bf16(p[2 * k2 + 1][2], p[2 * k2 + 1][3]);
                    Pf[qt][k2] = __builtin_bit_cast(bf16x8, pk);
                }
            }
#pragma unroll
            for (int dt = 0; dt < 4; ++dt)
#pragma unroll
                for (int k2 = 0; k2 < 2; ++k2) {
                    const LAS bf16_t* vp = Vt + (16 * dt + fr) * VS + 32 * k2 + 4 * fq;
                    const u32x2 v0 = *(const LAS u32x2*)vp, v1 = *(const LAS u32x2*)(vp + 16);
                    u32x4 vv; vv.x = v0.x; vv.y = v0.y; vv.z = v1.x; vv.w = v1.y;
                    const bf16x8 vf = __builtin_bit_cast(bf16x8, vv);
#pragma unroll
                    for (int qt = 0; qt < 2; ++qt) Oa[dt][qt] = __builtin_amdgcn_mfma_f32_16x16x32_bf16(vf, Pf[qt][k2], Oa[dt][qt], 0, 0, 0);
                }
            ti = tn;
        }
#undef SWA_KPOS
#undef SWA_VALID
#undef SWA_KROW
#pragma unroll
        for (int qt = 0; qt < 2; ++qt) {
            float l = lrun[qt]; l += __shfl_xor(l, 16); l += __shfl_xor(l, 32);
            const float inv = 1.0f / l;
            bf16_t* op = O + (size_t)(qrow0 + 16 * qt + fr) * D + h * 64 + 4 * fq;
#pragma unroll
            for (int dt = 0; dt < 4; ++dt) { const f32x4 o = Oa[dt][qt] * inv; u32x2 pk; pk.x = cvt_pk_bf16(o[0], o[1]); pk.y = cvt_pk_bf16(o[2], o[3]); *(u32x2*)(op + 16 * dt) = pk; }
        }
    }
}

__device__ __forceinline__ void phase_nat(LAS unsigned char* lds, const bf16_t* QKV, const bf16_t* VT, bf16_t* O, const float* rpb, bool need_ctx) {
    constexpr int LDQ = 3072, KS = 264, VS = 72;
    LAS bf16_t* Ks = (LAS bf16_t*)lds;
    LAS bf16_t* Vt = Ks + 64 * KS;
    LAS float* rp = (LAS float*)(Vt + 256 * VS);
    const int tid = opaque_tid(), w = tid >> 6, lane = tid & 63, fr = lane & 15, fq = lane >> 4;
    const bool fast = gridDim.x == 256;
    const int xcd = blockIdx.x & 7, mloc = blockIdx.x >> 3;
    const int hg = fast ? (mloc & 3) : (blockIdx.x & 3);
    const int hw = w >> 1, h = 4 * hg + hw, qsub = (w & 1) * 32;
    __syncthreads();
    for (int e = tid; e < 4 * 465; e += 512) rp[e] = rpb[(size_t)(4 * hg) * 465 + e] * 1.4426950408889634f;
    int kc0[2], relb[2]; unsigned okm = 0u;
#pragma unroll
    for (int qt = 0; qt < 2; ++qt) {
        const int c0 = qsub + 16 * qt, c = c0 + fr;
        kc0[qt] = c0 - 8 < 0 ? 0 : (c0 - 8 > 32 ? 32 : c0 - 8);
        const int cst = c - 8 < 0 ? 0 : (c - 8 > 48 ? 48 : c - 8);
        relb[qt] = kc0[qt] + 4 * fq - c + 15;
#pragma unroll
        for (int i = 0; i < 2; ++i)
#pragma unroll
            for (int j = 0; j < 4; ++j) { const int kk = kc0[qt] + 16 * i + 4 * fq + j; if (kk >= cst && kk < cst + 16) okm |= 1u << (qt * 8 + i * 4 + j); }
    }
    const int n_items = 2048 + (need_ctx ? 32 : 0);
    for (int kk = 0; ; ++kk) {
        bool cq; int b, r, rs = 0;
        if (fast) {
            if (kk < 8) { const int G = kk * 8 + xcd; cq = false; b = G >> 5; r = ((G & 31) << 3) + (mloc >> 2); }
            else if (kk == 8 && need_ctx && blockIdx.x < 32) { const int it = ((blockIdx.x & 7) << 2) | (blockIdx.x >> 3); cq = true; b = it >> 4; r = (it >> 2) & 3; }
            else break;
        } else {
            const int item = blockIdx.x + kk * gridDim.x;
            if (item >= n_items) break;
            cq = item >= 2048;
            if (!cq) { r = (item >> 2) & 255; b = item >> 10; } else { const int it = item - 2048; r = (it >> 2) & 3; b = it >> 4; }
        }
        if (!cq) rs = r - 4 < 0 ? 0 : (r - 4 > 248 ? 248 : r - 4);
        const int qrow0 = cq ? (MX + b * CTXL + r * 64 + qsub) : (b * SEQ + r * 64 + qsub);
        const int ntiles = cq ? 4 : 12;
        bf16x8 Qf[2][2];
#pragma unroll
        for (int qt = 0; qt < 2; ++qt)
#pragma unroll
            for (int k2 = 0; k2 < 2; ++k2) Qf[qt][k2] = *(const bf16x8*)(QKV + (size_t)(qrow0 + 16 * qt + fr) * LDQ + h * 64 + 32 * k2 + 8 * fq);
        f32x4 Oa[4][2];
#pragma unroll
        for (int dt = 0; dt < 4; ++dt)
#pragma unroll
            for (int qt = 0; qt < 2; ++qt) Oa[dt][qt] = (f32x4){0.f, 0.f, 0.f, 0.f};
        float mrun[2] = {-INFINITY, -INFINITY}, lrun[2] = {0.f, 0.f};
        u32x4 kreg[4], vreg[4];
        const bf16_t* vtx = VT + (size_t)(b * 16 + 4 * hg) * 64 * SEQ;
        const bf16_t* vtc = VT + (size_t)2 * 16 * 64 * SEQ + (size_t)(b * 16 + 4 * hg) * 64 * CTXL;
#define NAT_LOAD(ti_) do { const int _ti = (ti_); \
            const bool _c = _ti < 4; const int _krow0 = _c ? (MX + b * CTXL + 64 * _ti) : (b * SEQ + (rs + _ti - 4) * 64); \
            const bf16_t* _vb = _c ? vtc + 64 * _ti : vtx + (rs + _ti - 4) * 64; const size_t _vs = _c ? (size_t)CTXL : (size_t)SEQ; \
            _Pragma("unroll") for (int _i = 0; _i < 4; ++_i) { const int _cx = tid + 512 * _i; \
                kreg[_i] = *(const u32x4*)(QKV + (size_t)(_krow0 + (_cx >> 5)) * LDQ + 1024 + hg * 256 + 8 * (_cx & 31)); \
                vreg[_i] = *(const u32x4*)(_vb + (size_t)(_cx >> 3) * _vs + 8 * (_cx & 7)); } } while (0)
        NAT_LOAD(0);
#pragma unroll 1
        for (int ti = 0; ti < ntiles; ++ti) {
            __syncthreads();
#pragma unroll
            for (int i = 0; i < 4; ++i) { const int cx = tid + 512 * i;
                *(LAS u32x4*)(Ks + (cx >> 5) * KS + 8 * (cx & 31)) = kreg[i];
                *(LAS u32x4*)(Vt + (cx >> 3) * VS + 8 * (cx & 7)) = vreg[i]; }
            __syncthreads();
            if (ti + 1 < ntiles) NAT_LOAD(ti + 1);
            if (ti < 4) {
#pragma unroll
                for (int qt = 0; qt < 2; ++qt) {
                    f32x4 s[4];
#pragma unroll
                    for (int kt = 0; kt < 4; ++kt) {
                        const bf16x8 k0 = *(const LAS bf16x8*)(Ks + (16 * kt + fr) * KS + hw * 64 + 8 * fq);
                        const bf16x8 k1 = *(const LAS bf16x8*)(Ks + (16 * kt + fr) * KS + hw * 64 + 32 + 8 * fq);
                        f32x4 z = (f32x4){0.f, 0.f, 0.f, 0.f};
                        z = __builtin_amdgcn_mfma_f32_16x16x32_bf16(k0, Qf[qt][0], z, 0, 0, 0);
                        s[kt] = __builtin_amdgcn_mfma_f32_16x16x32_bf16(k1, Qf[qt][1], z, 0, 0, 0);
                    }
                    float mx = -INFINITY;
#pragma unroll
                    for (int kt = 0; kt < 4; ++kt)
#pragma unroll
                        for (int j = 0; j < 4; ++j) mx = fmaxf(mx, s[kt][j]);
                    mx = fmaxf(mx, __shfl_xor(mx, 16)); mx = fmaxf(mx, __shfl_xor(mx, 32));
                    const float mnew = fmaxf(mrun[qt], mx), alpha = __builtin_amdgcn_exp2f(mrun[qt] - mnew);
                    mrun[qt] = mnew;
                    float ls = 0.f;
#pragma unroll
                    for (int kt = 0; kt < 4; ++kt)
#pragma unroll
                        for (int j = 0; j < 4; ++j) { s[kt][j] = __builtin_amdgcn_exp2f(s[kt][j] - mnew); ls += s[kt][j]; }
                    lrun[qt] = lrun[qt] * alpha + ls;
#pragma unroll
                    for (int dt = 0; dt < 4; ++dt) Oa[dt][qt] = Oa[dt][qt] * alpha;
#pragma unroll
                    for (int k2 = 0; k2 < 2; ++k2) {
                        u32x4 pk; pk.x = cvt_pk_bf16(s[2 * k2][0], s[2 * k2][1]); pk.y = cvt_pk_bf16(s[2 * k2][2], s[2 * k2][3]);
                        pk.z = cvt_pk_bf16(s[2 * k2 + 1][0], s[2 * k2 + 1][1]); pk.w = cvt_pk_bf16(s[2 * k2 + 1][2], s[2 * k2 + 1][3]);
                        const bf16x8 pf = __builtin_bit_cast(bf16x8, pk);
#pragma unroll
                        for (int dt = 0; dt < 4; ++dt) {
                            const LAS bf16_t* vp = Vt + (hw * 64 + 16 * dt + fr) * VS + 32 * k2 + 4 * fq;
                            const u32x2 v0 = *(const LAS u32x2*)vp, v1 = *(const LAS u32x2*)(vp + 16);
                            u32x4 vv; vv.x = v0.x; vv.y = v0.y; vv.z = v1.x; vv.w = v1.y;
                            Oa[dt][qt] = __builtin_amdgcn_mfma_f32_16x16x32_bf16(__builtin_bit_cast(bf16x8, vv), pf, Oa[dt][qt], 0, 0, 0);
                        }
                    }
                }
            } else {
                const LAS float* rrow = rp + hw * 465 + ((rs + ti - 4) - r + 7) * 31;
#pragma unroll
                for (int qt = 0; qt < 2; ++qt) {
                    f32x4 s[2];
#pragma unroll
                    for (int i = 0; i < 2; ++i) {
                        const LAS bf16_t* kp = Ks + (kc0[qt] + 16 * i + fr) * KS + hw * 64 + 8 * fq;
                        f32x4 z = (f32x4){0.f, 0.f, 0.f, 0.f};
                        z = __builtin_amdgcn_mfma_f32_16x16x32_bf16(*(const LAS bf16x8*)kp, Qf[qt][0], z, 0, 0, 0);
                        s[i] = __builtin_amdgcn_mfma_f32_16x16x32_bf16(*(const LAS bf16x8*)(kp + 32), Qf[qt][1], z, 0, 0, 0);
                    }
                    const LAS float* bp = rrow + relb[qt];
                    float mx = -INFINITY;
#pragma unroll
                    for (int i = 0; i < 2; ++i)
#pragma unroll
                        for (int j = 0; j < 4; ++j) { const bool ok = (okm >> (qt * 8 + i * 4 + j)) & 1u; const float bv = bp[16 * i + j];
                            s[i][j] = ok ? s[i][j] + bv : -INFINITY; mx = fmaxf(mx, s[i][j]); }
                    mx = fmaxf(mx, __shfl_xor(mx, 16)); mx = fmaxf(mx, __shfl_xor(mx, 32));
                    const float mnew = fmaxf(mrun[qt], mx), alpha = __builtin_amdgcn_exp2f(mrun[qt] - mnew);
                    mrun[qt] = mnew;
                    float ls = 0.f;
#pragma unroll
                    for (int i = 0; i < 2; ++i)
#pragma unroll
                        for (int j = 0; j < 4; ++j) { s[i][j] = __builtin_amdgcn_exp2f(s[i][j] - mnew); ls += s[i][j]; }
                    lrun[qt] = lrun[qt] * alpha + ls;
                    u32x4 pk; pk.x = cvt_pk_bf16(s[0][0], s[0][1]); pk.y = cvt_pk_bf16(s[0][2], s[0][3]); pk.z = cvt_pk_bf16(s[1][0], s[1][1]); pk.w = cvt_pk_bf16(s[1][2], s[1][3]);
                    const bf16x8 pf = __builtin_bit_cast(bf16x8, pk);
#pragma unroll
                    for (int dt = 0; dt < 4; ++dt) {
                        const LAS bf16_t* vp = Vt + (hw * 64 + 16 * dt + fr) * VS + kc0[qt] + 4 * fq;
                        const u32x2 v0 = *(const LAS u32x2*)vp, v1 = *(const LAS u32x2*)(vp + 16);
                        u32x4 vv; vv.x = v0.x; vv.y = v0.y; vv.z = v1.x; vv.w = v1.y;
                        Oa[dt][qt] = __builtin_amdgcn_mfma_f32_16x16x32_bf16(__builtin_bit_cast(bf16x8, vv), pf, Oa[dt][qt] * alpha, 0, 0, 0);
                    }
                }
            }
        }
#undef NAT_LOAD
#pragma unroll
        for (int qt = 0; qt < 2; ++qt) {
            float l = lrun[qt]; l += __shfl_xor(l, 16); l += __shfl_xor(l, 32);
            const float inv = 1.0f / l;
            bf16_t* op = O + (size_t)(qrow0 + 16 * qt + fr) * D + h * 64 + 4 * fq;
#pragma unroll
            for (int dt = 0; dt < 4; ++dt) { const f32x4 o = Oa[dt][qt] * inv; u32x2 pk; pk.x = cvt_pk_bf16(o[0], o[1]); pk.y = cvt_pk_bf16(o[2], o[3]); *(u32x2*)(op + 16 * dt) = pk; }
        }
    }
}

struct RnnP { const bf16_t* GXR; const bf16_t* Wg; const float* gate_b; const float* lam; const float* conv_w; const float* conv_b; float* PE; float* CIN; bf16_t* Y; };

template <int DIR>
__device__ __forceinline__ void rnn_dir(const RnnP& P, const LAS bf16_t* xc, LAS float* hfl, LAS bf16_t* cat, int nb, int b, int cc, int w, int fr, int fq) {
    const int ch = nb * 128 + 16 * w + fr;
    bf16x8 Bf[2][4];
#pragma unroll
    for (int gt = 0; gt < 2; ++gt)
#pragma unroll
        for (int ks = 0; ks < 4; ++ks) Bf[gt][ks] = *(const bf16x8*)(P.Wg + ((size_t)((DIR * 2 + gt) * 12 + nb) * 128 + 16 * w + fr) * 128 + 32 * ks + 8 * fq);
    constexpr float LOG2E = 1.4426950408889634f;
    const float nbr = -LOG2E * P.gate_b[(DIR * 2 + 0) * DRNN + ch], nbi = -LOG2E * P.gate_b[(DIR * 2 + 1) * DRNN + ch];
    const float nlam = -P.lam[DIR * DRNN + ch];
    const float sp = nlam > 20.0f ? nlam : log1pf(expf(nlam));
    const float c_la = -8.0f * LOG2E * sp, c_x2 = -16.0f * sp;
    float hrun = 0.f, prun = 1.f;
#pragma unroll
    for (int step = 0; step < 8; ++step) {
        const int mt = DIR == 0 ? step : 7 - step;
        f32x4 zr = (f32x4){0.f, 0.f, 0.f, 0.f}, zi = zr;
#pragma unroll
        for (int ks = 0; ks < 4; ++ks) {
            const bf16x8 af = *(const LAS bf16x8*)(xc + (16 * mt + fr) * 136 + 32 * ks + 8 * fq);
            zr = __builtin_amdgcn_mfma_f32_16x16x32_bf16(af, Bf[0][ks], zr, 0, 0, 0);
            zi = __builtin_amdgcn_mfma_f32_16x16x32_bf16(af, Bf[1][ks], zi, 0, 0, 0);
        }
        f32x4 xv4, er, ei, rg, ig, av, om, bv;
#pragma unroll
        for (int j = 0; j < 4; ++j) xv4[j] = bf2f(xc[(16 * mt + 4 * fq + j) * 136 + 16 * w + fr]);
        const f32x4 tr_ = zr * (-LOG2E) + nbr, ti_ = zi * (-LOG2E) + nbi;
#pragma unroll
        for (int j = 0; j < 4; ++j) { er[j] = __builtin_amdgcn_exp2f(tr_[j]); ei[j] = __builtin_amdgcn_exp2f(ti_[j]); }
        er = er + 1.0f; ei = ei + 1.0f;
#pragma unroll
        for (int j = 0; j < 4; ++j) { rg[j] = __builtin_amdgcn_rcpf(er[j]); ig[j] = __builtin_amdgcn_rcpf(ei[j]); }
        const f32x4 la2 = rg * c_la, x2 = rg * c_x2;
#pragma unroll
        for (int j = 0; j < 4; ++j) av[j] = __builtin_amdgcn_exp2f(la2[j]);
        const f32x4 xk = __builtin_elementwise_max(x2, (f32x4){-0.1f, -0.1f, -0.1f, -0.1f});
        const f32x4 ser = -xk * (xk * 0.5f * (xk * (1.0f / 3.0f) * (xk * 0.25f * (xk * 0.2f + 1.0f) + 1.0f) + 1.0f) + 1.0f);
        const f32x4 big = 1.0f - av * av;
#pragma unroll
        for (int j = 0; j < 4; ++j) om[j] = __builtin_amdgcn_sqrtf(x2[j] > -0.1f ? ser[j] : big[j]);
        bv = om * (ig * xv4);
        float cumA[4], hl[4];
        if (DIR == 0) { cumA[0] = av[0]; hl[0] = bv[0];
#pragma unroll
            for (int j = 1; j < 4; ++j) { hl[j] = av[j] * hl[j - 1] + bv[j]; cumA[j] = av[j] * cumA[j - 1]; }
        } else { cumA[3] = av[3]; hl[3] = bv[3];
#pragma unroll
            for (int j = 2; j >= 0; --j) { hl[j] = av[j] * hl[j + 1] + bv[j]; cumA[j] = av[j] * cumA[j + 1]; }
        }
        const float PAl = DIR == 0 ? cumA[3] : cumA[0], HBl = DIR == 0 ? hl[3] : hl[0];
        float cin = hrun, mycin = 0.f, mypp = 1.f;
#pragma unroll
        for (int qq = 0; qq < 4; ++qq) {
            const int q = DIR == 0 ? qq : 3 - qq;
            const float pa = __shfl(PAl, fr + 16 * q), hb = __shfl(HBl, fr + 16 * q);
            if (q == fq) { mycin = cin; mypp = prun; }
            cin = pa * cin + hb; prun *= pa;
        }
        hrun = cin;
#pragma unroll
        for (int j = 0; j < 4; ++j) {
            const int tok = 16 * mt + 4 * fq + j;
            const float hv = hl[j] + cumA[j] * mycin;
            const unsigned cq = (unsigned)(cumA[j] * mypp * 255.0f + 0.5f);
            LAS float* hp = hfl + tok * 132 + 16 * w + fr;
            LAS bf16_t* cp = cat + tok * 136 + 16 * w + fr;
            if (DIR == 0) { *hp = hv; *cp = (bf16_t)cq; }
            else { *(LAS unsigned*)hp = cvt_pk_bf16(*hp + hv, 0.f) & 0xffffu; *cp = (bf16_t)((unsigned)*cp | (cq << 8)); }
        }
    }
    if (fq == 0) { float* Pp = P.PE + (size_t)((b * 2 + DIR) * NCHUNK + cc) * DRNN + ch; Pp[0] = prun; Pp[PE_HALF] = hrun; }
}

__device__ __forceinline__ void phase_rnn_carry(const RnnP& P) {
    const int tid = opaque_tid();
    if (tid >= 24) return;
    const int chain = blockIdx.x * 24 + tid;
    if (chain >= 2 * 2 * DRNN) return;
    const int ch = chain % DRNN, bd = chain / DRNN, dir = bd & 1;
    const float* Pp = P.PE + (size_t)(bd * NCHUNK) * DRNN + ch; const float* Ep = Pp + PE_HALF;
    float* Cp = P.CIN + (size_t)(bd * NCHUNK) * DRNN + ch;
    float h = 0.f;
#pragma unroll 1
    for (int p0 = 0; p0 < NCHUNK; p0 += 13) {
        float pv[13], ev[13];
#pragma unroll
        for (int k = 0; k < 13; ++k) { const int p = p0 + k; const int c2 = dir == 0 ? p : (p == 0 ? 1 : (p == 1 ? 0 : 131 - p)); pv[k] = Pp[(size_t)c2 * DRNN]; ev[k] = Ep[(size_t)c2 * DRNN]; }
#pragma unroll
        for (int k = 0; k < 13; ++k) { const int p = p0 + k; const int c2 = dir == 0 ? p : (p == 0 ? 1 : (p == 1 ? 0 : 131 - p)); Cp[(size_t)c2 * DRNN] = h; h = pv[k] * h + ev[k]; }
    }
}

__device__ __forceinline__ void phase_rnn(LAS unsigned char* lds, const RnnP& P, bf16_t* HS, bf16_t* CA) {
    LAS bf16_t* xc = (LAS bf16_t*)lds;
    LAS float* hfl = (LAS float*)(lds + 34816);
    LAS bf16_t* cat = (LAS bf16_t*)(lds + 102400);
    const int tid = opaque_tid(), w = tid >> 6, lane = tid & 63, fr = lane & 15, fq = lane >> 4;
    for (int item = blockIdx.x; item < 2 * NCHUNK * 12; item += gridDim.x) {
        const int nb = item % 12, c = item / 12, b = c / NCHUNK, cc = c % NCHUNK;
        const int seq0 = cc < 2 ? MX + b * CTXL : b * SEQ, seqlen = cc < 2 ? CTXL : SEQ, t0 = cc < 2 ? cc * 128 : (cc - 2) * 128;
        __syncthreads();
        {
            const int cg = tid & 15, tr = tid >> 4, ch0 = nb * 128 + 8 * cg;
            float cw[4][8], cb[8];
#pragma unroll
            for (int k = 0; k < 4; ++k) { const f32x4 a0 = *(const f32x4*)(P.conv_w + k * DRNN + ch0), a1 = *(const f32x4*)(P.conv_w + k * DRNN + ch0 + 4);
#pragma unroll
                for (int e = 0; e < 4; ++e) { cw[k][e] = a0[e]; cw[k][4 + e] = a1[e]; } }
            { const f32x4 a0 = *(const f32x4*)(P.conv_b + ch0), a1 = *(const f32x4*)(P.conv_b + ch0 + 4);
#pragma unroll
                for (int e = 0; e < 4; ++e) { cb[e] = a0[e]; cb[4 + e] = a1[e]; } }
#pragma unroll
            for (int i = 0; i < 4; ++i) {
                const int t = tr + 32 * i;
                float acc[8];
#pragma unroll
                for (int e = 0; e < 8; ++e) acc[e] = cb[e];
#pragma unroll
                for (int k = 0; k < 4; ++k) {
                    const int tt = t0 + t + k - 1;
                    if (tt >= 0 && tt < seqlen) {
                        const u32x4 v = *(const u32x4*)(P.GXR + (size_t)(seq0 + tt) * 3072 + DRNN + ch0);
                        acc[0] += bflo(v.x) * cw[k][0]; acc[1] += bfhi(v.x) * cw[k][1]; acc[2] += bflo(v.y) * cw[k][2]; acc[3] += bfhi(v.y) * cw[k][3];
                        acc[4] += bflo(v.z) * cw[k][4]; acc[5] += bfhi(v.z) * cw[k][5]; acc[6] += bflo(v.w) * cw[k][6]; acc[7] += bfhi(v.w) * cw[k][7];
                    }
                }
                u32x4 o; o.x = cvt_pk_bf16(acc[0], acc[1]); o.y = cvt_pk_bf16(acc[2], acc[3]); o.z = cvt_pk_bf16(acc[4], acc[5]); o.w = cvt_pk_bf16(acc[6], acc[7]);
                *(LAS u32x4*)(xc + t * 136 + 8 * cg) = o;
            }
        }
        __syncthreads();
        rnn_dir<0>(P, xc, hfl, cat, nb, b, cc, w, fr, fq);
        rnn_dir<1>(P, xc, hfl, cat, nb, b, cc, w, fr, fq);
        __syncthreads();
#pragma unroll
        for (int i = 0; i < 4; ++i) {
            const int cidx = tid + 512 * i, t = cidx >> 4, cg = cidx & 15;
            const size_t go = (size_t)(seq0 + t0 + t) * DRNN + nb * 128 + 8 * cg;
            const u32x4 h0 = *(const LAS u32x4*)(hfl + t * 132 + 8 * cg), h1 = *(const LAS u32x4*)(hfl + t * 132 + 8 * cg + 4);
            u32x4 o; o.x = (h0.x & 0xffffu) | (h0.y << 16); o.y = (h0.z & 0xffffu) | (h0.w << 16); o.z = (h1.x & 0xffffu) | (h1.y << 16); o.w = (h1.z & 0xffffu) | (h1.w << 16);
            *(u32x4*)(HS + go) = o;
            *(u32x4*)(CA + go) = *(const LAS u32x4*)(cat + t * 136 + 8 * cg);
        }
    }
}

__device__ __forceinline__ void phase_rnn_out(const RnnP& P, bf16_t* HS, const bf16_t* CA, bool need_ctx) {
    const int tid_ = opaque_tid(), lane = tid_ & 63, gw = blockIdx.x * 8 + (tid_ >> 6), NGW = gridDim.x * 8;
    const int nrows = need_ctx ? MT : MX;
    for (int row = gw; row < nrows; row += NGW) {
        int b, cc;
        if (row < MX) { b = row >> 14; cc = 2 + ((row & (SEQ - 1)) >> 7); } else { const int rc = row - MX; b = rc >> 8; cc = (rc & 255) >> 7; }
        const float* cf = P.CIN + (size_t)((b * 2 + 0) * NCHUNK + cc) * DRNN; const float* cbk = P.CIN + (size_t)((b * 2 + 1) * NCHUNK + cc) * DRNN;
#pragma unroll
        for (int k = 0; k < 3; ++k) {
            const int ch0 = 8 * (lane + 64 * k);
            const u32x4 hs = *(const u32x4*)(HS + (size_t)row * DRNN + ch0), ca = *(const u32x4*)(CA + (size_t)row * DRNN + ch0), gg = *(const u32x4*)(P.GXR + (size_t)row * 3072 + ch0);
            const f32x4 f0 = *(const f32x4*)(cf + ch0), f1 = *(const f32x4*)(cf + ch0 + 4), b0 = *(const f32x4*)(cbk + ch0), b1 = *(const f32x4*)(cbk + ch0 + 4);
            const unsigned hsw[4] = {hs.x, hs.y, hs.z, hs.w}, caw[4] = {ca.x, ca.y, ca.z, ca.w}, ggw[4] = {gg.x, gg.y, gg.z, gg.w};
            unsigned ow[4];
#pragma unroll
            for (int e = 0; e < 4; ++e) {
                const float cfl = e < 2 ? f0[2 * e] : f1[2 * e - 4], cfh = e < 2 ? f0[2 * e + 1] : f1[2 * e - 3];
                const float cbl = e < 2 ? b0[2 * e] : b1[2 * e - 4], cbh = e < 2 ? b0[2 * e + 1] : b1[2 * e - 3];
                const unsigned cw_ = caw[e];
                const float hl_ = bflo(hsw[e]) + (float)(cw_ & 0xffu) * (1.0f / 255.0f) * cfl + (float)((cw_ >> 8) & 0xffu) * (1.0f / 255.0f) * cbl;
                const float hh_ = bfhi(hsw[e]) + (float)((cw_ >> 16) & 0xffu) * (1.0f / 255.0f) * cfh + (float)(cw_ >> 24) * (1.0f / 255.0f) * cbh;
                const float gl = bflo(ggw[e]), gh = bfhi(ggw[e]);
                const float yl = hl_ * gl * __builtin_amdgcn_rcpf(1.0f + __builtin_amdgcn_exp2f(gl * (-2.302208198f - 0.1029432397f * gl * gl)));
                const float yh = hh_ * gh * __builtin_amdgcn_rcpf(1.0f + __builtin_amdgcn_exp2f(gh * (-2.302208198f - 0.1029432397f * gh * gh)));
                ow[e] = cvt_pk_bf16(yl, yh);
            }
            u32x4 o; o.x = ow[0]; o.y = ow[1]; o.z = ow[2]; o.w = ow[3];
            *(u32x4*)(HS + (size_t)row * DRNN + ch0) = o;
        }
    }
}

#ifndef DBL
#define DBL 0
#endif
#ifndef PHM
#define PHM 0xFFFF
#endif
enum { OP_SKIP = 0, OP_NORM, OP_GS, OP_GR, OP_GB, OP_GROPE, OP_RNN1, OP_RNN2, OP_RNN3, OP_ATT0, OP_ATT1 };

__global__ void __launch_bounds__(512, 2) fwd_megakernel(Args a) {
    extern __shared__ __attribute__((aligned(16))) unsigned char shm[];
    LAS unsigned char* lds = (LAS unsigned char*)shm;
    cg::grid_group grid = cg::this_grid();

    if (blockIdx.x == 0) { unsigned* bw = (unsigned*)(a.ws + WS_BAR); for (int e = threadIdx.x; e < XCD_BAR_WORDS; e += 512) bw[e] = 0u; }
    volatile LAS unsigned* xbst = (volatile LAS unsigned*)(lds + LDS_XB);
    if (threadIdx.x == 0) { xbst[0] = 0u; xbst[1] = 0u; xbst[2] = 0u; xbst[3] = 0u; }
#if PHM & 1
    for (int rep = 0; rep < ((DBL & 1) ? 2 : 1); ++rep) { phase_prep(a, lds); __syncthreads(); }
#endif
    grid.sync();
    const XcdBarrier xb = xcd_barrier_post((unsigned*)(a.ws + WS_BAR), xbst);
#pragma unroll 1
    for (int i = 0; i < NLAYER; ++i) {
        const int kind = i % 3, j = i / 3;
        const bool need_ctx = i < NLAYER - 1;
        const int MO = need_ctx ? MT : MX;
#pragma unroll 1
        for (int op = 0; op < 12; ++op) {
            unsigned char* ws = opaque_ptr(a.ws);
            float* xs = (float*)(ws + WS_XS);
            bf16_t* HN = (bf16_t*)(ws + WS_HN);
            bf16_t* ACT = (bf16_t*)(ws + WS_ACT);
            const float* modl = (const float*)(ws + WS_MOD) + (size_t)i * 3 * 9216;
            int type;
            switch (op) {
                case 0: case 3: case 9: type = OP_NORM; break;
                case 1: case 10: type = OP_GS; break;
                case 2: case 8: case 11: type = OP_GR; break;
                case 4: type = kind == 1 ? OP_GROPE : OP_GB; break;
                case 5: type = kind == 0 ? OP_RNN1 : (kind == 1 ? OP_ATT0 : OP_ATT1); break;
                case 6: type = kind == 0 ? OP_RNN2 : OP_SKIP; break;
                default: type = kind == 0 ? OP_RNN3 : OP_SKIP; break;
            }
            if (type == OP_SKIP) continue;
            if (type == OP_NORM) {
                const int sub = op == 0 ? 0 : (op == 3 ? 1 : 2);
#if PHM & 2
                for (int rep = 0; rep < ((DBL & 2) ? 2 : 1); ++rep) phase_norm(a, i, sub, (i == 0) && (op == 0), op == 9 ? MO : MT, !((i == 0) && (op == 0)), op == 9 ? (kind == 0 ? 6 : 4) : 11);
#endif
            } else if (type == OP_GS || type == OP_GR || type == OP_GB || type == OP_GROPE) {
                pg8::Gemm g; EpiAny E;
                E.e0.out = ACT;
                E.e1.slab = (float*)(ws + WS_SLAB); E.e1.y = (bf16_t*)(ws + WS_EXTRA); E.e1.gate = modl; E.e1.coef = 0.5f;
                E.e2.out = ACT; E.e2.ldc = 3072; E.e2.qcols = kind == 0 ? 0 : 1024; E.e2.qscale = 0.125f * 1.4426950408889634f; E.e2.vt = kind == 2 ? (bf16_t*)(ws + WS_EXTRA) : (bf16_t*)nullptr;
                E.e3.out = ACT; E.e3.rope = (const float*)(ws + WS_ROPE);
                if (type == OP_GS) {
                    const int which = op == 1 ? 0 : 1;
                    E.mode = 0; g.A = HN; g.Bt = (const bf16_t*)(ws + WS_WGU) + (size_t)(i * 2 + which) * 5632 * 1024; g.M = which == 0 ? MT : MO; g.N = 5632; g.K = 1024;
                } else if (type == OP_GR) {
                    E.mode = 1;
                    if (op == 8) {
                        g.A = HN; g.M = MO; g.N = 1024; g.K = kind == 0 ? 1536 : 1024;
                        g.Bt = kind == 0 ? (const bf16_t*)(ws + WS_WAOUT) + (size_t)j * 1024 * 1536 : (kind == 1 ? (const bf16_t*)(ws + WS_WBO) : (const bf16_t*)(ws + WS_WCO));
                        E.e1.gate = modl + (1 * 3 + 2) * 1024; E.e1.coef = 1.0f;
                    } else {
                        const int which = op == 2 ? 0 : 1;
                        g.A = ACT; g.M = which == 0 ? MT : MO; g.N = 1024; g.K = 2816;
                        g.Bt = (const bf16_t*)(ws + WS_WDN) + (size_t)(i * 2 + which) * 1024 * 2816;
                        E.e1.gate = modl + ((which == 0 ? 0 : 2) * 3 + 2) * 1024; E.e1.coef = 0.5f;
                    }
                } else if (type == OP_GB) {
                    E.mode = 2; g.A = HN; g.Bt = kind == 0 ? (const bf16_t*)(ws + WS_WAIN) + (size_t)j * 3072 * 1024 : (const bf16_t*)(ws + WS_WCQKV); g.M = MT; g.N = 3072; g.K = 1024;
                } else {
                    E.mode = 3; g.A = HN; g.Bt = (const bf16_t*)(ws + WS_WBQKV); g.M = MT; g.N = 1536; g.K = 1024;
                }
                pg8::StaticOrder S; S.init(g.M, g.N, g.K, (int)gridDim.x, (int)blockIdx.x, type == OP_GR);
#if PHM & 64
                { const int nrep = ((DBL & 64) || ((DBL & 256) && type == OP_GR) || ((DBL & 512) && type == OP_GS)) ? 2 : 1; const float coef_real = E.e1.coef;
                  for (int rep = 0; rep < nrep; ++rep) { E.e1.coef = rep == nrep - 1 ? coef_real : 0.f; pg8::gemm_phase(lds, g, S, E); } }
#endif
            } else if (type == OP_RNN1 || type == OP_RNN2 || type == OP_RNN3) {
                RnnP P{ACT, (const bf16_t*)(ws + WS_WAG) + (size_t)j * 48 * 128 * 128, a.in[I_AGATEB] + (size_t)j * 4 * DRNN, a.in[I_ALAM] + (size_t)j * 2 * DRNN,
                       a.in[I_ACONVW] + (size_t)j * 4 * DRNN, a.in[I_ACONVB] + (size_t)j * DRNN, (float*)(ws + WS_PE), (float*)(ws + WS_CIN), HN};
                if (type == OP_RNN2) phase_rnn_carry(P);
#if PHM & 4
                for (int rep = 0; rep < ((DBL & 4) ? 2 : 1); ++rep) if (type == OP_RNN1) phase_rnn(lds, P, HN, (bf16_t*)(ws + WS_EXTRA));
#endif
#if PHM & 8
                if (type == OP_RNN3) phase_rnn_out(P, HN, (const bf16_t*)(ws + WS_EXTRA), need_ctx);
#endif
            } else if (type == OP_ATT0) {
#if PHM & 16
                for (int rep = 0; rep < ((DBL & 16) ? 2 : 1); ++rep) phase_swa(lds, ACT, HN, a.in[I_BSINKS] + (size_t)j * 16, need_ctx);
#endif
            } else {
#if PHM & 32
                for (int rep = 0; rep < ((DBL & 32) ? 2 : 1); ++rep) phase_nat(lds, ACT, (const bf16_t*)(ws + WS_EXTRA), HN, a.in[I_CRPB] + (size_t)j * 16 * 465, need_ctx);
#endif
            }
            xcd_barrier(xb);
#if DBL & 128
            xcd_barrier(xb);
#endif
        }
    }
#if PHM & 2
    phase_final(a);
#endif
}

extern "C" void kernel_launch(void* const* d_in, const int* in_sizes, int n_in, void* d_out, int out_size, void* d_ws, size_t ws_size, hipStream_t stream) {
    static int grid_blocks = 0;
    if (grid_blocks == 0) {
        if (n_in != 23 || ws_size < WS_END) { fprintf(stderr, "kernel_launch: unexpected n_in %d or ws_size %zu (need %zu)\n", n_in, ws_size, (size_t)WS_END); grid_blocks = -1; return; }
        int dev = 0, cus = 0, per_cu = 0;
        (void)hipGetDevice(&dev);
        (void)hipDeviceGetAttribute(&cus, hipDeviceAttributeMultiprocessorCount, dev);
        if (hipFuncSetAttribute((const void*)fwd_megakernel, hipFuncAttributeMaxDynamicSharedMemorySize, LDS_BYTES) != hipSuccess) fprintf(stderr, "kernel_launch: hipFuncSetAttribute failed\n");
        (void)hipOccupancyMaxActiveBlocksPerMultiprocessor(&per_cu, (const void*)fwd_megakernel, 512, LDS_BYTES);
        (void)hipGetLastError();
        if (per_cu < 1) per_cu = 1;
        grid_blocks = cus * 1;
    }
    if (grid_blocks < 0) return;
    Args a{};
    for (int i = 0; i < 23; ++i) a.in[i] = (const float*)d_in[i];
    a.out = (float*)d_out; a.ws = (unsigned char*)d_ws;
    void* args[] = {&a};
    hipError_t e = hipLaunchCooperativeKernel((const void*)fwd_megakernel, dim3(grid_blocks), dim3(512), args, LDS_BYTES, stream);
    if (e != hipSuccess) fprintf(stderr, "cooperative launch failed: %s (grid %d)\n", hipGetErrorString(e), grid_blocks);
}
```

```cpp
#include <hip/hip_runtime.h>
#include <hip/hip_cooperative_groups.h>
#include <cstdio>
#include <cstdint>
namespace cg = cooperative_groups;

#define LAS __attribute__((address_space(3)))
typedef unsigned short bf16_t;
typedef short bf16x8 __attribute__((ext_vector_type(8)));
typedef short bf16x4 __attribute__((ext_vector_type(4)));
typedef float f32x4 __attribute__((ext_vector_type(4)));
typedef unsigned u32x4 __attribute__((ext_vector_type(4)));
typedef unsigned u32x2 __attribute__((ext_vector_type(2)));

constexpr int D = 1024, SEQ = 16384, CTXL = 256, MX = 32768, MCTX = 512, MT = MX + MCTX;
constexpr int DFF = 2816, DRNN = 1536, NLAYER = 4;
constexpr int NCHUNK = 130;
constexpr int LDS_XB = 137216;
constexpr int LDS_BYTES = LDS_XB + 256;

#define XCD_BAR_WORDS 3456
constexpr size_t al256(size_t x) { return (x + 255) & ~(size_t)255; }
constexpr size_t WS_WGU = 0;
constexpr size_t WS_WDN = al256(WS_WGU + (size_t)8 * 5632 * 1024 * 2);
constexpr size_t WS_WAIN = al256(WS_WDN + (size_t)8 * 1024 * 2816 * 2);
constexpr size_t WS_WAOUT = al256(WS_WAIN + (size_t)2 * 3072 * 1024 * 2);
constexpr size_t WS_WAG = al256(WS_WAOUT + (size_t)2 * 1024 * 1536 * 2);
constexpr size_t WS_WBQKV = al256(WS_WAG + (size_t)96 * 128 * 128 * 2);
constexpr size_t WS_WBO = al256(WS_WBQKV + (size_t)1536 * 1024 * 2);
constexpr size_t WS_WCQKV = al256(WS_WBO + (size_t)1024 * 1024 * 2);
constexpr size_t WS_WCO = al256(WS_WCQKV + (size_t)3072 * 1024 * 2);
constexpr size_t WS_MOD = al256(WS_WCO + (size_t)1024 * 1024 * 2);
constexpr size_t WS_ROPE = al256(WS_MOD + (size_t)4 * 3 * 9216 * 4);
constexpr size_t WS_PE = al256(WS_ROPE + (size_t)2 * 256 * 16 * 4);
constexpr size_t PE_HALF = (size_t)2 * 2 * NCHUNK * DRNN;
constexpr size_t WS_CIN = al256(WS_PE + 2 * PE_HALF * 4);
constexpr size_t WS_XS = al256(WS_CIN + PE_HALF * 4);
constexpr size_t WS_HN = al256(WS_XS + (size_t)MT * D * 4);
constexpr size_t WS_ACT = al256(WS_HN + (size_t)MT * 1536 * 2);
constexpr size_t WS_EXTRA = al256(WS_ACT + (size_t)MT * 3072 * 2);
constexpr size_t WS_SLAB = al256(WS_EXTRA + (size_t)MT * 1024 * 2);
constexpr size_t WS_BAR = al256(WS_EXTRA + (size_t)MT * 1536 * 2);
static_assert(WS_SLAB + (size_t)11 * MCTX * D * 4 <= WS_BAR, "slabs must fit in EXTRA's tail");
constexpr size_t WS_END = al256(WS_BAR + (size_t)XCD_BAR_WORDS * 4);

__device__ __forceinline__ int opaque_tid() { int t = threadIdx.x; asm volatile("" : "+v"(t)); return t; }
template <class T> __device__ __forceinline__ T* opaque_ptr(T* p) { asm volatile("" : "+s"(p)); return p; }
__device__ __forceinline__ unsigned cvt_pk_bf16(float lo, float hi) { unsigned r; asm("v_cvt_pk_bf16_f32 %0, %1, %2" : "=v"(r) : "v"(lo), "v"(hi)); return r; }
__device__ __forceinline__ float bf2f(bf16_t b) { return __uint_as_float(((unsigned)b) << 16); }
__device__ __forceinline__ float bflo(unsigned u) { return __uint_as_float(u << 16); }
__device__ __forceinline__ float bfhi(unsigned u) { return __uint_as_float(u & 0xffff0000u); }
__device__ __forceinline__ float sigmoidf_(float z) { return __builtin_amdgcn_rcpf(1.0f + __expf(-z)); }
__device__ __forceinline__ float siluf_(float z) { return z * sigmoidf_(z); }
__device__ __forceinline__ float gelu_tanh(float x) { const float u = 0.7978845608028654f * (x + 0.044715f * x * x * x); return x * sigmoidf_(2.0f * u); }
__device__ __forceinline__ float wave_sum(float v) {
#pragma unroll
    for (int o = 1; o < 64; o <<= 1) v += __shfl_xor(v, o);
    return v;
}

#define XB_TMO      128
#define XB_XCNT(j)  (256  + 64 * (j))
#define XB_XSUB(j)  (1280 + 64 * (j))
#define XB_XGEN(j)  (2304 + 64 * (j))
#define XB_TOP      3328
#define XB_TOPGEN   3392
#define XB_SPIN_CAP (1u << 20)
__device__ __forceinline__ unsigned xb_ld(unsigned* p)              { return __hip_atomic_load(p, __ATOMIC_RELAXED, __HIP_MEMORY_SCOPE_AGENT); }
__device__ __forceinline__ unsigned xb_add(unsigned* p, unsigned v) { return __hip_atomic_fetch_add(p, v, __ATOMIC_RELAXED, __HIP_MEMORY_SCOPE_AGENT); }
__device__ __forceinline__ unsigned xb_xcc_id() { return (unsigned)__builtin_amdgcn_s_getreg((3 << 11) | 20) & 0xFu; }
#define XB_SPIN(cond, bar) do { unsigned _sp = 0; while (cond) { __builtin_amdgcn_s_sleep(1); \
    if ((++_sp & 255u) == 0u) { if (xb_ld(&(bar)[XB_TMO])) break; if (_sp > XB_SPIN_CAP) { atomicAdd(&(bar)[XB_TMO], 1u); break; } } } } while (0)
struct XcdBarrier { unsigned* bar; unsigned x; volatile LAS unsigned* st; };
__device__ __forceinline__ XcdBarrier xcd_barrier_post(unsigned* bar, volatile LAS unsigned* st) {
    XcdBarrier b; b.bar = bar; b.x = xb_xcc_id(); b.st = st;
    if (threadIdx.x == 0) (void)xb_add(&bar[XB_XCNT(b.x)], 1u);
    return b;
}
__device__ __forceinline__ void xcd_barrier_complete(unsigned* bar, unsigned x, unsigned& nloc, unsigned& nx) {
    const unsigned G = gridDim.x * gridDim.y * gridDim.z;
    unsigned sum, cnt, mine, sp = 0u;
    for (;;) {
        sum = 0u; cnt = 0u; mine = 0u;
#pragma unroll
        for (unsigned j = 0; j < 16; ++j) { const unsigned c = xb_ld(&bar[XB_XCNT(j)]); sum += c; cnt += (c > 0u) ? 1u : 0u; mine = (j == x) ? c : mine; }
        if (sum == G) break;
        __builtin_amdgcn_s_sleep(1);
        if ((++sp & 255u) == 0u) { if (xb_ld(&bar[XB_TMO])) break; if (sp > XB_SPIN_CAP) { atomicAdd(&bar[XB_TMO], 1u); break; } }
    }
    nloc = mine > 0u ? mine : 1u; nx = cnt > 0u ? cnt : 1u;
}
__device__ __forceinline__ void xcd_barrier(const XcdBarrier& b) {
    asm volatile("s_waitcnt vmcnt(0)" ::: "memory");
    __syncthreads();
    if (threadIdx.x == 0) {
        unsigned* bar = b.bar;
        __builtin_amdgcn_s_waitcnt(0);
        unsigned nloc = b.st[0], nx = b.st[1];
        if (nloc == 0u) { xcd_barrier_complete(bar, b.x, nloc, nx); b.st[0] = nloc; b.st[1] = nx; }
        const unsigned old = xb_add(&bar[XB_XSUB(b.x)], 1u);
        const unsigned gen = old / nloc;
        if (old + 1u == (gen + 1u) * nloc) {
            __builtin_amdgcn_fence(__ATOMIC_RELEASE, "agent");
            asm volatile("s_waitcnt vmcnt(0)" ::: "memory");
            const unsigned og = xb_add(&bar[XB_TOP], 1u);
            const unsigned tg = og / nx;
            if (og + 1u == (tg + 1u) * nx) xb_add(&bar[XB_TOPGEN], 1u);
            else XB_SPIN(xb_ld(&bar[XB_TOPGEN]) == tg, bar);
            __builtin_amdgcn_fence(__ATOMIC_ACQUIRE, "agent");
            xb_add(&bar[XB_XGEN(b.x)], 1u);
            asm volatile("s_waitcnt vmcnt(0)" ::: "memory");
        } else {
            XB_SPIN(xb_ld(&bar[XB_XGEN(b.x)]) == gen, bar);
            __builtin_amdgcn_fence(__ATOMIC_ACQUIRE, "agent");
            asm volatile("s_waitcnt vmcnt(0)" ::: "memory");
        }
    }
    __syncthreads();
}

namespace pg8 {
constexpr int BM = 256, BK = 64, HALF = 128, HTB = HALF * BK * 2, STAGE_BYTES = 8 * HTB, NXCD = 8, WGM = 8;
__device__ __forceinline__ int lds_byte(int r, int c) { const int st = (r >> 4) * 2 + (c >> 5), rr = r & 15, cc = c & 31, ob = rr * 64 + cc * 2; return st * 1024 + (ob ^ (((ob >> 9) & 1) << 5)); }
__device__ __forceinline__ void stage_rc(int b, int& R, int& C) { const int st = b / 1024, sb = b % 1024, swz = sb ^ (((sb >> 9) & 1) << 5); R = (st >> 1) * 16 + swz / 64; C = (st & 1) * 32 + (swz % 64) / 2; }
__device__ __forceinline__ int perm32(int rho) { const int n = rho >> 4, i = rho & 15; return 8 * (i >> 2) + 4 * n + (i & 3); }
struct Unit { int pm, pn, ks, nt, at; };
struct Gemm { const bf16_t* A; const bf16_t* Bt; int M, N, K; };
struct StaticOrder {
    int nM, nN, nwg, G, c, nctx, main_nt;
    __device__ void init(int M, int N, int K, int G_, int c_, bool splitctx) {
        nN = N / BM; G = G_; c = c_; main_nt = K / BK;
        if (splitctx && M == MT) { nM = MX / BM; nctx = 2 * nN * (K / 256); } else { nM = M / BM; nctx = 0; }
        nwg = nM * nN;
    }
    __device__ bool next(int i, Unit& u) const {
        long L = (long)i * G + c;
        if (L >= nwg) {
            L -= nwg; if (L >= nctx) return false;
            const int rem = (int)L % (2 * nN);
            u.ks = (int)L / (2 * nN); u.pm = 128 + (rem & 1); u.pn = rem >> 1; u.nt = 4; u.at = 1; return true;
        }
        int wgid = (int)L; { const int q = nwg / NXCD, r = nwg % NXCD, xcd = wgid % NXCD, off = wgid / NXCD; wgid = (xcd < r ? xcd * (q + 1) : r * (q + 1) + (xcd - r) * q) + off; }
        const int nig = WGM * nN, gid = wgid / nig, fm = gid * WGM, gsz = (nM - fm) < WGM ? (nM - fm) : WGM;
        u.pm = fm + ((wgid % nig) % gsz); u.pn = (wgid % nig) / gsz; u.ks = 0; u.nt = main_nt; u.at = 0; return true;
    }
};
template <class Epi>
__device__ __forceinline__ void gemm_phase(LAS unsigned char* lds, const Gemm g, const StaticOrder& S, const Epi& E) {
    const int tid = opaque_tid(), wid = __builtin_amdgcn_readfirstlane(tid >> 6), lane = tid & 63, wr = wid >> 2, wc = wid & 3, fr = lane & 15, fq = lane >> 4;
    const int K = g.K;
    unsigned voffA[2], voffB[2];
#pragma unroll
    for (int i = 0; i < 2; ++i) { int R, C; stage_rc(tid * 16 + i * 8192, R, C); const int Rb = E.perm() ? ((R & ~31) + perm32(R & 31)) : R;
        voffA[i] = (unsigned)(R * K + C) * 2u; voffB[i] = (unsigned)(Rb * K + C) * 2u; }
    const size_t kstep = (size_t)(BK * 2);
    const size_t hstep = (size_t)HALF * K * 2;
    const size_t tstep = 2 * hstep;
    const unsigned ldsw = (unsigned)wid * 1024u;
    const int aoff = lds_byte(wr * 64 + fr, fq * 8), boff = lds_byte(wc * 32 + fr, fq * 8);
#define PG8_SA(b, h) (((b) * 2 + (h)) * HTB)
#define PG8_SB(b, h) ((4 + (b) * 2 + (h)) * HTB)
#define PG8_STAGE(bufoff, gbase, voff) do { _Pragma("unroll") for (int _i = 0; _i < 2; ++_i) \
        __builtin_amdgcn_global_load_lds((const unsigned*)((const char*)(gbase) + (voff)[_i]), (LAS unsigned*)(lds + (bufoff) + ldsw + _i * 8192), 16, 0, 0); } while (0)
#define PG8_LDA(dst, b, h) do { _Pragma("unroll") for (int m = 0; m < 4; ++m) _Pragma("unroll") for (int k = 0; k < 2; ++k) dst[m][k] = *(const LAS bf16x8*)(lds + PG8_SA(b, h) + aoff + m * 2048 + k * 1024); } while (0)
#define PG8_LDB(dst, b, h) do { _Pragma("unroll") for (int n = 0; n < 2; ++n) _Pragma("unroll") for (int k = 0; k < 2; ++k) dst[n][k] = *(const LAS bf16x8*)(lds + PG8_SB(b, h) + boff + n * 2048 + k * 1024); } while (0)
#define PG8_MMA(ai, bj, At, Bt) do { __builtin_amdgcn_s_setprio(1); _Pragma("unroll") for (int m = 0; m < 4; ++m) _Pragma("unroll") for (int n = 0; n < 2; ++n) _Pragma("unroll") for (int k = 0; k < 2; ++k) \
        acc[ai][bj][m][n] = __builtin_amdgcn_mfma_f32_16x16x32_bf16(Bt[n][k], At[m][k], acc[ai][bj][m][n], 0, 0, 0); __builtin_amdgcn_s_setprio(0); } while (0)
#define PG8_WAIT_V(n) asm volatile("s_waitcnt vmcnt(" #n ")" ::: "memory")
#define PG8_WAIT_L(n) asm volatile("s_waitcnt lgkmcnt(" #n ")" ::: "memory")
#define PG8_BAR __builtin_amdgcn_s_barrier()
#define PG8_SCHED __builtin_amdgcn_sched_barrier(0)
    Unit cur, nxt; int ui = 0;
    if (!S.next(0, cur)) return;
    f32x4 acc[2][2][4][2];
#pragma unroll
    for (int a = 0; a < 2; ++a)
#pragma unroll
        for (int b = 0; b < 2; ++b)
#pragma unroll
            for (int m = 0; m < 4; ++m)
#pragma unroll
                for (int n = 0; n < 2; ++n) acc[a][b][m][n] = (f32x4){0.f, 0.f, 0.f, 0.f};
    bf16x8 At[4][2], B0[2][2], B1[2][2];
    const char* cA = (const char*)g.A + (size_t)cur.pm * tstep + (size_t)cur.ks * 512; const char* cB = (const char*)g.Bt + (size_t)cur.pn * tstep + (size_t)cur.ks * 512;
    PG8_STAGE(PG8_SB(0, 0), cB, voffB); PG8_STAGE(PG8_SA(0, 0), cA, voffA); PG8_STAGE(PG8_SB(0, 1), cB + hstep, voffB); PG8_STAGE(PG8_SA(0, 1), cA + hstep, voffA);
    if (wr == 1) PG8_BAR;
    PG8_WAIT_V(4); PG8_BAR;
    PG8_STAGE(PG8_SB(1, 0), cB + kstep, voffB); PG8_STAGE(PG8_SA(1, 0), cA + kstep, voffA); PG8_STAGE(PG8_SB(1, 1), cB + hstep + kstep, voffB);
    PG8_WAIT_V(6); PG8_BAR;
    for (;;) {
        const bool has_next = S.next(ui + 1, nxt);
        const char* nA = has_next ? (const char*)g.A + (size_t)nxt.pm * tstep + (size_t)nxt.ks * 512 : cA; const char* nB = has_next ? (const char*)g.Bt + (size_t)nxt.pn * tstep + (size_t)nxt.ks * 512 : cB;
        const int nt = cur.nt;
        for (int t = 0; t < nt; t += 2) {
            const bool last = (t == nt - 2);
            const char* a1 = cA + (size_t)(t + 1) * kstep;
            const char* a2 = last ? nA : cA + (size_t)(t + 2) * kstep; const char* b2 = last ? nB : cB + (size_t)(t + 2) * kstep;
            const char* a3 = a2 + kstep; const char* b3 = b2 + kstep;
            PG8_LDB(B0, 0, 0); PG8_SCHED; PG8_LDA(At, 0, 0); PG8_STAGE(PG8_SA(1, 1), a1 + hstep, voffA);
            PG8_WAIT_L(8); PG8_BAR; PG8_WAIT_L(0); PG8_MMA(0, 0, At, B0); PG8_BAR; PG8_SCHED;
            PG8_LDB(B1, 0, 1); PG8_STAGE(PG8_SB(0, 0), b2, voffB);
            PG8_BAR; PG8_WAIT_L(0); PG8_MMA(0, 1, At, B1); PG8_BAR;
            PG8_LDA(At, 0, 1); PG8_STAGE(PG8_SA(0, 0), a2, voffA);
            PG8_BAR; PG8_WAIT_L(0); PG8_MMA(1, 0, At, B0); PG8_BAR; PG8_SCHED;
            PG8_STAGE(PG8_SB(0, 1), b2 + hstep, voffB);
            PG8_WAIT_V(6); PG8_BAR; PG8_MMA(1, 1, At, B1); PG8_BAR;
            PG8_LDB(B0, 1, 0); PG8_SCHED; PG8_LDA(At, 1, 0); PG8_STAGE(PG8_SA(0, 1), a2 + hstep, voffA);
            PG8_WAIT_L(8); PG8_BAR; PG8_WAIT_L(0); PG8_MMA(0, 0, At, B0); PG8_BAR; PG8_SCHED;
            PG8_LDB(B1, 1, 1); PG8_STAGE(PG8_SB(1, 0), b3, voffB);
            PG8_BAR; PG8_WAIT_L(0); PG8_MMA(0, 1, At, B1); PG8_BAR;
            PG8_LDA(At, 1, 1); PG8_STAGE(PG8_SA(1, 0), a3, voffA);
            PG8_BAR; PG8_WAIT_L(0); PG8_MMA(1, 0, At, B0); PG8_BAR; PG8_SCHED;
            PG8_STAGE(PG8_SB(1, 1), b3 + hstep, voffB);
            PG8_WAIT_V(6); PG8_BAR; PG8_MMA(1, 1, At, B1); PG8_BAR;
        }
        if (wr == 0) PG8_BAR;
        E(acc, cur, wr, wc, fr, fq);
        if (!has_next) break;
#pragma unroll
        for (int a = 0; a < 2; ++a)
#pragma unroll
            for (int b = 0; b < 2; ++b)
#pragma unroll
                for (int m = 0; m < 4; ++m)
#pragma unroll
                    for (int n = 0; n < 2; ++n) acc[a][b][m][n] = (f32x4){0.f, 0.f, 0.f, 0.f};
        cur = nxt; cA = nA; cB = nB; ++ui;
        if (wr == 1) PG8_BAR;
    }
    PG8_WAIT_V(0);
    PG8_BAR;
#undef PG8_SA
#undef PG8_SB
#undef PG8_STAGE
#undef PG8_LDA
#undef PG8_LDB
#undef PG8_MMA
#undef PG8_WAIT_V
#undef PG8_WAIT_L
#undef PG8_BAR
#undef PG8_SCHED
}
}
using pg8::Unit;
typedef f32x4 AccT[2][2][4][2];

struct EpiSwiGLU {
    static constexpr bool PERM = true;
    bf16_t* out;
    __device__ __forceinline__ void operator()(const AccT& acc, const Unit& u, int wr, int wc, int fr, int fq) const {
        const int row0 = u.pm * 256 + wr * 64 + fr, col0 = u.pn * 128 + wc * 32 + 8 * fq;
#pragma unroll
        for (int ai = 0; ai < 2; ++ai)
#pragma unroll
            for (int m = 0; m < 4; ++m) {
                const f32x4 g0 = acc[ai][0][m][0], g1 = acc[ai][0][m][1], u0 = acc[ai][1][m][0], u1 = acc[ai][1][m][1];
                u32x4 o;
                o.x = cvt_pk_bf16(siluf_(g0[0]) * u0[0], siluf_(g0[1]) * u0[1]); o.y = cvt_pk_bf16(siluf_(g0[2]) * u0[2], siluf_(g0[3]) * u0[3]);
                o.z = cvt_pk_bf16(siluf_(g1[0]) * u1[0], siluf_(g1[1]) * u1[1]); o.w = cvt_pk_bf16(siluf_(g1[2]) * u1[2], siluf_(g1[3]) * u1[3]);
                *(u32x4*)(out + (size_t)(row0 + ai * 128 + m * 16) * DFF + col0) = o;
            }
    }
};
struct EpiResid {
    static constexpr bool PERM = true;
    float* slab; bf16_t* y; const float* gate; float coef;
    __device__ __forceinline__ void operator()(const AccT& acc, const Unit& u, int wr, int wc, int fr, int fq) const {
        const int mb = (u.pm >= 128) ? 2 : (u.pm >= 64 ? 1 : 0);
        const float* gp = gate + mb * 9216;
        const int row0 = u.pm * 256 + wr * 64 + fr, col0 = u.pn * 256 + wc * 32 + 8 * fq;
        f32x4 gv[2][2];
#pragma unroll
        for (int bj = 0; bj < 2; ++bj)
#pragma unroll
            for (int n = 0; n < 2; ++n) gv[bj][n] = *(const f32x4*)(gp + col0 + bj * 128 + 4 * n) * coef;
#pragma unroll
        for (int ai = 0; ai < 2; ++ai)
#pragma unroll
            for (int m = 0; m < 4; ++m) {
                const size_t ro = (size_t)(row0 + ai * 128 + m * 16) * D + col0;
#pragma unroll
                for (int bj = 0; bj < 2; ++bj) {
                    const f32x4 v0 = gv[bj][0] * acc[ai][bj][m][0], v1 = gv[bj][1] * acc[ai][bj][m][1];
                    if (u.at) {
                        float* pf = slab + (size_t)u.ks * MCTX * D + (ro - (size_t)MX * D) + bj * 128;
                        *(f32x4*)pf = v0; *(f32x4*)(pf + 4) = v1;
                    } else {
                        u32x4 o; o.x = cvt_pk_bf16(v0[0], v0[1]); o.y = cvt_pk_bf16(v0[2], v0[3]); o.z = cvt_pk_bf16(v1[0], v1[1]); o.w = cvt_pk_bf16(v1[2], v1[3]);
                        *(u32x4*)(y + ro + bj * 128) = o;
                    }
                }
            }
    }
};
struct EpiBf16 {
    static constexpr bool PERM = true;
    bf16_t* out; int ldc; int qcols; float qscale; bf16_t* vt;
    __device__ __forceinline__ void operator()(const AccT& acc, const Unit& u, int wr, int wc, int fr, int fq) const {
        const int row0 = u.pm * 256 + wr * 64 + fr, col0 = u.pn * 256 + wc * 32 + 8 * fq;
        const float sc = (u.pn * 256 < qcols) ? qscale : 1.0f;
        if (vt != nullptr && u.pn >= 8) {
            const bool isx = u.pm < 128;
            const int bb = isx ? (u.pm >> 6) : ((u.pm - 128));
            const size_t tstride = isx ? (size_t)SEQ : (size_t)CTXL;
            bf16_t* base = vt + (isx ? (size_t)0 : (size_t)2 * 16 * 64 * SEQ) + (size_t)bb * 16 * 64 * tstride;
            const int tok0 = (isx ? ((u.pm & 63) * 256) : 0) + wr * 64 + fr;
#pragma unroll
            for (int ai = 0; ai < 2; ++ai)
#pragma unroll
                for (int m = 0; m < 4; ++m) {
                    const int tok = tok0 + ai * 128 + m * 16;
#pragma unroll
                    for (int bj = 0; bj < 2; ++bj) {
                        const int hd = col0 - 2048 + bj * 128;
                        bf16_t* p = base + (size_t)hd * tstride + tok;
                        const f32x4 v0 = acc[ai][bj][m][0], v1 = acc[ai][bj][m][1];
                        const unsigned a0 = cvt_pk_bf16(v0[0], v0[1]), a1 = cvt_pk_bf16(v0[2], v0[3]), a2 = cvt_pk_bf16(v1[0], v1[1]), a3 = cvt_pk_bf16(v1[2], v1[3]);
                        p[0 * tstride] = (bf16_t)(a0 & 0xffff); p[1 * tstride] = (bf16_t)(a0 >> 16); p[2 * tstride] = (bf16_t)(a1 & 0xffff); p[3 * tstride] = (bf16_t)(a1 >> 16);
                        p[4 * tstride] = (bf16_t)(a2 & 0xffff); p[5 * tstride] = (bf16_t)(a2 >> 16); p[6 * tstride] = (bf16_t)(a3 & 0xffff); p[7 * tstride] = (bf16_t)(a3 >> 16);
                    }
                }
            return;
        }
#pragma unroll
        for (int ai = 0; ai < 2; ++ai)
#pragma unroll
            for (int m = 0; m < 4; ++m) {
                bf16_t* rowp = out + (size_t)(row0 + ai * 128 + m * 16) * ldc + col0;
#pragma unroll
                for (int bj = 0; bj < 2; ++bj) {
                    const f32x4 v0 = acc[ai][bj][m][0] * sc, v1 = acc[ai][bj][m][1] * sc;
                    u32x4 o; o.x = cvt_pk_bf16(v0[0], v0[1]); o.y = cvt_pk_bf16(v0[2], v0[3]); o.z = cvt_pk_bf16(v1[0], v1[1]); o.w = cvt_pk_bf16(v1[2], v1[3]);
                    *(u32x4*)(rowp + bj * 128) = o;
                }
            }
    }
};
struct EpiRope {
    static constexpr bool PERM = false;
    bf16_t* out; const float* rope;
    __device__ __forceinline__ void operator()(const AccT& acc, const Unit& u, int wr, int wc, int fr, int fq) const {
        const int row0 = u.pm * 256 + wr * 64 + fr, col0 = u.pn * 256 + wc * 32 + 4 * fq;
        const bool is_q = u.pn < 4, is_v = u.pn == 5, do_rope = (!is_v) && (u.pm < 128);
        const float sc = is_q ? 0.125f * 1.4426950408889634f : 1.0f;
#pragma unroll
        for (int ai = 0; ai < 2; ++ai)
#pragma unroll
            for (int m = 0; m < 4; ++m) {
                const int row = row0 + ai * 128 + m * 16;
                const int t = row & (SEQ - 1);
                const int pos = (wc & 1) ? (t & 63) : (t >> 6);
                f32x4 cs = (f32x4){1.f, 1.f, 1.f, 1.f}, sn = (f32x4){0.f, 0.f, 0.f, 0.f};
                if (do_rope) { cs = *(const f32x4*)(rope + pos * 16 + 4 * fq); sn = *(const f32x4*)(rope + 4096 + pos * 16 + 4 * fq); }
                bf16_t* rowp = out + (size_t)row * 1536 + col0;
#pragma unroll
                for (int bj = 0; bj < 2; ++bj) {
                    const f32x4 x1 = acc[ai][bj][m][0], x2 = acc[ai][bj][m][1];
                    const f32x4 o1 = (x1 * cs - x2 * sn) * sc, o2 = (x2 * cs + x1 * sn) * sc;
                    u32x2 a, b; a.x = cvt_pk_bf16(o1[0], o1[1]); a.y = cvt_pk_bf16(o1[2], o1[3]); b.x = cvt_pk_bf16(o2[0], o2[1]); b.y = cvt_pk_bf16(o2[2], o2[3]);
                    *(u32x2*)(rowp + bj * 128) = a; *(u32x2*)(rowp + bj * 128 + 16) = b;
                }
            }
    }
};

struct EpiAny {
    int mode;
    EpiSwiGLU e0; EpiResid e1; EpiBf16 e2; EpiRope e3;
    __device__ __forceinline__ bool perm() const { return mode != 3; }
    __device__ __forceinline__ void operator()(const AccT& acc, const Unit& u, int wr, int wc, int fr, int fq) const {
        if (mode == 0) e0(acc, u, wr, wc, fr, fq);
        else if (mode == 1) e1(acc, u, wr, wc, fr, fq);
        else if (mode == 2) e2(acc, u, wr, wc, fr, fq);
        else e3(acc, u, wr, wc, fr, fq);
    }
};

struct Args {
    const float* in[23];
    float* out;
    unsigned char* ws;
};
enum { I_X = 0, I_C, I_CTX, I_CCTX, I_WADA, I_BADA, I_NORMG, I_WGU, I_WDN, I_AWIN, I_ACONVW, I_ACONVB, I_AGATEW, I_AGATEB, I_ALAM, I_AWOUT,
       I_BWQKV, I_BSINKS, I_BWO, I_CWQKV, I_CRPB, I_CWO, I_FINALG };

__device__ __forceinline__ void transpose_item(const float* W, int K, int N, bf16_t* WT, int k0, int n0, int drow0, LAS float* scr, int lane) {
    f32x4 wv[8];
#pragma unroll
    for (int i = 0; i < 8; ++i) wv[i] = __builtin_nontemporal_load((const f32x4*)(W + (size_t)(k0 + (lane >> 3) + 8 * i) * N + n0 + 4 * (lane & 7)));
#pragma unroll
    for (int i = 0; i < 8; ++i) { LAS float* sp = scr + ((lane >> 3) + 8 * i) * 33 + 4 * (lane & 7); sp[0] = wv[i][0]; sp[1] = wv[i][1]; sp[2] = wv[i][2]; sp[3] = wv[i][3]; }
    asm volatile("s_waitcnt lgkmcnt(0)" ::: "memory");
    const int c = lane & 7;
#pragma unroll
    for (int j = 0; j < 4; ++j) { const int n = (lane >> 3) + 8 * j; const LAS float* s = scr + (8 * c) * 33 + n;
        u32x4 o; o.x = cvt_pk_bf16(s[0 * 33], s[1 * 33]); o.y = cvt_pk_bf16(s[2 * 33], s[3 * 33]); o.z = cvt_pk_bf16(s[4 * 33], s[5 * 33]); o.w = cvt_pk_bf16(s[6 * 33], s[7 * 33]);
        *(u32x4*)(WT + (size_t)(drow0 + n) * K + k0 + 8 * c) = o; }
    asm volatile("s_waitcnt lgkmcnt(0)" ::: "memory");
}
__device__ __forceinline__ bool transpose_family(int& it, const float* W, int cnt, int K, int N, bf16_t* WT, bool gu, LAS float* scr, int lane) {
    const int nblk = N / 32, kblk = K / 64, per = nblk * kblk, tot = per * cnt;
    if (it >= tot) { it -= tot; return false; }
    const int mi = it / per, r = it % per, kb = r / nblk, nb = r % nblk;
    const int n0 = 32 * nb; int drow0 = n0;
    if (gu) { const int half = n0 >= DFF ? 1 : 0, nn = n0 - half * DFF; drow0 = (nn >> 7) * 256 + half * 128 + (nn & 127); }
    transpose_item(W + (size_t)mi * K * N, K, N, WT + (size_t)mi * K * N, 64 * kb, n0, drow0, scr, lane);
    return true;
}
__device__ __forceinline__ void phase_prep(const Args& a, LAS unsigned char* lds) {
    const int tid = opaque_tid(), lane = tid & 63, wave = tid >> 6;
    unsigned char* ws = a.ws;
    {
        const int idx = blockIdx.x * 512 + tid;
        if (idx < 4096) {
            const int pos = idx >> 4, j = idx & 15;
            double inv = (j & 3) == 0 ? 1.0 : ((j & 3) == 1 ? 0.5623413251903491 : ((j & 3) == 2 ? 0.31622776601683794 : 0.1778279410038923));
            const int dec = j >> 2; inv *= (dec == 0 ? 1.0 : dec == 1 ? 0.1 : dec == 2 ? 0.01 : 0.001);
            double rev = (double)pos * inv * 0.15915494309189535; rev -= floor(rev);
            float* rope = (float*)(ws + WS_ROPE);
            rope[idx] = __builtin_amdgcn_cosf((float)rev); rope[4096 + idx] = __builtin_amdgcn_sinf((float)rev);
        }
    }
    {
        LAS float* sv = (LAS float*)lds;
        LAS float* red = sv + 3 * 1024;
        for (int e = tid; e < 3 * 1024; e += 512) { const int v = e >> 10, k = e & 1023; const float cv = v < 2 ? a.in[I_C][v * 1024 + k] : a.in[I_CCTX][k]; sv[e] = siluf_(cv); }
        __syncthreads();
        float* mod = (float*)(ws + WS_MOD);
        for (int task = blockIdx.x; task < 4 * 72; task += gridDim.x) {
            const int i = task / 72, col0 = (task % 72) * 128;
            const int cg4 = tid & 31, kg = tid >> 5;
            const float* wp = a.in[I_WADA] + ((size_t)i * 1024 + kg * 64) * 9216 + col0 + 4 * cg4;
            f32x4 s0 = (f32x4){0, 0, 0, 0}, s1 = s0, s2 = s0;
#pragma unroll 8
            for (int k = 0; k < 64; ++k) { const f32x4 w = *(const f32x4*)(wp + (size_t)k * 9216); const int kk = kg * 64 + k; s0 += w * sv[kk]; s1 += w * sv[1024 + kk]; s2 += w * sv[2048 + kk]; }
#pragma unroll
            for (int e = 0; e < 4; ++e) { red[(kg * 3 + 0) * 128 + 4 * cg4 + e] = s0[e]; red[(kg * 3 + 1) * 128 + 4 * cg4 + e] = s1[e]; red[(kg * 3 + 2) * 128 + 4 * cg4 + e] = s2[e]; }
            __syncthreads();
            if (tid < 384) { const int v = tid >> 7, cc = tid & 127; float s = 0.f;
#pragma unroll
                for (int q = 0; q < 16; ++q) s += red[(q * 3 + v) * 128 + cc];
                mod[((size_t)i * 3 + v) * 9216 + col0 + cc] = s + a.in[I_BADA][(size_t)i * 9216 + col0 + cc]; }
            __syncthreads();
        }
    }
    {
        LAS float* scr = (LAS float*)(lds + wave * 8448);
        const int gw = blockIdx.x * 8 + wave, NGW = gridDim.x * 8;
        constexpr int TOT = 8 * 16 * 176 + 8 * 44 * 32 + 2 * 16 * 96 + 2 * 24 * 32 + 96 * 2 * 4 + 16 * 48 + 16 * 32 + 16 * 96 + 16 * 32;
        for (int item = gw; item < TOT; item += NGW) {
            int it = item;
            if (transpose_family(it, a.in[I_WGU], 8, 1024, 5632, (bf16_t*)(ws + WS_WGU), true, scr, lane)) continue;
            if (transpose_family(it, a.in[I_WDN], 8, 2816, 1024, (bf16_t*)(ws + WS_WDN), false, scr, lane)) continue;
            if (transpose_family(it, a.in[I_AWIN], 2, 1024, 3072, (bf16_t*)(ws + WS_WAIN), false, scr, lane)) continue;
            if (transpose_family(it, a.in[I_AWOUT], 2, 1536, 1024, (bf16_t*)(ws + WS_WAOUT), false, scr, lane)) continue;
            if (transpose_family(it, a.in[I_AGATEW], 96, 128, 128, (bf16_t*)(ws + WS_WAG), false, scr, lane)) continue;
            if (transpose_family(it, a.in[I_BWQKV], 1, 1024, 1536, (bf16_t*)(ws + WS_WBQKV), false, scr, lane)) continue;
            if (transpose_family(it, a.in[I_BWO], 1, 1024, 1024, (bf16_t*)(ws + WS_WBO), false, scr, lane)) continue;
            if (transpose_family(it, a.in[I_CWQKV], 1, 1024, 3072, (bf16_t*)(ws + WS_WCQKV), false, scr, lane)) continue;
            transpose_family(it, a.in[I_CWO], 1, 1024, 1024, (bf16_t*)(ws + WS_WCO), false, scr, lane);
        }
    }
}

__device__ __forceinline__ void phase_norm(const Args& a, int layer, int sub, bool first, int nrows, bool addy, int nsplit) {
    const int tid_ = opaque_tid(), lane = tid_ & 63, gw = blockIdx.x * 8 + (tid_ >> 6), NGW = gridDim.x * 8;
    bf16_t* xs = (bf16_t*)(a.ws + WS_XS); bf16_t* hn = (bf16_t*)(a.ws + WS_HN);
    const float* mod = (const float*)(a.ws + WS_MOD) + (size_t)layer * 3 * 9216;
    const float* ng = a.in[I_NORMG] + ((size_t)layer * 3 + sub) * 1024;
    const bf16_t* yb = (const bf16_t*)(a.ws + WS_EXTRA);
    f32x4 gv[4];
#pragma unroll
    for (int j = 0; j < 4; ++j) gv[j] = *(const f32x4*)(ng + 4 * lane + 256 * j);
    constexpr int R = 4;
    for (int r0 = gw; r0 < MX; r0 += R * NGW) {
        f32x4 v[R][4]; u32x2 xx[R][4], yy[R][4]; int rowq[R]; bool okq[R];
#pragma unroll
        for (int q = 0; q < R; ++q) {
            okq[q] = r0 + q * NGW < MX; rowq[q] = okq[q] ? r0 + q * NGW : r0;
            if (first) {
#pragma unroll
                for (int j = 0; j < 4; ++j) v[q][j] = __builtin_nontemporal_load((const f32x4*)(a.in[I_X] + (size_t)rowq[q] * D + 4 * lane + 256 * j));
            } else {
#pragma unroll
                for (int j = 0; j < 4; ++j) xx[q][j] = __builtin_nontemporal_load((const u32x2*)(xs + (size_t)rowq[q] * D + 4 * lane + 256 * j));
            }
            if (addy) {
#pragma unroll
                for (int j = 0; j < 4; ++j) yy[q][j] = __builtin_nontemporal_load((const u32x2*)(yb + (size_t)rowq[q] * D + 4 * lane + 256 * j));
            }
        }
#pragma unroll
        for (int q = 0; q < R; ++q) {
            const int row = rowq[q];
            float s = 0.f;
#pragma unroll
            for (int j = 0; j < 4; ++j) {
                if (!first) { v[q][j][0] = bflo(xx[q][j].x); v[q][j][1] = bfhi(xx[q][j].x); v[q][j][2] = bflo(xx[q][j].y); v[q][j][3] = bfhi(xx[q][j].y); }
                if (addy) { v[q][j][0] += bflo(yy[q][j].x); v[q][j][1] += bfhi(yy[q][j].x); v[q][j][2] += bflo(yy[q][j].y); v[q][j][3] += bfhi(yy[q][j].y); }
                s += (v[q][j][0] * v[q][j][0] + v[q][j][1] * v[q][j][1]) + (v[q][j][2] * v[q][j][2] + v[q][j][3] * v[q][j][3]);
            }
            if ((first || addy) && okq[q]) {
#pragma unroll
                for (int j = 0; j < 4; ++j) { u32x2 o; o.x = cvt_pk_bf16(v[q][j][0], v[q][j][1]); o.y = cvt_pk_bf16(v[q][j][2], v[q][j][3]); __builtin_nontemporal_store(o, (u32x2*)(xs + (size_t)row * D + 4 * lane + 256 * j)); }
            }
            const float rstd = rsqrtf(wave_sum(s) * (1.0f / D) + 1e-6f);
            const float* shp = mod + (row >= SEQ ? 1 : 0) * 9216 + (sub * 3 + 0) * 1024; const float* scp = shp + 1024;
            if (okq[q]) {
#pragma unroll
                for (int j = 0; j < 4; ++j) {
                    const f32x4 sh = *(const f32x4*)(shp + 4 * lane + 256 * j), sc = *(const f32x4*)(scp + 4 * lane + 256 * j);
                    const f32x4 y = v[q][j] * rstd * gv[j] * (sc + 1.0f) + sh;
                    u32x2 o; o.x = cvt_pk_bf16(y[0], y[1]); o.y = cvt_pk_bf16(y[2], y[3]);
                    __builtin_nontemporal_store(o, (u32x2*)(hn + (size_t)row * D + 4 * lane + 256 * j));
                }
            }
        }
    }
    for (int row = MX + gw; row < nrows; row += NGW) {
        f32x4 v[4]; float s = 0.f;
        if (first) {
#pragma unroll
            for (int j = 0; j < 4; ++j) v[j] = *(const f32x4*)(a.in[I_CTX] + (size_t)(row - MX) * D + 4 * lane + 256 * j);
        } else {
#pragma unroll
            for (int j = 0; j < 4; ++j) { const u32x2 x2 = *(const u32x2*)(xs + (size_t)row * D + 4 * lane + 256 * j); v[j][0] = bflo(x2.x); v[j][1] = bfhi(x2.x); v[j][2] = bflo(x2.y); v[j][3] = bfhi(x2.y); }
        }
        if (addy) {
            const float* sr = (const float*)(a.ws + WS_SLAB) + (size_t)(row - MX) * D;
#pragma unroll 1
            for (int ks = 0; ks < nsplit; ++ks) {
#pragma unroll
                for (int j = 0; j < 4; ++j) v[j] += *(const f32x4*)(sr + (size_t)ks * MCTX * D + 4 * lane + 256 * j);
            }
        }
#pragma unroll
        for (int j = 0; j < 4; ++j) s += (v[j][0] * v[j][0] + v[j][1] * v[j][1]) + (v[j][2] * v[j][2] + v[j][3] * v[j][3]);
        if (first || addy) {
#pragma unroll
            for (int j = 0; j < 4; ++j) { u32x2 o; o.x = cvt_pk_bf16(v[j][0], v[j][1]); o.y = cvt_pk_bf16(v[j][2], v[j][3]); *(u32x2*)(xs + (size_t)row * D + 4 * lane + 256 * j) = o; }
        }
        const float rstd = rsqrtf(wave_sum(s) * (1.0f / D) + 1e-6f);
        const float* shp = mod + 2 * 9216 + (sub * 3 + 0) * 1024; const float* scp = shp + 1024;
#pragma unroll
        for (int j = 0; j < 4; ++j) {
            const f32x4 sh = *(const f32x4*)(shp + 4 * lane + 256 * j), sc = *(const f32x4*)(scp + 4 * lane + 256 * j);
            const f32x4 y = v[j] * rstd * gv[j] * (sc + 1.0f) + sh;
            u32x2 o; o.x = cvt_pk_bf16(y[0], y[1]); o.y = cvt_pk_bf16(y[2], y[3]);
            *(u32x2*)(hn + (size_t)row * D + 4 * lane + 256 * j) = o;
        }
    }
}
__device__ __forceinline__ void phase_final(const Args& a) {
    const int tid_ = opaque_tid(), lane = tid_ & 63, gw = blockIdx.x * 8 + (tid_ >> 6), NGW = gridDim.x * 8;
    const bf16_t* xs = (const bf16_t*)(a.ws + WS_XS);
    const bf16_t* yb = (const bf16_t*)(a.ws + WS_EXTRA);
    f32x4 gv[4];
#pragma unroll
    for (int j = 0; j < 4; ++j) gv[j] = *(const f32x4*)(a.in[I_FINALG] + 4 * lane + 256 * j);
    constexpr int R = 4;
    for (int r0 = gw; r0 < MX; r0 += R * NGW) {
        u32x2 xx[R][4], yy[R][4]; int rowq[R]; bool okq[R];
#pragma unroll
        for (int q = 0; q < R; ++q) {
            okq[q] = r0 + q * NGW < MX; rowq[q] = okq[q] ? r0 + q * NGW : r0;
#pragma unroll
            for (int j = 0; j < 4; ++j) { xx[q][j] = *(const u32x2*)(xs + (size_t)rowq[q] * D + 4 * lane + 256 * j); yy[q][j] = *(const u32x2*)(yb + (size_t)rowq[q] * D + 4 * lane + 256 * j); }
        }
#pragma unroll
        for (int q = 0; q < R; ++q) {
            float s = 0.f; f32x4 v[4];
#pragma unroll
            for (int j = 0; j < 4; ++j) {
                v[j][0] = bflo(xx[q][j].x) + bflo(yy[q][j].x); v[j][1] = bfhi(xx[q][j].x) + bfhi(yy[q][j].x); v[j][2] = bflo(xx[q][j].y) + bflo(yy[q][j].y); v[j][3] = bfhi(xx[q][j].y) + bfhi(yy[q][j].y);
                s += (v[j][0] * v[j][0] + v[j][1] * v[j][1]) + (v[j][2] * v[j][2] + v[j][3] * v[j][3]);
            }
            const float rstd = rsqrtf(wave_sum(s) * (1.0f / D) + 1e-6f);
            if (okq[q]) {
#pragma unroll
                for (int j = 0; j < 4; ++j) *(f32x4*)(a.out + (size_t)rowq[q] * D + 4 * lane + 256 * j) = v[j] * rstd * gv[j];
            }
        }
    }
}

__device__ __forceinline__ void phase_swa(LAS unsigned char* lds, const bf16_t* QKV, bf16_t* O, const float* sinks, bool need_ctx) {
    constexpr int LDQ = 1536, KS = 72, VS = 72;
    LAS bf16_t* Ks = (LAS bf16_t*)lds;
    LAS bf16_t* Vt = Ks + 64 * KS;
    const int tid = opaque_tid(), w = tid >> 6, lane = tid & 63, fr = lane & 15, fq = lane >> 4;
    const int lrow = tid >> 3, lcg = tid & 7;
    const int n_items = 2048 + (need_ctx ? 32 : 0);
    for (int item = blockIdx.x; item < n_items; item += gridDim.x) {
        const bool cq = item >= 2048;
        int b, hp, g, jb;
        if (!cq) { hp = item & 1; g = (item >> 1) & 3; jb = (item >> 3) & 127; b = item >> 10; }
        else { const int it = item - 2048; hp = it & 1; g = (it >> 1) & 3; jb = (it >> 3) & 1; b = it >> 4; }
        const int h = 4 * g + 2 * hp + (w >> 2), qsub = (w & 3) * 32;
        const int qrow0 = cq ? (MX + b * CTXL + jb * 128 + qsub) : (b * SEQ + jb * 128 + qsub);
        const int kcol0 = 1024 + g * 64, vcol0 = 1280 + g * 64;
        bf16x8 Qf[2][2];
#pragma unroll
        for (int qt = 0; qt < 2; ++qt)
#pragma unroll
            for (int k2 = 0; k2 < 2; ++k2) Qf[qt][k2] = *(const bf16x8*)(QKV + (size_t)(qrow0 + 16 * qt + fr) * LDQ + h * 64 + 32 * k2 + 8 * fq);
        f32x4 Oa[4][2];
#pragma unroll
        for (int dt = 0; dt < 4; ++dt)
#pragma unroll
            for (int qt = 0; qt < 2; ++qt) Oa[dt][qt] = (f32x4){0.f, 0.f, 0.f, 0.f};
        float mrun[2], lrun[2];
        { const float sk = sinks[h] * 1.4426950408889634f; mrun[0] = mrun[1] = sk; lrun[0] = lrun[1] = (fq == 0) ? 1.0f : 0.0f; }
        const int ntiles = cq ? 4 : 10;
#define SWA_KPOS(t_) (jb * 128 - 128 + 64 * ((t_) - 4))
#define SWA_VALID(t_) ((t_) < 4 || (SWA_KPOS(t_) >= 0 && SWA_KPOS(t_) < SEQ))
#define SWA_KROW(t_) ((t_) < 4 ? (MX + b * CTXL + 64 * (t_)) : (b * SEQ + SWA_KPOS(t_)))
        u32x4 kreg, vreg;
        int ti = 0;
        { const size_t ro = (size_t)(SWA_KROW(0) + lrow) * LDQ + 8 * lcg; kreg = *(const u32x4*)(QKV + ro + kcol0); vreg = *(const u32x4*)(QKV + ro + vcol0); }
        while (ti < ntiles) {
            __syncthreads();
            *(LAS u32x4*)(Ks + lrow * KS + 8 * lcg) = kreg;
            { LAS bf16_t* vp = Vt + (8 * lcg) * VS + lrow;
              vp[0 * VS] = (bf16_t)(vreg.x & 0xffff); vp[1 * VS] = (bf16_t)(vreg.x >> 16); vp[2 * VS] = (bf16_t)(vreg.y & 0xffff); vp[3 * VS] = (bf16_t)(vreg.y >> 16);
              vp[4 * VS] = (bf16_t)(vreg.z & 0xffff); vp[5 * VS] = (bf16_t)(vreg.z >> 16); vp[6 * VS] = (bf16_t)(vreg.w & 0xffff); vp[7 * VS] = (bf16_t)(vreg.w >> 16); }
            __syncthreads();
            int tn = ti + 1;
            while (tn < ntiles && !SWA_VALID(tn)) ++tn;
            if (tn < ntiles) { const size_t ro = (size_t)(SWA_KROW(tn) + lrow) * LDQ + 8 * lcg; kreg = *(const u32x4*)(QKV + ro + kcol0); vreg = *(const u32x4*)(QKV + ro + vcol0); }
            const int kpos0 = SWA_KPOS(ti);
            f32x4 s[4][2];
#pragma unroll
            for (int kt = 0; kt < 4; ++kt) {
                const bf16x8 k0 = *(const LAS bf16x8*)(Ks + (16 * kt + fr) * KS + 8 * fq);
                const bf16x8 k1 = *(const LAS bf16x8*)(Ks + (16 * kt + fr) * KS + 32 + 8 * fq);
#pragma unroll
                for (int qt = 0; qt < 2; ++qt) {
                    f32x4 z = (f32x4){0.f, 0.f, 0.f, 0.f};
                    z = __builtin_amdgcn_mfma_f32_16x16x32_bf16(k0, Qf[qt][0], z, 0, 0, 0);
                    s[kt][qt] = __builtin_amdgcn_mfma_f32_16x16x32_bf16(k1, Qf[qt][1], z, 0, 0, 0);
                }
            }
            if (ti >= 4) {
#pragma unroll
                for (int qt = 0; qt < 2; ++qt) {
                    const int qpos = jb * 128 + qsub + 16 * qt + fr;
#pragma unroll
                    for (int kt = 0; kt < 4; ++kt)
#pragma unroll
                        for (int j = 0; j < 4; ++j) { const int dlt = qpos - (kpos0 + 16 * kt + 4 * fq + j); if (dlt > 128 || dlt < -128) s[kt][qt][j] = -INFINITY; }
                }
            }
            bf16x8 Pf[2][2];
#pragma unroll
            for (int qt = 0; qt < 2; ++qt) {
                float mx = -INFINITY;
#pragma unroll
                for (int kt = 0; kt < 4; ++kt)
#pragma unroll
                    for (int j = 0; j < 4; ++j) mx = fmaxf(mx, s[kt][qt][j]);
                mx = fmaxf(mx, __shfl_xor(mx, 16)); mx = fmaxf(mx, __shfl_xor(mx, 32));
                const float mnew = fmaxf(mrun[qt], mx);
                const float alpha = __builtin_amdgcn_exp2f(mrun[qt] - mnew);
                mrun[qt] = mnew;
                float ls = 0.f;
                float p[4][4];
#pragma unroll
                for (int kt = 0; kt < 4; ++kt)
#pragma unroll
                    for (int j = 0; j < 4; ++j) { p[kt][j] = __builtin_amdgcn_exp2f(s[kt][qt][j] - mnew); ls += p[kt][j]; }
                lrun[qt] = lrun[qt] * alpha + ls;
#pragma unroll
                for (int dt = 0; dt < 4; ++dt) Oa[dt][qt] = Oa[dt][qt] * alpha;
#pragma unroll
                for (int k2 = 0; k2 < 2; ++k2) {
                    u32x4 pk; pk.x = cvt_pk_bf16(p[2 * k2][0], p[2 * k2][1]); pk.y = cvt_pk_bf16(p[2 * k2][2], p[2 * k2][3]);
                    pk.z = cvt_pk_bf16(p[2 * k2 + 1][0], p[2 * k2 + 1][1]); pk.w = cvt_pk_bf16(p[2 * k2 + 1][2], p[2 * k2 + 1][3]);
                    Pf[qt][k2] = __builtin_bit_cast(bf16x8, pk);
                }
            }
#pragma unroll
            for (int dt = 0; dt < 4; ++dt)
#pragma unroll
                for (int k2 = 0; k2 < 2; ++k2) {
                    const LAS bf16_t* vp = Vt + (16 * dt + fr) * VS + 32 * k2 + 4 * fq;
                    const u32x2 v0 = *(const LAS u32x2*)vp, v1 = *(const LAS u32x2*)(vp + 16);
                    u32x4 vv; vv.x = v0.x; vv.y = v0.y; vv.z = v1.x; vv.w = v1.y;
                    const bf16x8 vf = __builtin_bit_cast(bf16x8, vv);
#pragma unroll
                    for (int qt = 0; qt < 2; ++qt) Oa[dt][qt] = __builtin_amdgcn_mfma_f32_16x16x32_bf16(vf, Pf[qt][k2], Oa[dt][qt], 0, 0, 0);
                }
            ti = tn;
        }
#undef SWA_KPOS
#undef SWA_VALID
#undef SWA_KROW
#pragma unroll
        for (int qt = 0; qt < 2; ++qt) {
            float l = lrun[qt]; l += __shfl_xor(l, 16); l += __shfl_xor(l, 32);
            const float inv = 1.0f / l;
            bf16_t* op = O + (size_t)(qrow0 + 16 * qt + fr) * D + h * 64 + 4 * fq;
#pragma unroll
            for (int dt = 0; dt < 4; ++dt) { const f32x4 o = Oa[dt][qt] * inv; u32x2 pk; pk.x = cvt_pk_bf16(o[0], o[1]); pk.y = cvt_pk_bf16(o[2], o[3]); *(u32x2*)(op + 16 * dt) = pk; }
        }
    }
}

__device__ __forceinline__ void phase_nat(LAS unsigned char* lds, const bf16_t* QKV, const bf16_t* VT, bf16_t* O, const float* rpb, bool need_ctx) {
    constexpr int LDQ = 3072, KS = 264, VS = 72;
    LAS bf16_t* Ks = (LAS bf16_t*)lds;
    LAS bf16_t* Vt = Ks + 64 * KS;
    LAS float* rp = (LAS float*)(Vt + 256 * VS);
    const int tid = opaque_tid(), w = tid >> 6, lane = tid & 63, fr = lane & 15, fq = lane >> 4;
    const bool fast = gridDim.x == 256;
    const int xcd = blockIdx.x & 7, mloc = blockIdx.x >> 3;
    const int hg = fast ? (mloc & 3) : (blockIdx.x & 3);
    const int hw = w >> 1, h = 4 * hg + hw, qsub = (w & 1) * 32;
    __syncthreads();
    for (int e = tid; e < 4 * 465; e += 512) rp[e] = rpb[(size_t)(4 * hg) * 465 + e] * 1.4426950408889634f;
    int kc0[2], relb[2]; unsigned okm = 0u;
#pragma unroll
    for (int qt = 0; qt < 2; ++qt) {
        const int c0 = qsub + 16 * qt, c = c0 + fr;
        kc0[qt] = c0 - 8 < 0 ? 0 : (c0 - 8 > 32 ? 32 : c0 - 8);
        const int cst = c - 8 < 0 ? 0 : (c - 8 > 48 ? 48 : c - 8);
        relb[qt] = kc0[qt] + 4 * fq - c + 15;
#pragma unroll
        for (int i = 0; i < 2; ++i)
#pragma unroll
            for (int j = 0; j < 4; ++j) { const int kk = kc0[qt] + 16 * i + 4 * fq + j; if (kk >= cst && kk < cst + 16) okm |= 1u << (qt * 8 + i * 4 + j); }
    }
    const int n_items = 2048 + (need_ctx ? 32 : 0);
    for (int kk = 0; ; ++kk) {
        bool cq; int b, r, rs = 0;
        if (fast) {
            if (kk < 8) { const int G = kk * 8 + xcd; cq = false; b = G >> 5; r = ((G & 31) << 3) + (mloc >> 2); }
            else if (kk == 8 && need_ctx && blockIdx.x < 32) { const int it = ((blockIdx.x & 7) << 2) | (blockIdx.x >> 3); cq = true; b = it >> 4; r = (it >> 2) & 3; }
            else break;
        } else {
            const int item = blockIdx.x + kk * gridDim.x;
            if (item >= n_items) break;
            cq = item >= 2048;
            if (!cq) { r = (item >> 2) & 255; b = item >> 10; } else { const int it = item - 2048; r = (it >> 2) & 3; b = it >> 4; }
        }
        if (!cq) rs = r - 4 < 0 ? 0 : (r - 4 > 248 ? 248 : r - 4);
        const int qrow0 = cq ? (MX + b * CTXL + r * 64 + qsub) : (b * SEQ + r * 64 + qsub);
        const int ntiles = cq ? 4 : 12;
        bf16x8 Qf[2][2];
#pragma unroll
        for (int qt = 0; qt < 2; ++qt)
#pragma unroll
            for (int k2 = 0; k2 < 2; ++k2) Qf[qt][k2] = *(const bf16x8*)(QKV + (size_t)(qrow0 + 16 * qt + fr) * LDQ + h * 64 + 32 * k2 + 8 * fq);
        f32x4 Oa[4][2];
#pragma unroll
        for (int dt = 0; dt < 4; ++dt)
#pragma unroll
            for (int qt = 0; qt < 2; ++qt) Oa[dt][qt] = (f32x4){0.f, 0.f, 0.f, 0.f};
        float mrun[2] = {-INFINITY, -INFINITY}, lrun[2] = {0.f, 0.f};
        u32x4 kreg[4], vreg[4];
        const bf16_t* vtx = VT + (size_t)(b * 16 + 4 * hg) * 64 * SEQ;
        const bf16_t* vtc = VT + (size_t)2 * 16 * 64 * SEQ + (size_t)(b * 16 + 4 * hg) * 64 * CTXL;
#define NAT_LOAD(ti_) do { const int _ti = (ti_); \
            const bool _c = _ti < 4; const int _krow0 = _c ? (MX + b * CTXL + 64 * _ti) : (b * SEQ + (rs + _ti - 4) * 64); \
            const bf16_t* _vb = _c ? vtc + 64 * _ti : vtx + (rs + _ti - 4) * 64; const size_t _vs = _c ? (size_t)CTXL : (size_t)SEQ; \
            _Pragma("unroll") for (int _i = 0; _i < 4; ++_i) { const int _cx = tid + 512 * _i; \
                kreg[_i] = *(const u32x4*)(QKV + (size_t)(_krow0 + (_cx >> 5)) * LDQ + 1024 + hg * 256 + 8 * (_cx & 31)); \
                vreg[_i] = *(const u32x4*)(_vb + (size_t)(_cx >> 3) * _vs + 8 * (_cx & 7)); } } while (0)
        NAT_LOAD(0);
#pragma unroll 1
        for (int ti = 0; ti < ntiles; ++ti) {
            __syncthreads();
#pragma unroll
            for (int i = 0; i < 4; ++i) { const int cx = tid + 512 * i;
                *(LAS u32x4*)(Ks + (cx >> 5) * KS + 8 * (cx & 31)) = kreg[i];
                *(LAS u32x4*)(Vt + (cx >> 3) * VS + 8 * (cx & 7)) = vreg[i]; }
            __syncthreads();
            if (ti + 1 < ntiles) NAT_LOAD(ti + 1);
            if (ti < 4) {
#pragma unroll
                for (int qt = 0; qt < 2; ++qt) {
                    f32x4 s[4];
#pragma unroll
                    for (int kt = 0; kt < 4; ++kt) {
                        const bf16x8 k0 = *(const LAS bf16x8*)(Ks + (16 * kt + fr) * KS + hw * 64 + 8 * fq);
                        const bf16x8 k1 = *(const LAS bf16x8*)(Ks + (16 * kt + fr) * KS + hw * 64 + 32 + 8 * fq);
                        f32x4 z = (f32x4){0.f, 0.f, 0.f, 0.f};
                        z = __builtin_amdgcn_mfma_f32_16x16x32_bf16(k0, Qf[qt][0], z, 0, 0, 0);
                        s[kt] = __builtin_amdgcn_mfma_f32_16x16x32_bf16(k1, Qf[qt][1], z, 0, 0, 0);
                    }
                    float mx = -INFINITY;
#pragma unroll
                    for (int kt = 0; kt < 4; ++kt)
#pragma unroll
                        for (int j = 0; j < 4; ++j) mx = fmaxf(mx, s[kt][j]);
                    mx = fmaxf(mx, __shfl_xor(mx, 16)); mx = fmaxf(mx, __shfl_xor(mx, 32));
                    const float mnew = fmaxf(mrun[qt], mx), alpha = __builtin_amdgcn_exp2f(mrun[qt] - mnew);
                    mrun[qt] = mnew;
                    float ls = 0.f;
#pragma unroll
                    for (int kt = 0; kt < 4; ++kt)
#pragma unroll
                        for (int j = 0; j < 4; ++j) { s[kt][j] = __builtin_amdgcn_exp2f(s[kt][j] - mnew); ls += s[kt][j]; }
                    lrun[qt] = lrun[qt] * alpha + ls;
#pragma unroll
                    for (int dt = 0; dt < 4; ++dt) Oa[dt][qt] = Oa[dt][qt] * alpha;
#pragma unroll
                    for (int k2 = 0; k2 < 2; ++k2) {
                        u32x4 pk; pk.x = cvt_pk_bf16(s[2 * k2][0], s[2 * k2][1]); pk.y = cvt_pk_bf16(s[2 * k2][2], s[2 * k2][3]);
                        pk.z = cvt_pk_bf16(s[2 * k2 + 1][0], s[2 * k2 + 1][1]); pk.w = cvt_pk_bf16(s[2 * k2 + 1][2], s[2 * k2 + 1][3]);
                        const bf16x8 pf = __builtin_bit_cast(bf16x8, pk);
#pragma unroll
                        for (int dt = 0; dt < 4; ++dt) {
                            const LAS bf16_t* vp = Vt + (hw * 64 + 16 * dt + fr) * VS + 32 * k2 + 4 * fq;
                            const u32x2 v0 = *(const LAS u32x2*)vp, v1 = *(const LAS u32x2*)(vp + 16);
                            u32x4 vv; vv.x = v0.x; vv.y = v0.y; vv.z = v1.x; vv.w = v1.y;
                            Oa[dt][qt] = __builtin_amdgcn_mfma_f32_16x16x32_bf16(__builtin_bit_cast(bf16x8, vv), pf, Oa[dt][qt], 0, 0, 0);
                        }
                    }
                }
            } else {
                const LAS float* rrow = rp + hw * 465 + ((rs + ti - 4) - r + 7) * 31;
#pragma unroll
                for (int qt = 0; qt < 2; ++qt) {
                    f32x4 s[2];
#pragma unroll
                    for (int i = 0; i < 2; ++i) {
                        const LAS bf16_t* kp = Ks + (kc0[qt] + 16 * i + fr) * KS + hw * 64 + 8 * fq;
                        f32x4 z = (f32x4){0.f, 0.f, 0.f, 0.f};
                        z = __builtin_amdgcn_mfma_f32_16x16x32_bf16(*(const LAS bf16x8*)kp, Qf[qt][0], z, 0, 0, 0);
                        s[i] = __builtin_amdgcn_mfma_f32_16x16x32_bf16(*(const LAS bf16x8*)(kp + 32), Qf[qt][1], z, 0, 0, 0);
                    }
                    const LAS float* bp = rrow + relb[qt];
                    float mx = -INFINITY;
#pragma unroll
                    for (int i = 0; i < 2; ++i)
#pragma unroll
                        for (int j = 0; j < 4; ++j) { const bool ok = (okm >> (qt * 8 + i * 4 + j)) & 1u; const float bv = bp[16 * i + j];
                            s[i][j] = ok ? s[i][j] + bv : -INFINITY; mx = fmaxf(mx, s[i][j]); }
                    mx = fmaxf(mx, __shfl_xor(mx, 16)); mx = fmaxf(mx, __shfl_xor(mx, 32));
                    const float mnew = fmaxf(mrun[qt], mx), alpha = __builtin_amdgcn_exp2f(mrun[qt] - mnew);
                    mrun[qt] = mnew;
                    float ls = 0.f;
#pragma unroll
                    for (int i = 0; i < 2; ++i)
#pragma unroll
                        for (int j = 0; j < 4; ++j) { s[i][j] = __builtin_amdgcn_exp2f(s[i][j] - mnew); ls += s[i][j]; }
                    lrun[qt] = lrun[qt] * alpha + ls;
                    u32x4 pk; pk.x = cvt_pk_bf16(s[0][0], s[0][1]); pk.y = cvt_pk_bf16(s[0][2], s[0][3]); pk.z = cvt_pk_bf16(s[1][0], s[1][1]); pk.w = cvt_pk_bf16(s[1][2], s[1][3]);
                    const bf16x8 pf = __builtin_bit_cast(bf16x8, pk);
#pragma unroll
                    for (int dt = 0; dt < 4; ++dt) {
                        const LAS bf16_t* vp = Vt + (hw * 64 + 16 * dt + fr) * VS + kc0[qt] + 4 * fq;
                        const u32x2 v0 = *(const LAS u32x2*)vp, v1 = *(const LAS u32x2*)(vp + 16);
                        u32x4 vv; vv.x = v0.x; vv.y = v0.y; vv.z = v1.x; vv.w = v1.y;
                        Oa[dt][qt] = __builtin_amdgcn_mfma_f32_16x16x32_bf16(__builtin_bit_cast(bf16x8, vv), pf, Oa[dt][qt] * alpha, 0, 0, 0);
                    }
                }
            }
        }
#undef NAT_LOAD
#pragma unroll
        for (int qt = 0; qt < 2; ++qt) {
            float l = lrun[qt]; l += __shfl_xor(l, 16); l += __shfl_xor(l, 32);
            const float inv = 1.0f / l;
            bf16_t* op = O + (size_t)(qrow0 + 16 * qt + fr) * D + h * 64 + 4 * fq;
#pragma unroll
            for (int dt = 0; dt < 4; ++dt) { const f32x4 o = Oa[dt][qt] * inv; u32x2 pk; pk.x = cvt_pk_bf16(o[0], o[1]); pk.y = cvt_pk_bf16(o[2], o[3]); *(u32x2*)(op + 16 * dt) = pk; }
        }
    }
}

struct RnnP { const bf16_t* GXR; const bf16_t* Wg; const float* gate_b; const float* lam; const float* conv_w; const float* conv_b; float* PE; float* CIN; bf16_t* Y; };

template <int DIR>
__device__ __forceinline__ void rnn_dir(const RnnP& P, const LAS bf16_t* xc, LAS float* hfl, LAS bf16_t* cat, int nb, int b, int cc, int w, int fr, int fq) {
    const int ch = nb * 128 + 16 * w + fr;
    bf16x8 Bf[2][4];
#pragma unroll
    for (int gt = 0; gt < 2; ++gt)
#pragma unroll
        for (int ks = 0; ks < 4; ++ks) Bf[gt][ks] = *(const bf16x8*)(P.Wg + ((size_t)((DIR * 2 + gt) * 12 + nb) * 128 + 16 * w + fr) * 128 + 32 * ks + 8 * fq);
    constexpr float LOG2E = 1.4426950408889634f;
    const float nbr = -LOG2E * P.gate_b[(DIR * 2 + 0) * DRNN + ch], nbi = -LOG2E * P.gate_b[(DIR * 2 + 1) * DRNN + ch];
    const float nlam = -P.lam[DIR * DRNN + ch];
    const float sp = nlam > 20.0f ? nlam : log1pf(expf(nlam));
    const float c_la = -8.0f * LOG2E * sp, c_x2 = -16.0f * sp;
    float hrun = 0.f, prun = 1.f;
#pragma unroll
    for (int step = 0; step < 8; ++step) {
        const int mt = DIR == 0 ? step : 7 - step;
        f32x4 zr = (f32x4){0.f, 0.f, 0.f, 0.f}, zi = zr;
#pragma unroll
        for (int ks = 0; ks < 4; ++ks) {
            const bf16x8 af = *(const LAS bf16x8*)(xc + (16 * mt + fr) * 136 + 32 * ks + 8 * fq);
            zr = __builtin_amdgcn_mfma_f32_16x16x32_bf16(af, Bf[0][ks], zr, 0, 0, 0);
            zi = __builtin_amdgcn_mfma_f32_16x16x32_bf16(af, Bf[1][ks], zi, 0, 0, 0);
        }
        f32x4 xv4, er, ei, rg, ig, av, om, bv;
#pragma unroll
        for (int j = 0; j < 4; ++j) xv4[j] = bf2f(xc[(16 * mt + 4 * fq + j) * 136 + 16 * w + fr]);
        const f32x4 tr_ = zr * (-LOG2E) + nbr, ti_ = zi * (-LOG2E) + nbi;
#pragma unroll
        for (int j = 0; j < 4; ++j) { er[j] = __builtin_amdgcn_exp2f(tr_[j]); ei[j] = __builtin_amdgcn_exp2f(ti_[j]); }
        er = er + 1.0f; ei = ei + 1.0f;
#pragma unroll
        for (int j = 0; j < 4; ++j) { rg[j] = __builtin_amdgcn_rcpf(er[j]); ig[j] = __builtin_amdgcn_rcpf(ei[j]); }
        const f32x4 la2 = rg * c_la, x2 = rg * c_x2;
#pragma unroll
        for (int j = 0; j < 4; ++j) av[j] = __builtin_amdgcn_exp2f(la2[j]);
        const f32x4 xk = __builtin_elementwise_max(x2, (f32x4){-0.1f, -0.1f, -0.1f, -0.1f});
        const f32x4 ser = -xk * (xk * 0.5f * (xk * (1.0f / 3.0f) * (xk * 0.25f * (xk * 0.2f + 1.0f) + 1.0f) + 1.0f) + 1.0f);
        const f32x4 big = 1.0f - av * av;
        const f32x4 omv = (x2 > -0.1f) ? ser : big;
#pragma unroll
        for (int j = 0; j < 4; ++j) om[j] = __builtin_amdgcn_sqrtf(omv[j]);
        bv = om * (ig * xv4);
        float cumA[4], hl[4];
        if (DIR == 0) { cumA[0] = av[0]; hl[0] = bv[0];
#pragma unroll
            for (int j = 1; j < 4; ++j) { hl[j] = av[j] * hl[j - 1] + bv[j]; cumA[j] = av[j] * cumA[j - 1]; }
        } else { cumA[3] = av[3]; hl[3] = bv[3];
#pragma unroll
            for (int j = 2; j >= 0; --j) { hl[j] = av[j] * hl[j + 1] + bv[j]; cumA[j] = av[j] * cumA[j + 1]; }
        }
        const float PAl = DIR == 0 ? cumA[3] : cumA[0], HBl = DIR == 0 ? hl[3] : hl[0];
        float cin = hrun, mycin = 0.f, mypp = 1.f;
#pragma unroll
        for (int qq = 0; qq < 4; ++qq) {
            const int q = DIR == 0 ? qq : 3 - qq;
            const float pa = __shfl(PAl, fr + 16 * q), hb = __shfl(HBl, fr + 16 * q);
            if (q == fq) { mycin = cin; mypp = prun; }
            cin = pa * cin + hb; prun *= pa;
        }
        hrun = cin;
#pragma unroll
        for (int j = 0; j < 4; ++j) {
            const int tok = 16 * mt + 4 * fq + j;
            const float hv = hl[j] + cumA[j] * mycin;
            const unsigned cq = (unsigned)(cumA[j] * mypp * 255.0f + 0.5f);
            LAS float* hp = hfl + tok * 132 + 16 * w + fr;
            LAS bf16_t* cp = cat + tok * 136 + 16 * w + fr;
            if (DIR == 0) { *hp = hv; *cp = (bf16_t)cq; }
            else { *(LAS unsigned*)hp = cvt_pk_bf16(*hp + hv, 0.f) & 0xffffu; *cp = (bf16_t)((unsigned)*cp | (cq << 8)); }
        }
    }
    if (fq == 0) { float* Pp = P.PE + (size_t)((b * 2 + DIR) * NCHUNK + cc) * DRNN + ch; Pp[0] = prun; Pp[PE_HALF] = hrun; }
}

__device__ __forceinline__ void phase_rnn_carry(const RnnP& P) {
    const int tid = opaque_tid();
    if (tid >= 24) return;
    const int chain = blockIdx.x * 24 + tid;
    if (chain >= 2 * 2 * DRNN) return;
    const int ch = chain % DRNN, bd = chain / DRNN, dir = bd & 1;
    const float* Pp = P.PE + (size_t)(bd * NCHUNK) * DRNN + ch; const float* Ep = Pp + PE_HALF;
    float* Cp = P.CIN + (size_t)(bd * NCHUNK) * DRNN + ch;
    float h = 0.f;
#pragma unroll 1
    for (int p0 = 0; p0 < NCHUNK; p0 += 13) {
        float pv[13], ev[13];
#pragma unroll
        for (int k = 0; k < 13; ++k) { const int p = p0 + k; const int c2 = dir == 0 ? p : (p == 0 ? 1 : (p == 1 ? 0 : 131 - p)); pv[k] = Pp[(size_t)c2 * DRNN]; ev[k] = Ep[(size_t)c2 * DRNN]; }
#pragma unroll
        for (int k = 0; k < 13; ++k) { const int p = p0 + k; const int c2 = dir == 0 ? p : (p == 0 ? 1 : (p == 1 ? 0 : 131 - p)); Cp[(size_t)c2 * DRNN] = h; h = pv[k] * h + ev[k]; }
    }
}

__device__ __forceinline__ void phase_rnn(LAS unsigned char* lds, const RnnP& P, bf16_t* HS, bf16_t* CA) {
    LAS bf16_t* xc = (LAS bf16_t*)lds;
    LAS float* hfl = (LAS float*)(lds + 34816);
    LAS bf16_t* cat = (LAS bf16_t*)(lds + 102400);
    const int tid = opaque_tid(), w = tid >> 6, lane = tid & 63, fr = lane & 15, fq = lane >> 4;
    const int cg = tid & 15, tr = tid >> 4;
    u32x4 nx[7];
#define RNN_FETCH(item_) do { const int _it = (item_); const int _nb = _it % 12, _c = _it / 12, _b = _c / NCHUNK, _cc = _c % NCHUNK; \
        const int _seq0 = _cc < 2 ? MX + _b * CTXL : _b * SEQ, _len = _cc < 2 ? CTXL : SEQ, _t0 = _cc < 2 ? _cc * 128 : (_cc - 2) * 128; \
        _Pragma("unroll") for (int _r = 0; _r < 7; ++_r) { const int _tt = _t0 + 4 * tr + _r - 1; \
            nx[_r] = (_tt >= 0 && _tt < _len) ? *(const u32x4*)(P.GXR + (size_t)(_seq0 + _tt) * 3072 + DRNN + _nb * 128 + 8 * cg) : (u32x4){0u, 0u, 0u, 0u}; } } while (0)
    if ((int)blockIdx.x < 2 * NCHUNK * 12) RNN_FETCH((int)blockIdx.x);
    for (int item = blockIdx.x; item < 2 * NCHUNK * 12; item += gridDim.x) {
        const int nb = item % 12, c = item / 12, b = c / NCHUNK, cc = c % NCHUNK;
        const int seq0 = cc < 2 ? MX + b * CTXL : b * SEQ, t0 = cc < 2 ? cc * 128 : (cc - 2) * 128;
        __syncthreads();
        {
            const int ch0 = nb * 128 + 8 * cg;
            float cw[4][8], cb[8];
#pragma unroll
            for (int k = 0; k < 4; ++k) { const f32x4 a0 = *(const f32x4*)(P.conv_w + k * DRNN + ch0), a1 = *(const f32x4*)(P.conv_w + k * DRNN + ch0 + 4);
#pragma unroll
                for (int e = 0; e < 4; ++e) { cw[k][e] = a0[e]; cw[k][4 + e] = a1[e]; } }
            { const f32x4 a0 = *(const f32x4*)(P.conv_b + ch0), a1 = *(const f32x4*)(P.conv_b + ch0 + 4);
#pragma unroll
                for (int e = 0; e < 4; ++e) { cb[e] = a0[e]; cb[4 + e] = a1[e]; } }
#pragma unroll
            for (int q = 0; q < 4; ++q) {
                float acc[8];
#pragma unroll
                for (int e = 0; e < 8; ++e) acc[e] = cb[e];
#pragma unroll
                for (int k = 0; k < 4; ++k) {
                    const u32x4 v = nx[q + k];
                    acc[0] += bflo(v.x) * cw[k][0]; acc[1] += bfhi(v.x) * cw[k][1]; acc[2] += bflo(v.y) * cw[k][2]; acc[3] += bfhi(v.y) * cw[k][3];
                    acc[4] += bflo(v.z) * cw[k][4]; acc[5] += bfhi(v.z) * cw[k][5]; acc[6] += bflo(v.w) * cw[k][6]; acc[7] += bfhi(v.w) * cw[k][7];
                }
                u32x4 o; o.x = cvt_pk_bf16(acc[0], acc[1]); o.y = cvt_pk_bf16(acc[2], acc[3]); o.z = cvt_pk_bf16(acc[4], acc[5]); o.w = cvt_pk_bf16(acc[6], acc[7]);
                *(LAS u32x4*)(xc + (4 * tr + q) * 136 + 8 * cg) = o;
            }
        }
        __syncthreads();
        if (item + (int)gridDim.x < 2 * NCHUNK * 12) RNN_FETCH(item + (int)gridDim.x);
        rnn_dir<0>(P, xc, hfl, cat, nb, b, cc, w, fr, fq);
        rnn_dir<1>(P, xc, hfl, cat, nb, b, cc, w, fr, fq);
        __syncthreads();
#pragma unroll
        for (int i = 0; i < 4; ++i) {
            const int cidx = tid + 512 * i, t = cidx >> 4, cg = cidx & 15;
            const size_t go = (size_t)(seq0 + t0 + t) * DRNN + nb * 128 + 8 * cg;
            const u32x4 h0 = *(const LAS u32x4*)(hfl + t * 132 + 8 * cg), h1 = *(const LAS u32x4*)(hfl + t * 132 + 8 * cg + 4);
            u32x4 o; o.x = (h0.x & 0xffffu) | (h0.y << 16); o.y = (h0.z & 0xffffu) | (h0.w << 16); o.z = (h1.x & 0xffffu) | (h1.y << 16); o.w = (h1.z & 0xffffu) | (h1.w << 16);
            *(u32x4*)(HS + go) = o;
            *(u32x4*)(CA + go) = *(const LAS u32x4*)(cat + t * 136 + 8 * cg);
        }
    }
}

#undef RNN_FETCH
__device__ __forceinline__ void phase_rnn_out(const RnnP& P, bf16_t* HS, const bf16_t* CA, bool need_ctx) {
    const int tid_ = opaque_tid(), lane = tid_ & 63, gw = blockIdx.x * 8 + (tid_ >> 6), NGW = gridDim.x * 8;
    const int nrows = need_ctx ? MT : MX;
    for (int row = gw; row < nrows; row += NGW) {
        int b, cc;
        if (row < MX) { b = row >> 14; cc = 2 + ((row & (SEQ - 1)) >> 7); } else { const int rc = row - MX; b = rc >> 8; cc = (rc & 255) >> 7; }
        const float* cf = P.CIN + (size_t)((b * 2 + 0) * NCHUNK + cc) * DRNN; const float* cbk = P.CIN + (size_t)((b * 2 + 1) * NCHUNK + cc) * DRNN;
#pragma unroll
        for (int k = 0; k < 3; ++k) {
            const int ch0 = 8 * (lane + 64 * k);
            const u32x4 hs = *(const u32x4*)(HS + (size_t)row * DRNN + ch0), ca = *(const u32x4*)(CA + (size_t)row * DRNN + ch0), gg = *(const u32x4*)(P.GXR + (size_t)row * 3072 + ch0);
            const f32x4 f0 = *(const f32x4*)(cf + ch0), f1 = *(const f32x4*)(cf + ch0 + 4), b0 = *(const f32x4*)(cbk + ch0), b1 = *(const f32x4*)(cbk + ch0 + 4);
            const unsigned hsw[4] = {hs.x, hs.y, hs.z, hs.w}, caw[4] = {ca.x, ca.y, ca.z, ca.w}, ggw[4] = {gg.x, gg.y, gg.z, gg.w};
            unsigned ow[4];
#pragma unroll
            for (int e = 0; e < 4; ++e) {
                const float cfl = e < 2 ? f0[2 * e] : f1[2 * e - 4], cfh = e < 2 ? f0[2 * e + 1] : f1[2 * e - 3];
                const float cbl = e < 2 ? b0[2 * e] : b1[2 * e - 4], cbh = e < 2 ? b0[2 * e + 1] : b1[2 * e - 3];
                const unsigned cw_ = caw[e];
                const float hl_ = bflo(hsw[e]) + (float)(cw_ & 0xffu) * (1.0f / 255.0f) * cfl + (float)((cw_ >> 8) & 0xffu) * (1.0f / 255.0f) * cbl;
                const float hh_ = bfhi(hsw[e]) + (float)((cw_ >> 16) & 0xffu) * (1.0f / 255.0f) * cfh + (float)(cw_ >> 24) * (1.0f / 255.0f) * cbh;
                const float gl = bflo(ggw[e]), gh = bfhi(ggw[e]);
                const float yl = hl_ * gl * __builtin_amdgcn_rcpf(1.0f + __builtin_amdgcn_exp2f(gl * (-2.302208198f - 0.1029432397f * gl * gl)));
                const float yh = hh_ * gh * __builtin_amdgcn_rcpf(1.0f + __builtin_amdgcn_exp2f(gh * (-2.302208198f - 0.1029432397f * gh * gh)));
                ow[e] = cvt_pk_bf16(yl, yh);
            }
            u32x4 o; o.x = ow[0]; o.y = ow[1]; o.z = ow[2]; o.w = ow[3];
            *(u32x4*)(HS + (size_t)row * DRNN + ch0) = o;
        }
    }
}

#ifndef DBL
#define DBL 0
#endif
#ifndef PHM
#define PHM 0xFFFF
#endif
enum { OP_SKIP = 0, OP_NORM, OP_GS, OP_GR, OP_GB, OP_GROPE, OP_RNN1, OP_RNN2, OP_RNN3, OP_ATT0, OP_ATT1 };

__global__ void __launch_bounds__(512, 2) fwd_megakernel(Args a) {
    extern __shared__ __attribute__((aligned(16))) unsigned char shm[];
    LAS unsigned char* lds = (LAS unsigned char*)shm;
    cg::grid_group grid = cg::this_grid();

    if (blockIdx.x == 0) { unsigned* bw = (unsigned*)(a.ws + WS_BAR); for (int e = threadIdx.x; e < XCD_BAR_WORDS; e += 512) bw[e] = 0u; }
    volatile LAS unsigned* xbst = (volatile LAS unsigned*)(lds + LDS_XB);
    if (threadIdx.x == 0) { xbst[0] = 0u; xbst[1] = 0u; xbst[2] = 0u; xbst[3] = 0u; }
#if PHM & 1
    for (int rep = 0; rep < ((DBL & 1) ? 2 : 1); ++rep) { phase_prep(a, lds); __syncthreads(); }
#endif
    grid.sync();
    const XcdBarrier xb = xcd_barrier_post((unsigned*)(a.ws + WS_BAR), xbst);
#pragma unroll 1
    for (int i = 0; i < NLAYER; ++i) {
        const int kind = i % 3, j = i / 3;
        const bool need_ctx = i < NLAYER - 1;
        const int MO = need_ctx ? MT : MX;
#pragma unroll 1
        for (int op = 0; op < 12; ++op) {
            unsigned char* ws = opaque_ptr(a.ws);
            float* xs = (float*)(ws + WS_XS);
            bf16_t* HN = (bf16_t*)(ws + WS_HN);
            bf16_t* ACT = (bf16_t*)(ws + WS_ACT);
            const float* modl = (const float*)(ws + WS_MOD) + (size_t)i * 3 * 9216;
            int type;
            switch (op) {
                case 0: case 3: case 9: type = OP_NORM; break;
                case 1: case 10: type = OP_GS; break;
                case 2: case 8: case 11: type = OP_GR; break;
                case 4: type = kind == 1 ? OP_GROPE : OP_GB; break;
                case 5: type = kind == 0 ? OP_RNN1 : (kind == 1 ? OP_ATT0 : OP_ATT1); break;
                case 6: type = kind == 0 ? OP_RNN2 : OP_SKIP; break;
                default: type = kind == 0 ? OP_RNN3 : OP_SKIP; break;
            }
            if (type == OP_SKIP) continue;
            if (type == OP_NORM) {
                const int sub = op == 0 ? 0 : (op == 3 ? 1 : 2);
#if PHM & 2
                for (int rep = 0; rep < ((DBL & 2) ? 2 : 1); ++rep) phase_norm(a, i, sub, (i == 0) && (op == 0), op == 9 ? MO : MT, !((i == 0) && (op == 0)), op == 9 ? (kind == 0 ? 6 : 4) : 11);
#endif
            } else if (type == OP_GS || type == OP_GR || type == OP_GB || type == OP_GROPE) {
                pg8::Gemm g; EpiAny E;
                E.e0.out = ACT;
                E.e1.slab = (float*)(ws + WS_SLAB); E.e1.y = (bf16_t*)(ws + WS_EXTRA); E.e1.gate = modl; E.e1.coef = 0.5f;
                E.e2.out = ACT; E.e2.ldc = 3072; E.e2.qcols = kind == 0 ? 0 : 1024; E.e2.qscale = 0.125f * 1.4426950408889634f; E.e2.vt = kind == 2 ? (bf16_t*)(ws + WS_EXTRA) : (bf16_t*)nullptr;
                E.e3.out = ACT; E.e3.rope = (const float*)(ws + WS_ROPE);
                if (type == OP_GS) {
                    const int which = op == 1 ? 0 : 1;
                    E.mode = 0; g.A = HN; g.Bt = (const bf16_t*)(ws + WS_WGU) + (size_t)(i * 2 + which) * 5632 * 1024; g.M = which == 0 ? MT : MO; g.N = 5632; g.K = 1024;
                } else if (type == OP_GR) {
                    E.mode = 1;
                    if (op == 8) {
                        g.A = HN; g.M = MO; g.N = 1024; g.K = kind == 0 ? 1536 : 1024;
                        g.Bt = kind == 0 ? (const bf16_t*)(ws + WS_WAOUT) + (size_t)j * 1024 * 1536 : (kind == 1 ? (const bf16_t*)(ws + WS_WBO) : (const bf16_t*)(ws + WS_WCO));
                        E.e1.gate = modl + (1 * 3 + 2) * 1024; E.e1.coef = 1.0f;
                    } else {
                        const int which = op == 2 ? 0 : 1;
                        g.A = ACT; g.M = which == 0 ? MT : MO; g.N = 1024; g.K = 2816;
                        g.Bt = (const bf16_t*)(ws + WS_WDN) + (size_t)(i * 2 + which) * 1024 * 2816;
                        E.e1.gate = modl + ((which == 0 ? 0 : 2) * 3 + 2) * 1024; E.e1.coef = 0.5f;
                    }
                } else if (type == OP_GB) {
                    E.mode = 2; g.A = HN; g.Bt = kind == 0 ? (const bf16_t*)(ws + WS_WAIN) + (size_t)j * 3072 * 1024 : (const bf16_t*)(ws + WS_WCQKV); g.M = MT; g.N = 3072; g.K = 1024;
                } else {
                    E.mode = 3; g.A = HN; g.Bt = (const bf16_t*)(ws + WS_WBQKV); g.M = MT; g.N = 1536; g.K = 1024;
                }
                pg8::StaticOrder S; S.init(g.M, g.N, g.K, (int)gridDim.x, (int)blockIdx.x, type == OP_GR);
#if PHM & 64
                { const int nrep = ((DBL & 64) || ((DBL & 256) && type == OP_GR) || ((DBL & 512) && type == OP_GS)) ? 2 : 1; const float coef_real = E.e1.coef;
                  for (int rep = 0; rep < nrep; ++rep) { E.e1.coef = rep == nrep - 1 ? coef_real : 0.f; pg8::gemm_phase(lds, g, S, E); } }
#endif
            } else if (type == OP_RNN1 || type == OP_RNN2 || type == OP_RNN3) {
                RnnP P{ACT, (const bf16_t*)(ws + WS_WAG) + (size_t)j * 48 * 128 * 128, a.in[I_AGATEB] + (size_t)j * 4 * DRNN, a.in[I_ALAM] + (size_t)j * 2 * DRNN,
                       a.in[I_ACONVW] + (size_t)j * 4 * DRNN, a.in[I_ACONVB] + (size_t)j * DRNN, (float*)(ws + WS_PE), (float*)(ws + WS_CIN), HN};
                if (type == OP_RNN2) phase_rnn_carry(P);
#if PHM & 4
                for (int rep = 0; rep < ((DBL & 4) ? 2 : 1); ++rep) if (type == OP_RNN1) phase_rnn(lds, P, HN, (bf16_t*)(ws + WS_EXTRA));
#endif
#if PHM & 8
                if (type == OP_RNN3) phase_rnn_out(P, HN, (const bf16_t*)(ws + WS_EXTRA), need_ctx);
#endif
            } else if (type == OP_ATT0) {
#if PHM & 16
                for (int rep = 0; rep < ((DBL & 16) ? 2 : 1); ++rep) phase_swa(lds, ACT, HN, a.in[I_BSINKS] + (size_t)j * 16, need_ctx);
#endif
            } else {
#if PHM & 32
                for (int rep = 0; rep < ((DBL & 32) ? 2 : 1); ++rep) phase_nat(lds, ACT, (const bf16_t*)(ws + WS_EXTRA), HN, a.in[I_CRPB] + (size_t)j * 16 * 465, need_ctx);
#endif
            }
            xcd_barrier(xb);
#if DBL & 128
            xcd_barrier(xb);
#endif
        }
    }
#if PHM & 2
    phase_final(a);
#endif
}

extern "C" void kernel_launch(void* const* d_in, const int* in_sizes, int n_in, void* d_out, int out_size, void* d_ws, size_t ws_size, hipStream_t stream) {
    static int grid_blocks = 0;
    if (grid_blocks == 0) {
        if (n_in != 23 || ws_size < WS_END) { fprintf(stderr, "kernel_launch: unexpected n_in %d or ws_size %zu (need %zu)\n", n_in, ws_size, (size_t)WS_END); grid_blocks = -1; return; }
        int dev = 0, cus = 0, per_cu = 0;
        (void)hipGetDevice(&dev);
        (void)hipDeviceGetAttribute(&cus, hipDeviceAttributeMultiprocessorCount, dev);
        if (hipFuncSetAttribute((const void*)fwd_megakernel, hipFuncAttributeMaxDynamicSharedMemorySize, LDS_BYTES) != hipSuccess) fprintf(stderr, "kernel_launch: hipFuncSetAttribute failed\n");
        (void)hipOccupancyMaxActiveBlocksPerMultiprocessor(&per_cu, (const void*)fwd_megakernel, 512, LDS_BYTES);
        (void)hipGetLastError();
        if (per_cu < 1) per_cu = 1;
        grid_blocks = cus * 1;
    }
    if (grid_blocks < 0) return;
    Args a{};
    for (int i = 0; i < 23; ++i) a.in[i] = (const float*)d_in[i];
    a.out = (float*)d_out; a.ws = (unsigned char*)d_ws;
    void* args[] = {&a};
    hipError_t e = hipLaunchCooperativeKernel((const void*)fwd_megakernel, dim3(grid_blocks), dim3(512), args, LDS_BYTES, stream);
    if (e != hipSuccess) fprintf(stderr, "cooperative launch failed: %s (grid %d)\n", hipGetErrorString(e), grid_blocks);
}
```

```cpp
#include <hip/hip_runtime.h>
#include <hip/hip_cooperative_groups.h>
#include <cstdio>
#include <cstdint>
namespace cg = cooperative_groups;

#define LAS __attribute__((address_space(3)))
typedef unsigned short bf16_t;
typedef short bf16x8 __attribute__((ext_vector_type(8)));
typedef short bf16x4 __attribute__((ext_vector_type(4)));
typedef float f32x4 __attribute__((ext_vector_type(4)));
typedef unsigned u32x4 __attribute__((ext_vector_type(4)));
typedef unsigned u32x2 __attribute__((ext_vector_type(2)));

constexpr int D = 1024, SEQ = 16384, CTXL = 256, MX = 32768, MCTX = 512, MT = MX + MCTX;
constexpr int DFF = 2816, DRNN = 1536, NLAYER = 4;
constexpr int NCHUNK = 130;
constexpr int LDS_XB = 137216;
constexpr int LDS_BYTES = LDS_XB + 256;

#define XCD_BAR_WORDS 3456
constexpr size_t al256(size_t x) { return (x + 255) & ~(size_t)255; }
constexpr size_t WS_WGU = 0;
constexpr size_t WS_WDN = al256(WS_WGU + (size_t)8 * 5632 * 1024 * 2);
constexpr size_t WS_WAIN = al256(WS_WDN + (size_t)8 * 1024 * 2816 * 2);
constexpr size_t WS_WAOUT = al256(WS_WAIN + (size_t)2 * 3072 * 1024 * 2);
constexpr size_t WS_WAG = al256(WS_WAOUT + (size_t)2 * 1024 * 1536 * 2);
constexpr size_t WS_WBQKV = al256(WS_WAG + (size_t)96 * 128 * 128 * 2);
constexpr size_t WS_WBO = al256(WS_WBQKV + (size_t)1536 * 1024 * 2);
constexpr size_t WS_WCQKV = al256(WS_WBO + (size_t)1024 * 1024 * 2);
constexpr size_t WS_WCO = al256(WS_WCQKV + (size_t)3072 * 1024 * 2);
constexpr size_t WS_MOD = al256(WS_WCO + (size_t)1024 * 1024 * 2);
constexpr size_t WS_ROPE = al256(WS_MOD + (size_t)4 * 3 * 9216 * 4);
constexpr size_t WS_PE = al256(WS_ROPE + (size_t)2 * 256 * 16 * 4);
constexpr size_t PE_HALF = (size_t)2 * 2 * NCHUNK * DRNN;
constexpr size_t WS_CIN = al256(WS_PE + 2 * PE_HALF * 4);
constexpr size_t WS_XS = al256(WS_CIN + PE_HALF * 4);
constexpr size_t WS_HN = al256(WS_XS + (size_t)MT * D * 4);
constexpr size_t WS_ACT = al256(WS_HN + (size_t)MT * 1536 * 2);
constexpr size_t WS_EXTRA = al256(WS_ACT + (size_t)MT * 3072 * 2);
constexpr size_t WS_SLAB = al256(WS_EXTRA + (size_t)MT * 1024 * 2);
constexpr size_t WS_BAR = al256(WS_EXTRA + (size_t)MT * 1536 * 2);
static_assert(WS_SLAB + (size_t)11 * MCTX * D * 4 <= WS_BAR, "slabs must fit in EXTRA's tail");
constexpr size_t WS_END = al256(WS_BAR + (size_t)XCD_BAR_WORDS * 4);

__device__ __forceinline__ int opaque_tid() { int t = threadIdx.x; asm volatile("" : "+v"(t)); return t; }
__device__ __forceinline__ size_t opaque_zero() { size_t z = 0; asm volatile("" : "+s"(z)); return z; }
__device__ __forceinline__ unsigned cvt_pk_bf16(float lo, float hi) { unsigned r; asm("v_cvt_pk_bf16_f32 %0, %1, %2" : "=v"(r) : "v"(lo), "v"(hi)); return r; }
__device__ __forceinline__ float bf2f(bf16_t b) { return __uint_as_float(((unsigned)b) << 16); }
__device__ __forceinline__ float bflo(unsigned u) { return __uint_as_float(u << 16); }
__device__ __forceinline__ float bfhi(unsigned u) { return __uint_as_float(u & 0xffff0000u); }
__device__ __forceinline__ float sigmoidf_(float z) { return __builtin_amdgcn_rcpf(1.0f + __expf(-z)); }
__device__ __forceinline__ float siluf_(float z) { return z * sigmoidf_(z); }
__device__ __forceinline__ float gelu_tanh(float x) { const float u = 0.7978845608028654f * (x + 0.044715f * x * x * x); return x * sigmoidf_(2.0f * u); }
__device__ __forceinline__ float wave_sum(float v) {
#pragma unroll
    for (int o = 1; o < 64; o <<= 1) v += __shfl_xor(v, o);
    return v;
}

#define XB_TMO      128
#define XB_XCNT(j)  (256  + 64 * (j))
#define XB_XSUB(j)  (1280 + 64 * (j))
#define XB_XGEN(j)  (2304 + 64 * (j))
#define XB_TOP      3328
#define XB_TOPGEN   3392
#define XB_SPIN_CAP (1u << 20)
__device__ __forceinline__ unsigned xb_ld(unsigned* p)              { return __hip_atomic_load(p, __ATOMIC_RELAXED, __HIP_MEMORY_SCOPE_AGENT); }
__device__ __forceinline__ unsigned xb_add(unsigned* p, unsigned v) { return __hip_atomic_fetch_add(p, v, __ATOMIC_RELAXED, __HIP_MEMORY_SCOPE_AGENT); }
__device__ __forceinline__ unsigned xb_xcc_id() { return (unsigned)__builtin_amdgcn_s_getreg((3 << 11) | 20) & 0xFu; }
#define XB_SPIN(cond, bar) do { unsigned _sp = 0; while (cond) { __builtin_amdgcn_s_sleep(1); \
    if ((++_sp & 255u) == 0u) { if (xb_ld(&(bar)[XB_TMO])) break; if (_sp > XB_SPIN_CAP) { atomicAdd(&(bar)[XB_TMO], 1u); break; } } } } while (0)
struct XcdBarrier { unsigned* bar; unsigned x; volatile LAS unsigned* st; };
__device__ __forceinline__ XcdBarrier xcd_barrier_post(unsigned* bar, volatile LAS unsigned* st) {
    XcdBarrier b; b.bar = bar; b.x = xb_xcc_id(); b.st = st;
    if (threadIdx.x == 0) (void)xb_add(&bar[XB_XCNT(b.x)], 1u);
    return b;
}
__device__ __forceinline__ void xcd_barrier_complete(unsigned* bar, unsigned x, unsigned& nloc, unsigned& nx) {
    const unsigned G = gridDim.x * gridDim.y * gridDim.z;
    unsigned sum, cnt, mine, sp = 0u;
    for (;;) {
        sum = 0u; cnt = 0u; mine = 0u;
#pragma unroll
        for (unsigned j = 0; j < 16; ++j) { const unsigned c = xb_ld(&bar[XB_XCNT(j)]); sum += c; cnt += (c > 0u) ? 1u : 0u; mine = (j == x) ? c : mine; }
        if (sum == G) break;
        __builtin_amdgcn_s_sleep(1);
        if ((++sp & 255u) == 0u) { if (xb_ld(&bar[XB_TMO])) break; if (sp > XB_SPIN_CAP) { atomicAdd(&bar[XB_TMO], 1u); break; } }
    }
    nloc = mine > 0u ? mine : 1u; nx = cnt > 0u ? cnt : 1u;
}
__device__ __forceinline__ void xcd_barrier(const XcdBarrier& b) {
    asm volatile("s_waitcnt vmcnt(0)" ::: "memory");
    __syncthreads();
    if (threadIdx.x == 0) {
        unsigned* bar = b.bar;
        __builtin_amdgcn_s_waitcnt(0);
        unsigned nloc = b.st[0], nx = b.st[1];
        if (nloc == 0u) { xcd_barrier_complete(bar, b.x, nloc, nx); b.st[0] = nloc; b.st[1] = nx; }
        const unsigned old = xb_add(&bar[XB_XSUB(b.x)], 1u);
        const unsigned gen = old / nloc;
        if (old + 1u == (gen + 1u) * nloc) {
            __builtin_amdgcn_fence(__ATOMIC_RELEASE, "agent");
            asm volatile("s_waitcnt vmcnt(0)" ::: "memory");
            const unsigned og = xb_add(&bar[XB_TOP], 1u);
            const unsigned tg = og / nx;
            if (og + 1u == (tg + 1u) * nx) xb_add(&bar[XB_TOPGEN], 1u);
            else XB_SPIN(xb_ld(&bar[XB_TOPGEN]) == tg, bar);
            __builtin_amdgcn_fence(__ATOMIC_ACQUIRE, "agent");
            xb_add(&bar[XB_XGEN(b.x)], 1u);
            asm volatile("s_waitcnt vmcnt(0)" ::: "memory");
        } else {
            XB_SPIN(xb_ld(&bar[XB_XGEN(b.x)]) == gen, bar);
            __builtin_amdgcn_fence(__ATOMIC_ACQUIRE, "agent");
            asm volatile("s_waitcnt vmcnt(0)" ::: "memory");
        }
    }
    __syncthreads();
}

namespace pg8 {
constexpr int BM = 256, BK = 64, HALF = 128, HTB = HALF * BK * 2, STAGE_BYTES = 8 * HTB, NXCD = 8, WGM = 8;
__device__ __forceinline__ int lds_byte(int r, int c) { const int st = (r >> 4) * 2 + (c >> 5), rr = r & 15, cc = c & 31, ob = rr * 64 + cc * 2; return st * 1024 + (ob ^ (((ob >> 9) & 1) << 5)); }
__device__ __forceinline__ void stage_rc(int b, int& R, int& C) { const int st = b / 1024, sb = b % 1024, swz = sb ^ (((sb >> 9) & 1) << 5); R = (st >> 1) * 16 + swz / 64; C = (st & 1) * 32 + (swz % 64) / 2; }
__device__ __forceinline__ int perm32(int rho) { const int n = rho >> 4, i = rho & 15; return 8 * (i >> 2) + 4 * n + (i & 3); }
struct Unit { int pm, pn, ks, nt, at; };
struct Gemm { const bf16_t* A; const bf16_t* Bt; int M, N, K; };
struct StaticOrder {
    int nM, nN, nwg, G, c, nctx, main_nt;
    __device__ void init(int M, int N, int K, int G_, int c_, bool splitctx) {
        nN = N / BM; G = G_; c = c_; main_nt = K / BK;
        if (splitctx && M == MT) { nM = MX / BM; nctx = 2 * nN * (K / 256); } else { nM = M / BM; nctx = 0; }
        nwg = nM * nN;
    }
    __device__ bool next(int i, Unit& u) const {
        long L = (long)i * G + c;
        if (L >= nwg) {
            L -= nwg; if (L >= nctx) return false;
            const int rem = (int)L % (2 * nN);
            u.ks = (int)L / (2 * nN); u.pm = 128 + (rem & 1); u.pn = rem >> 1; u.nt = 4; u.at = 1; return true;
        }
        int wgid = (int)L; { const int q = nwg / NXCD, r = nwg % NXCD, xcd = wgid % NXCD, off = wgid / NXCD; wgid = (xcd < r ? xcd * (q + 1) : r * (q + 1) + (xcd - r) * q) + off; }
        const int nig = WGM * nN, gid = wgid / nig, fm = gid * WGM, gsz = (nM - fm) < WGM ? (nM - fm) : WGM;
        u.pm = fm + ((wgid % nig) % gsz); u.pn = (wgid % nig) / gsz; u.ks = 0; u.nt = main_nt; u.at = 0; return true;
    }
};
template <class Epi>
__device__ __forceinline__ void gemm_phase(LAS unsigned char* lds, const Gemm g, const StaticOrder& S, const Epi& E) {
    const int tid = opaque_tid(), wid = __builtin_amdgcn_readfirstlane(tid >> 6), lane = tid & 63, wr = wid >> 2, wc = wid & 3, fr = lane & 15, fq = lane >> 4;
    const int K = g.K;
    unsigned voffA[2], voffB[2];
#pragma unroll
    for (int i = 0; i < 2; ++i) { int R, C; stage_rc(tid * 16 + i * 8192, R, C); const int Rb = E.perm() ? ((R & ~31) + perm32(R & 31)) : R;
        voffA[i] = (unsigned)(R * K + C) * 2u; voffB[i] = (unsigned)(Rb * K + C) * 2u; }
    const size_t kstep = (size_t)(BK * 2);
    const size_t hstep = (size_t)HALF * K * 2;
    const size_t tstep = 2 * hstep;
    const unsigned ldsw = (unsigned)wid * 1024u;
    const int aoff = lds_byte(wr * 64 + fr, fq * 8), boff = lds_byte(wc * 32 + fr, fq * 8);
#define PG8_SA(b, h) (((b) * 2 + (h)) * HTB)
#define PG8_SB(b, h) ((4 + (b) * 2 + (h)) * HTB)
#define PG8_STAGE(bufoff, gbase, voff) do { _Pragma("unroll") for (int _i = 0; _i < 2; ++_i) \
        __builtin_amdgcn_global_load_lds((const unsigned*)((const char*)(gbase) + (voff)[_i]), (LAS unsigned*)(lds + (bufoff) + ldsw + _i * 8192), 16, 0, 0); } while (0)
#define PG8_LDA(dst, b, h) do { _Pragma("unroll") for (int m = 0; m < 4; ++m) _Pragma("unroll") for (int k = 0; k < 2; ++k) dst[m][k] = *(const LAS bf16x8*)(lds + PG8_SA(b, h) + aoff + m * 2048 + k * 1024); } while (0)
#define PG8_LDB(dst, b, h) do { _Pragma("unroll") for (int n = 0; n < 2; ++n) _Pragma("unroll") for (int k = 0; k < 2; ++k) dst[n][k] = *(const LAS bf16x8*)(lds + PG8_SB(b, h) + boff + n * 2048 + k * 1024); } while (0)
#define PG8_MMA(ai, bj, At, Bt) do { __builtin_amdgcn_s_setprio(1); _Pragma("unroll") for (int m = 0; m < 4; ++m) _Pragma("unroll") for (int n = 0; n < 2; ++n) _Pragma("unroll") for (int k = 0; k < 2; ++k) \
        acc[ai][bj][m][n] = __builtin_amdgcn_mfma_f32_16x16x32_bf16(Bt[n][k], At[m][k], acc[ai][bj][m][n], 0, 0, 0); __builtin_amdgcn_s_setprio(0); } while (0)
#define PG8_WAIT_V(n) asm volatile("s_waitcnt vmcnt(" #n ")" ::: "memory")
#define PG8_WAIT_L(n) asm volatile("s_waitcnt lgkmcnt(" #n ")" ::: "memory")
#define PG8_BAR __builtin_amdgcn_s_barrier()
#define PG8_SCHED __builtin_amdgcn_sched_barrier(0)
    Unit cur, nxt; int ui = 0;
    if (!S.next(0, cur)) return;
    f32x4 acc[2][2][4][2];
#pragma unroll
    for (int a = 0; a < 2; ++a)
#pragma unroll
        for (int b = 0; b < 2; ++b)
#pragma unroll
            for (int m = 0; m < 4; ++m)
#pragma unroll
                for (int n = 0; n < 2; ++n) acc[a][b][m][n] = (f32x4){0.f, 0.f, 0.f, 0.f};
    bf16x8 At[4][2], B0[2][2], B1[2][2];
    const char* cA = (const char*)g.A + (size_t)cur.pm * tstep + (size_t)cur.ks * 512; const char* cB = (const char*)g.Bt + (size_t)cur.pn * tstep + (size_t)cur.ks * 512;
    PG8_STAGE(PG8_SB(0, 0), cB, voffB); PG8_STAGE(PG8_SA(0, 0), cA, voffA); PG8_STAGE(PG8_SB(0, 1), cB + hstep, voffB); PG8_STAGE(PG8_SA(0, 1), cA + hstep, voffA);
    if (wr == 1) PG8_BAR;
    PG8_WAIT_V(4); PG8_BAR;
    PG8_STAGE(PG8_SB(1, 0), cB + kstep, voffB); PG8_STAGE(PG8_SA(1, 0), cA + kstep, voffA); PG8_STAGE(PG8_SB(1, 1), cB + hstep + kstep, voffB);
    PG8_WAIT_V(6); PG8_BAR;
    for (;;) {
        const bool has_next = S.next(ui + 1, nxt);
        const char* nA = has_next ? (const char*)g.A + (size_t)nxt.pm * tstep + (size_t)nxt.ks * 512 : cA; const char* nB = has_next ? (const char*)g.Bt + (size_t)nxt.pn * tstep + (size_t)nxt.ks * 512 : cB;
        const int nt = cur.nt;
        for (int t = 0; t < nt; t += 2) {
            const bool last = (t == nt - 2);
            const char* a1 = cA + (size_t)(t + 1) * kstep;
            const char* a2 = last ? nA : cA + (size_t)(t + 2) * kstep; const char* b2 = last ? nB : cB + (size_t)(t + 2) * kstep;
            const char* a3 = a2 + kstep; const char* b3 = b2 + kstep;
            PG8_LDB(B0, 0, 0); PG8_SCHED; PG8_LDA(At, 0, 0); PG8_STAGE(PG8_SA(1, 1), a1 + hstep, voffA);
            PG8_WAIT_L(8); PG8_BAR; PG8_WAIT_L(0); PG8_MMA(0, 0, At, B0); PG8_BAR; PG8_SCHED;
            PG8_LDB(B1, 0, 1); PG8_STAGE(PG8_SB(0, 0), b2, voffB);
            PG8_BAR; PG8_WAIT_L(0); PG8_MMA(0, 1, At, B1); PG8_BAR;
            PG8_LDA(At, 0, 1); PG8_STAGE(PG8_SA(0, 0), a2, voffA);
            PG8_BAR; PG8_WAIT_L(0); PG8_MMA(1, 0, At, B0); PG8_BAR; PG8_SCHED;
            PG8_STAGE(PG8_SB(0, 1), b2 + hstep, voffB);
            PG8_WAIT_V(6); PG8_BAR; PG8_MMA(1, 1, At, B1); PG8_BAR;
            PG8_LDB(B0, 1, 0); PG8_SCHED; PG8_LDA(At, 1, 0); PG8_STAGE(PG8_SA(0, 1), a2 + hstep, voffA);
            PG8_WAIT_L(8); PG8_BAR; PG8_WAIT_L(0); PG8_MMA(0, 0, At, B0); PG8_BAR; PG8_SCHED;
            PG8_LDB(B1, 1, 1); PG8_STAGE(PG8_SB(1, 0), b3, voffB);
            PG8_BAR; PG8_WAIT_L(0); PG8_MMA(0, 1, At, B1); PG8_BAR;
            PG8_LDA(At, 1, 1); PG8_STAGE(PG8_SA(1, 0), a3, voffA);
            PG8_BAR; PG8_WAIT_L(0); PG8_MMA(1, 0, At, B0); PG8_BAR; PG8_SCHED;
            PG8_STAGE(PG8_SB(1, 1), b3 + hstep, voffB);
            PG8_WAIT_V(6); PG8_BAR; PG8_MMA(1, 1, At, B1); PG8_BAR;
        }
        if (wr == 0) PG8_BAR;
        E(acc, cur, wr, wc, fr, fq);
        if (!has_next) break;
#pragma unroll
        for (int a = 0; a < 2; ++a)
#pragma unroll
            for (int b = 0; b < 2; ++b)
#pragma unroll
                for (int m = 0; m < 4; ++m)
#pragma unroll
                    for (int n = 0; n < 2; ++n) acc[a][b][m][n] = (f32x4){0.f, 0.f, 0.f, 0.f};
        cur = nxt; cA = nA; cB = nB; ++ui;
        if (wr == 1) PG8_BAR;
    }
    PG8_WAIT_V(0);
    PG8_BAR;
#undef PG8_SA
#undef PG8_SB
#undef PG8_STAGE
#undef PG8_LDA
#undef PG8_LDB
#undef PG8_MMA
#undef PG8_WAIT_V
#undef PG8_WAIT_L
#undef PG8_BAR
#undef PG8_SCHED
}
}
using pg8::Unit;
typedef f32x4 AccT[2][2][4][2];

struct EpiSwiGLU {
    static constexpr bool PERM = true;
    bf16_t* out;
    __device__ __forceinline__ void operator()(const AccT& acc, const Unit& u, int wr, int wc, int fr, int fq) const {
        const int row0 = u.pm * 256 + wr * 64 + fr, col0 = u.pn * 128 + wc * 32 + 8 * fq;
#pragma unroll
        for (int ai = 0; ai < 2; ++ai)
#pragma unroll
            for (int m = 0; m < 4; ++m) {
                const f32x4 g0 = acc[ai][0][m][0], g1 = acc[ai][0][m][1], u0 = acc[ai][1][m][0], u1 = acc[ai][1][m][1];
                u32x4 o;
                o.x = cvt_pk_bf16(siluf_(g0[0]) * u0[0], siluf_(g0[1]) * u0[1]); o.y = cvt_pk_bf16(siluf_(g0[2]) * u0[2], siluf_(g0[3]) * u0[3]);
                o.z = cvt_pk_bf16(siluf_(g1[0]) * u1[0], siluf_(g1[1]) * u1[1]); o.w = cvt_pk_bf16(siluf_(g1[2]) * u1[2], siluf_(g1[3]) * u1[3]);
                *(u32x4*)(out + (size_t)(row0 + ai * 128 + m * 16) * DFF + col0) = o;
            }
    }
};
struct EpiResid {
    static constexpr bool PERM = true;
    float* slab; bf16_t* y; const float* gate; float coef;
    __device__ __forceinline__ void operator()(const AccT& acc, const Unit& u, int wr, int wc, int fr, int fq) const {
        const int mb = (u.pm >= 128) ? 2 : (u.pm >= 64 ? 1 : 0);
        const float* gp = gate + mb * 9216;
        const int row0 = u.pm * 256 + wr * 64 + fr, col0 = u.pn * 256 + wc * 32 + 8 * fq;
        f32x4 gv[2][2];
#pragma unroll
        for (int bj = 0; bj < 2; ++bj)
#pragma unroll
            for (int n = 0; n < 2; ++n) gv[bj][n] = *(const f32x4*)(gp + col0 + bj * 128 + 4 * n) * coef;
#pragma unroll
        for (int ai = 0; ai < 2; ++ai)
#pragma unroll
            for (int m = 0; m < 4; ++m) {
                const size_t ro = (size_t)(row0 + ai * 128 + m * 16) * D + col0;
#pragma unroll
                for (int bj = 0; bj < 2; ++bj) {
                    const f32x4 v0 = gv[bj][0] * acc[ai][bj][m][0], v1 = gv[bj][1] * acc[ai][bj][m][1];
                    if (u.at) {
                        float* pf = slab + (size_t)u.ks * MCTX * D + (ro - (size_t)MX * D) + bj * 128;
                        *(f32x4*)pf = v0; *(f32x4*)(pf + 4) = v1;
                    } else {
                        u32x4 o; o.x = cvt_pk_bf16(v0[0], v0[1]); o.y = cvt_pk_bf16(v0[2], v0[3]); o.z = cvt_pk_bf16(v1[0], v1[1]); o.w = cvt_pk_bf16(v1[2], v1[3]);
                        *(u32x4*)(y + ro + bj * 128) = o;
                    }
                }
            }
    }
};
struct EpiBf16 {
    static constexpr bool PERM = true;
    bf16_t* out; int ldc; int qcols; float qscale; bf16_t* vt;
    __device__ __forceinline__ void operator()(const AccT& acc, const Unit& u, int wr, int wc, int fr, int fq) const {
        const int row0 = u.pm * 256 + wr * 64 + fr, col0 = u.pn * 256 + wc * 32 + 8 * fq;
        const float sc = (u.pn * 256 < qcols) ? qscale : 1.0f;
        if (vt != nullptr && u.pn >= 8) {
            const bool isx = u.pm < 128;
            const int bb = isx ? (u.pm >> 6) : ((u.pm - 128));
            const size_t tstride = isx ? (size_t)SEQ : (size_t)CTXL;
            bf16_t* base = vt + (isx ? (size_t)0 : (size_t)2 * 16 * 64 * SEQ) + (size_t)bb * 16 * 64 * tstride;
            const int tok0 = (isx ? ((u.pm & 63) * 256) : 0) + wr * 64 + fr;
#pragma unroll
            for (int ai = 0; ai < 2; ++ai)
#pragma unroll
                for (int m = 0; m < 4; ++m) {
                    const int tok = tok0 + ai * 128 + m * 16;
#pragma unroll
                    for (int bj = 0; bj < 2; ++bj) {
                        const int hd = col0 - 2048 + bj * 128;
                        bf16_t* p = base + (size_t)hd * tstride + tok;
                        const f32x4 v0 = acc[ai][bj][m][0], v1 = acc[ai][bj][m][1];
                        const unsigned a0 = cvt_pk_bf16(v0[0], v0[1]), a1 = cvt_pk_bf16(v0[2], v0[3]), a2 = cvt_pk_bf16(v1[0], v1[1]), a3 = cvt_pk_bf16(v1[2], v1[3]);
                        p[0 * tstride] = (bf16_t)(a0 & 0xffff); p[1 * tstride] = (bf16_t)(a0 >> 16); p[2 * tstride] = (bf16_t)(a1 & 0xffff); p[3 * tstride] = (bf16_t)(a1 >> 16);
                        p[4 * tstride] = (bf16_t)(a2 & 0xffff); p[5 * tstride] = (bf16_t)(a2 >> 16); p[6 * tstride] = (bf16_t)(a3 & 0xffff); p[7 * tstride] = (bf16_t)(a3 >> 16);
                    }
                }
            return;
        }
#pragma unroll
        for (int ai = 0; ai < 2; ++ai)
#pragma unroll
            for (int m = 0; m < 4; ++m) {
                bf16_t* rowp = out + (size_t)(row0 + ai * 128 + m * 16) * ldc + col0;
#pragma unroll
                for (int bj = 0; bj < 2; ++bj) {
                    const f32x4 v0 = acc[ai][bj][m][0] * sc, v1 = acc[ai][bj][m][1] * sc;
                    u32x4 o; o.x = cvt_pk_bf16(v0[0], v0[1]); o.y = cvt_pk_bf16(v0[2], v0[3]); o.z = cvt_pk_bf16(v1[0], v1[1]); o.w = cvt_pk_bf16(v1[2], v1[3]);
                    *(u32x4*)(rowp + bj * 128) = o;
                }
            }
    }
};
struct EpiRope {
    static constexpr bool PERM = false;
    bf16_t* out; const float* rope;
    __device__ __forceinline__ void operator()(const AccT& acc, const Unit& u, int wr, int wc, int fr, int fq) const {
        const int row0 = u.pm * 256 + wr * 64 + fr, col0 = u.pn * 256 + wc * 32 + 4 * fq;
        const bool is_q = u.pn < 4, is_v = u.pn == 5, do_rope = (!is_v) && (u.pm < 128);
        const float sc = is_q ? 0.125f * 1.4426950408889634f : 1.0f;
#pragma unroll
        for (int ai = 0; ai < 2; ++ai)
#pragma unroll
            for (int m = 0; m < 4; ++m) {
                const int row = row0 + ai * 128 + m * 16;
                const int t = row & (SEQ - 1);
                const int pos = (wc & 1) ? (t & 63) : (t >> 6);
                f32x4 cs = (f32x4){1.f, 1.f, 1.f, 1.f}, sn = (f32x4){0.f, 0.f, 0.f, 0.f};
                if (do_rope) { cs = *(const f32x4*)(rope + pos * 16 + 4 * fq); sn = *(const f32x4*)(rope + 4096 + pos * 16 + 4 * fq); }
                bf16_t* rowp = out + (size_t)row * 1536 + col0;
#pragma unroll
                for (int bj = 0; bj < 2; ++bj) {
                    const f32x4 x1 = acc[ai][bj][m][0], x2 = acc[ai][bj][m][1];
                    const f32x4 o1 = (x1 * cs - x2 * sn) * sc, o2 = (x2 * cs + x1 * sn) * sc;
                    u32x2 a, b; a.x = cvt_pk_bf16(o1[0], o1[1]); a.y = cvt_pk_bf16(o1[2], o1[3]); b.x = cvt_pk_bf16(o2[0], o2[1]); b.y = cvt_pk_bf16(o2[2], o2[3]);
                    *(u32x2*)(rowp + bj * 128) = a; *(u32x2*)(rowp + bj * 128 + 16) = b;
                }
            }
    }
};

struct EpiAny {
    int mode;
    EpiSwiGLU e0; EpiResid e1; EpiBf16 e2; EpiRope e3;
    __device__ __forceinline__ bool perm() const { return mode != 3; }
    __device__ __forceinline__ void operator()(const AccT& acc, const Unit& u, int wr, int wc, int fr, int fq) const {
        if (mode == 0) e0(acc, u, wr, wc, fr, fq);
        else if (mode == 1) e1(acc, u, wr, wc, fr, fq);
        else if (mode == 2) e2(acc, u, wr, wc, fr, fq);
        else e3(acc, u, wr, wc, fr, fq);
    }
};

struct Args {
    const float* in[23];
    float* out;
    unsigned char* ws;
};
enum { I_X = 0, I_C, I_CTX, I_CCTX, I_WADA, I_BADA, I_NORMG, I_WGU, I_WDN, I_AWIN, I_ACONVW, I_ACONVB, I_AGATEW, I_AGATEB, I_ALAM, I_AWOUT,
       I_BWQKV, I_BSINKS, I_BWO, I_CWQKV, I_CRPB, I_CWO, I_FINALG };

__device__ __forceinline__ void transpose_item(const float* W, int K, int N, bf16_t* WT, int k0, int n0, int drow0, LAS float* scr, int lane) {
    f32x4 wv[8];
#pragma unroll
    for (int i = 0; i < 8; ++i) wv[i] = __builtin_nontemporal_load((const f32x4*)(W + (size_t)(k0 + (lane >> 3) + 8 * i) * N + n0 + 4 * (lane & 7)));
#pragma unroll
    for (int i = 0; i < 8; ++i) { LAS float* sp = scr + ((lane >> 3) + 8 * i) * 33 + 4 * (lane & 7); sp[0] = wv[i][0]; sp[1] = wv[i][1]; sp[2] = wv[i][2]; sp[3] = wv[i][3]; }
    asm volatile("s_waitcnt lgkmcnt(0)" ::: "memory");
    const int c = lane & 7;
#pragma unroll
    for (int j = 0; j < 4; ++j) { const int n = (lane >> 3) + 8 * j; const LAS float* s = scr + (8 * c) * 33 + n;
        u32x4 o; o.x = cvt_pk_bf16(s[0 * 33], s[1 * 33]); o.y = cvt_pk_bf16(s[2 * 33], s[3 * 33]); o.z = cvt_pk_bf16(s[4 * 33], s[5 * 33]); o.w = cvt_pk_bf16(s[6 * 33], s[7 * 33]);
        *(u32x4*)(WT + (size_t)(drow0 + n) * K + k0 + 8 * c) = o; }
    asm volatile("s_waitcnt lgkmcnt(0)" ::: "memory");
}
__device__ __forceinline__ bool transpose_family(int& it, const float* W, int cnt, int K, int N, bf16_t* WT, bool gu, LAS float* scr, int lane) {
    const int nblk = N / 32, kblk = K / 64, per = nblk * kblk, tot = per * cnt;
    if (it >= tot) { it -= tot; return false; }
    const int mi = it / per, r = it % per, kb = r / nblk, nb = r % nblk;
    const int n0 = 32 * nb; int drow0 = n0;
    if (gu) { const int half = n0 >= DFF ? 1 : 0, nn = n0 - half * DFF; drow0 = (nn >> 7) * 256 + half * 128 + (nn & 127); }
    transpose_item(W + (size_t)mi * K * N, K, N, WT + (size_t)mi * K * N, 64 * kb, n0, drow0, scr, lane);
    return true;
}
__device__ __forceinline__ void phase_prep(const Args& a, LAS unsigned char* lds) {
    const int tid = opaque_tid(), lane = tid & 63, wave = tid >> 6;
    unsigned char* ws = a.ws;
    {
        const int idx = blockIdx.x * 512 + tid;
        if (idx < 4096) {
            const int pos = idx >> 4, j = idx & 15;
            double inv = (j & 3) == 0 ? 1.0 : ((j & 3) == 1 ? 0.5623413251903491 : ((j & 3) == 2 ? 0.31622776601683794 : 0.1778279410038923));
            const int dec = j >> 2; inv *= (dec == 0 ? 1.0 : dec == 1 ? 0.1 : dec == 2 ? 0.01 : 0.001);
            double rev = (double)pos * inv * 0.15915494309189535; rev -= floor(rev);
            float* rope = (float*)(ws + WS_ROPE);
            rope[idx] = __builtin_amdgcn_cosf((float)rev); rope[4096 + idx] = __builtin_amdgcn_sinf((float)rev);
        }
    }
    {
        LAS float* sv = (LAS float*)lds;
        LAS float* red = sv + 3 * 1024;
        for (int e = tid; e < 3 * 1024; e += 512) { const int v = e >> 10, k = e & 1023; const float cv = v < 2 ? a.in[I_C][v * 1024 + k] : a.in[I_CCTX][k]; sv[e] = siluf_(cv); }
        __syncthreads();
        float* mod = (float*)(ws + WS_MOD);
        for (int task = blockIdx.x; task < 4 * 72; task += gridDim.x) {
            const int i = task / 72, col0 = (task % 72) * 128;
            const int cg4 = tid & 31, kg = tid >> 5;
            const float* wp = a.in[I_WADA] + ((size_t)i * 1024 + kg * 64) * 9216 + col0 + 4 * cg4;
            f32x4 s0 = (f32x4){0, 0, 0, 0}, s1 = s0, s2 = s0;
#pragma unroll 8
            for (int k = 0; k < 64; ++k) { const f32x4 w = *(const f32x4*)(wp + (size_t)k * 9216); const int kk = kg * 64 + k; s0 += w * sv[kk]; s1 += w * sv[1024 + kk]; s2 += w * sv[2048 + kk]; }
#pragma unroll
            for (int e = 0; e < 4; ++e) { red[(kg * 3 + 0) * 128 + 4 * cg4 + e] = s0[e]; red[(kg * 3 + 1) * 128 + 4 * cg4 + e] = s1[e]; red[(kg * 3 + 2) * 128 + 4 * cg4 + e] = s2[e]; }
            __syncthreads();
            if (tid < 384) { const int v = tid >> 7, cc = tid & 127; float s = 0.f;
#pragma unroll
                for (int q = 0; q < 16; ++q) s += red[(q * 3 + v) * 128 + cc];
                mod[((size_t)i * 3 + v) * 9216 + col0 + cc] = s + a.in[I_BADA][(size_t)i * 9216 + col0 + cc]; }
            __syncthreads();
        }
    }
    {
        LAS float* scr = (LAS float*)(lds + wave * 8448);
        const int gw = blockIdx.x * 8 + wave, NGW = gridDim.x * 8;
        constexpr int TOT = 8 * 16 * 176 + 8 * 44 * 32 + 2 * 16 * 96 + 2 * 24 * 32 + 96 * 2 * 4 + 16 * 48 + 16 * 32 + 16 * 96 + 16 * 32;
        for (int item = gw; item < TOT; item += NGW) {
            int it = item;
            if (transpose_family(it, a.in[I_WGU], 8, 1024, 5632, (bf16_t*)(ws + WS_WGU), true, scr, lane)) continue;
            if (transpose_family(it, a.in[I_WDN], 8, 2816, 1024, (bf16_t*)(ws + WS_WDN), false, scr, lane)) continue;
            if (transpose_family(it, a.in[I_AWIN], 2, 1024, 3072, (bf16_t*)(ws + WS_WAIN), false, scr, lane)) continue;
            if (transpose_family(it, a.in[I_AWOUT], 2, 1536, 1024, (bf16_t*)(ws + WS_WAOUT), false, scr, lane)) continue;
            if (transpose_family(it, a.in[I_AGATEW], 96, 128, 128, (bf16_t*)(ws + WS_WAG), false, scr, lane)) continue;
            if (transpose_family(it, a.in[I_BWQKV], 1, 1024, 1536, (bf16_t*)(ws + WS_WBQKV), false, scr, lane)) continue;
            if (transpose_family(it, a.in[I_BWO], 1, 1024, 1024, (bf16_t*)(ws + WS_WBO), false, scr, lane)) continue;
            if (transpose_family(it, a.in[I_CWQKV], 1, 1024, 3072, (bf16_t*)(ws + WS_WCQKV), false, scr, lane)) continue;
            transpose_family(it, a.in[I_CWO], 1, 1024, 1024, (bf16_t*)(ws + WS_WCO), false, scr, lane);
        }
    }
}

__device__ __forceinline__ void phase_norm(const Args& a, int layer, int sub, bool first, int nrows, bool addy, int nsplit) {
    const int tid_ = opaque_tid(), lane = tid_ & 63, gw = blockIdx.x * 8 + (tid_ >> 6), NGW = gridDim.x * 8;
    bf16_t* xs = (bf16_t*)(a.ws + WS_XS); bf16_t* hn = (bf16_t*)(a.ws + WS_HN);
    const float* mod = (const float*)(a.ws + WS_MOD) + (size_t)layer * 3 * 9216;
    const float* ng = a.in[I_NORMG] + ((size_t)layer * 3 + sub) * 1024;
    const bf16_t* yb = (const bf16_t*)(a.ws + WS_EXTRA);
    f32x4 gv[4];
#pragma unroll
    for (int j = 0; j < 4; ++j) gv[j] = *(const f32x4*)(ng + 4 * lane + 256 * j);
    constexpr int R = 4;
    for (int r0 = gw; r0 < MX; r0 += R * NGW) {
        f32x4 v[R][4]; u32x2 xx[R][4], yy[R][4]; int rowq[R]; bool okq[R];
#pragma unroll
        for (int q = 0; q < R; ++q) {
            okq[q] = r0 + q * NGW < MX; rowq[q] = okq[q] ? r0 + q * NGW : r0;
            if (first) {
#pragma unroll
                for (int j = 0; j < 4; ++j) v[q][j] = __builtin_nontemporal_load((const f32x4*)(a.in[I_X] + (size_t)rowq[q] * D + 4 * lane + 256 * j));
            } else {
#pragma unroll
                for (int j = 0; j < 4; ++j) xx[q][j] = __builtin_nontemporal_load((const u32x2*)(xs + (size_t)rowq[q] * D + 4 * lane + 256 * j));
            }
            if (addy) {
#pragma unroll
                for (int j = 0; j < 4; ++j) yy[q][j] = __builtin_nontemporal_load((const u32x2*)(yb + (size_t)rowq[q] * D + 4 * lane + 256 * j));
            }
        }
#pragma unroll
        for (int q = 0; q < R; ++q) {
            const int row = rowq[q];
            float s = 0.f;
#pragma unroll
            for (int j = 0; j < 4; ++j) {
                if (!first) { v[q][j][0] = bflo(xx[q][j].x); v[q][j][1] = bfhi(xx[q][j].x); v[q][j][2] = bflo(xx[q][j].y); v[q][j][3] = bfhi(xx[q][j].y); }
                if (addy) { v[q][j][0] += bflo(yy[q][j].x); v[q][j][1] += bfhi(yy[q][j].x); v[q][j][2] += bflo(yy[q][j].y); v[q][j][3] += bfhi(yy[q][j].y); }
                s += (v[q][j][0] * v[q][j][0] + v[q][j][1] * v[q][j][1]) + (v[q][j][2] * v[q][j][2] + v[q][j][3] * v[q][j][3]);
            }
            if ((first || addy) && okq[q]) {
#pragma unroll
                for (int j = 0; j < 4; ++j) { u32x2 o; o.x = cvt_pk_bf16(v[q][j][0], v[q][j][1]); o.y = cvt_pk_bf16(v[q][j][2], v[q][j][3]); __builtin_nontemporal_store(o, (u32x2*)(xs + (size_t)row * D + 4 * lane + 256 * j)); }
            }
            const float rstd = rsqrtf(wave_sum(s) * (1.0f / D) + 1e-6f);
            const float* shp = mod + (row >= SEQ ? 1 : 0) * 9216 + (sub * 3 + 0) * 1024; const float* scp = shp + 1024;
            if (okq[q]) {
#pragma unroll
                for (int j = 0; j < 4; ++j) {
                    const f32x4 sh = *(const f32x4*)(shp + 4 * lane + 256 * j), sc = *(const f32x4*)(scp + 4 * lane + 256 * j);
                    const f32x4 y = v[q][j] * rstd * gv[j] * (sc + 1.0f) + sh;
                    u32x2 o; o.x = cvt_pk_bf16(y[0], y[1]); o.y = cvt_pk_bf16(y[2], y[3]);
                    __builtin_nontemporal_store(o, (u32x2*)(hn + (size_t)row * D + 4 * lane + 256 * j));
                }
            }
        }
    }
    for (int row = MX + gw; row < nrows; row += NGW) {
        f32x4 v[4]; float s = 0.f;
        if (first) {
#pragma unroll
            for (int j = 0; j < 4; ++j) v[j] = *(const f32x4*)(a.in[I_CTX] + (size_t)(row - MX) * D + 4 * lane + 256 * j);
        } else {
#pragma unroll
            for (int j = 0; j < 4; ++j) { const u32x2 x2 = *(const u32x2*)(xs + (size_t)row * D + 4 * lane + 256 * j); v[j][0] = bflo(x2.x); v[j][1] = bfhi(x2.x); v[j][2] = bflo(x2.y); v[j][3] = bfhi(x2.y); }
        }
        if (addy) {
            const float* sr = (const float*)(a.ws + WS_SLAB) + (size_t)(row - MX) * D;
#pragma unroll 1
            for (int ks = 0; ks < nsplit; ++ks) {
#pragma unroll
                for (int j = 0; j < 4; ++j) v[j] += *(const f32x4*)(sr + (size_t)ks * MCTX * D + 4 * lane + 256 * j);
            }
        }
#pragma unroll
        for (int j = 0; j < 4; ++j) s += (v[j][0] * v[j][0] + v[j][1] * v[j][1]) + (v[j][2] * v[j][2] + v[j][3] * v[j][3]);
        if (first || addy) {
#pragma unroll
            for (int j = 0; j < 4; ++j) { u32x2 o; o.x = cvt_pk_bf16(v[j][0], v[j][1]); o.y = cvt_pk_bf16(v[j][2], v[j][3]); *(u32x2*)(xs + (size_t)row * D + 4 * lane + 256 * j) = o; }
        }
        const float rstd = rsqrtf(wave_sum(s) * (1.0f / D) + 1e-6f);
        const float* shp = mod + 2 * 9216 + (sub * 3 + 0) * 1024; const float* scp = shp + 1024;
#pragma unroll
        for (int j = 0; j < 4; ++j) {
            const f32x4 sh = *(const f32x4*)(shp + 4 * lane + 256 * j), sc = *(const f32x4*)(scp + 4 * lane + 256 * j);
            const f32x4 y = v[j] * rstd * gv[j] * (sc + 1.0f) + sh;
            u32x2 o; o.x = cvt_pk_bf16(y[0], y[1]); o.y = cvt_pk_bf16(y[2], y[3]);
            *(u32x2*)(hn + (size_t)row * D + 4 * lane + 256 * j) = o;
        }
    }
}
__device__ __forceinline__ void phase_final(const Args& a) {
    const int tid_ = opaque_tid(), lane = tid_ & 63, gw = blockIdx.x * 8 + (tid_ >> 6), NGW = gridDim.x * 8;
    const bf16_t* xs = (const bf16_t*)(a.ws + WS_XS);
    const bf16_t* yb = (const bf16_t*)(a.ws + WS_EXTRA);
    f32x4 gv[4];
#pragma unroll
    for (int j = 0; j < 4; ++j) gv[j] = *(const f32x4*)(a.in[I_FINALG] + 4 * lane + 256 * j);
    constexpr int R = 4;
    for (int r0 = gw; r0 < MX; r0 += R * NGW) {
        u32x2 xx[R][4], yy[R][4]; int rowq[R]; bool okq[R];
#pragma unroll
        for (int q = 0; q < R; ++q) {
            okq[q] = r0 + q * NGW < MX; rowq[q] = okq[q] ? r0 + q * NGW : r0;
#pragma unroll
            for (int j = 0; j < 4; ++j) { xx[q][j] = *(const u32x2*)(xs + (size_t)rowq[q] * D + 4 * lane + 256 * j); yy[q][j] = *(const u32x2*)(yb + (size_t)rowq[q] * D + 4 * lane + 256 * j); }
        }
#pragma unroll
        for (int q = 0; q < R; ++q) {
            float s = 0.f; f32x4 v[4];
#pragma unroll
            for (int j = 0; j < 4; ++j) {
                v[j][0] = bflo(xx[q][j].x) + bflo(yy[q][j].x); v[j][1] = bfhi(xx[q][j].x) + bfhi(yy[q][j].x); v[j][2] = bflo(xx[q][j].y) + bflo(yy[q][j].y); v[j][3] = bfhi(xx[q][j].y) + bfhi(yy[q][j].y);
                s += (v[j][0] * v[j][0] + v[j][1] * v[j][1]) + (v[j][2] * v[j][2] + v[j][3] * v[j][3]);
            }
            const float rstd = rsqrtf(wave_sum(s) * (1.0f / D) + 1e-6f);
            if (okq[q]) {
#pragma unroll
                for (int j = 0; j < 4; ++j) *(f32x4*)(a.out + (size_t)rowq[q] * D + 4 * lane + 256 * j) = v[j] * rstd * gv[j];
            }
        }
    }
}

__device__ __forceinline__ void phase_swa(LAS unsigned char* lds, const bf16_t* QKV, bf16_t* O, const float* sinks, bool need_ctx) {
    constexpr int LDQ = 1536, KS = 72, VS = 72;
    LAS bf16_t* Ks = (LAS bf16_t*)lds;
    LAS bf16_t* Vt = Ks + 64 * KS;
    const int tid = opaque_tid(), w = tid >> 6, lane = tid & 63, fr = lane & 15, fq = lane >> 4;
    const int lrow = tid >> 3, lcg = tid & 7;
    const int n_items = 2048 + (need_ctx ? 32 : 0);
    for (int item = blockIdx.x; item < n_items; item += gridDim.x) {
        const bool cq = item >= 2048;
        int b, hp, g, jb;
        if (!cq) { hp = item & 1; g = (item >> 1) & 3; jb = (item >> 3) & 127; b = item >> 10; }
        else { const int it = item - 2048; hp = it & 1; g = (it >> 1) & 3; jb = (it >> 3) & 1; b = it >> 4; }
        const int h = 4 * g + 2 * hp + (w >> 2), qsub = (w & 3) * 32;
        const int qrow0 = cq ? (MX + b * CTXL + jb * 128 + qsub) : (b * SEQ + jb * 128 + qsub);
        const int kcol0 = 1024 + g * 64, vcol0 = 1280 + g * 64;
        bf16x8 Qf[2][2];
#pragma unroll
        for (int qt = 0; qt < 2; ++qt)
#pragma unroll
            for (int k2 = 0; k2 < 2; ++k2) Qf[qt][k2] = *(const bf16x8*)(QKV + (size_t)(qrow0 + 16 * qt + fr) * LDQ + h * 64 + 32 * k2 + 8 * fq);
        f32x4 Oa[4][2];
#pragma unroll
        for (int dt = 0; dt < 4; ++dt)
#pragma unroll
            for (int qt = 0; qt < 2; ++qt) Oa[dt][qt] = (f32x4){0.f, 0.f, 0.f, 0.f};
        float mrun[2], lrun[2];
        { const float sk = sinks[h] * 1.4426950408889634f; mrun[0] = mrun[1] = sk; lrun[0] = lrun[1] = (fq == 0) ? 1.0f : 0.0f; }
        const int ntiles = cq ? 4 : 10;
#define SWA_KPOS(t_) (jb * 128 - 128 + 64 * ((t_) - 4))
#define SWA_VALID(t_) ((t_) < 4 || (SWA_KPOS(t_) >= 0 && SWA_KPOS(t_) < SEQ))
#define SWA_KROW(t_) ((t_) < 4 ? (MX + b * CTXL + 64 * (t_)) : (b * SEQ + SWA_KPOS(t_)))
        u32x4 kreg, vreg;
        int ti = 0;
        { const size_t ro = (size_t)(SWA_KROW(0) + lrow) * LDQ + 8 * lcg; kreg = *(const u32x4*)(QKV + ro + kcol0); vreg = *(const u32x4*)(QKV + ro + vcol0); }
        while (ti < ntiles) {
            __syncthreads();
            *(LAS u32x4*)(Ks + lrow * KS + 8 * lcg) = kreg;
            { LAS bf16_t* vp = Vt + (8 * lcg) * VS + lrow;
              vp[0 * VS] = (bf16_t)(vreg.x & 0xffff); vp[1 * VS] = (bf16_t)(vreg.x >> 16); vp[2 * VS] = (bf16_t)(vreg.y & 0xffff); vp[3 * VS] = (bf16_t)(vreg.y >> 16);
              vp[4 * VS] = (bf16_t)(vreg.z & 0xffff); vp[5 * VS] = (bf16_t)(vreg.z >> 16); vp[6 * VS] = (bf16_t)(vreg.w & 0xffff); vp[7 * VS] = (bf16_t)(vreg.w >> 16); }
            __syncthreads();
            int tn = ti + 1;
            while (tn < ntiles && !SWA_VALID(tn)) ++tn;
            if (tn < ntiles) { const size_t ro = (size_t)(SWA_KROW(tn) + lrow) * LDQ + 8 * lcg; kreg = *(const u32x4*)(QKV + ro + kcol0); vreg = *(const u32x4*)(QKV + ro + vcol0); }
            const int kpos0 = SWA_KPOS(ti);
            f32x4 s[4][2];
#pragma unroll
            for (int kt = 0; kt < 4; ++kt) {
                const bf16x8 k0 = *(const LAS bf16x8*)(Ks + (16 * kt + fr) * KS + 8 * fq);
                const bf16x8 k1 = *(const LAS bf16x8*)(Ks + (16 * kt + fr) * KS + 32 + 8 * fq);
#pragma unroll
                for (int qt = 0; qt < 2; ++qt) {
                    f32x4 z = (f32x4){0.f, 0.f, 0.f, 0.f};
                    z = __builtin_amdgcn_mfma_f32_16x16x32_bf16(k0, Qf[qt][0], z, 0, 0, 0);
                    s[kt][qt] = __builtin_amdgcn_mfma_f32_16x16x32_bf16(k1, Qf[qt][1], z, 0, 0, 0);
                }
            }
            if (ti >= 4) {
#pragma unroll
                for (int qt = 0; qt < 2; ++qt) {
                    const int qpos = jb * 128 + qsub + 16 * qt + fr;
#pragma unroll
                    for (int kt = 0; kt < 4; ++kt)
#pragma unroll
                        for (int j = 0; j < 4; ++j) { const int dlt = qpos - (kpos0 + 16 * kt + 4 * fq + j); if (dlt > 128 || dlt < -128) s[kt][qt][j] = -INFINITY; }
                }
            }
            bf16x8 Pf[2][2];
#pragma unroll
            for (int qt = 0; qt < 2; ++qt) {
                float mx = -INFINITY;
#pragma unroll
                for (int kt = 0; kt < 4; ++kt)
#pragma unroll
                    for (int j = 0; j < 4; ++j) mx = fmaxf(mx, s[kt][qt][j]);
                mx = fmaxf(mx, __shfl_xor(mx, 16)); mx = fmaxf(mx, __shfl_xor(mx, 32));
                const float mnew = fmaxf(mrun[qt], mx);
                const float alpha = __builtin_amdgcn_exp2f(mrun[qt] - mnew);
                mrun[qt] = mnew;
                float ls = 0.f;
                float p[4][4];
#pragma unroll
                for (int kt = 0; kt < 4; ++kt)
#pragma unroll
                    for (int j = 0; j < 4; ++j) { p[kt][j] = __builtin_amdgcn_exp2f(s[kt][qt][j] - mnew); ls += p[kt][j]; }
                lrun[qt] = lrun[qt] * alpha + ls;
#pragma unroll
                for (int dt = 0; dt < 4; ++dt) Oa[dt][qt] = Oa[dt][qt] * alpha;
#pragma unroll
                for (int k2 = 0; k2 < 2; ++k2) {
                    u32x4 pk; pk.x = cvt_pk_bf16(p[2 * k2][0], p[2 * k2][1]); pk.y = cvt_pk_bf16(p[2 * k2][2], p[2 * k2][3]);
                    pk.z = cvt_pk_bf16(p[2 * k2 + 1][0], p[2 * k2 + 1][1]); pk.w = cvt_pk_bf16(p[2 * k2 + 1][2], p[2 * k2 + 1][3]);
                    Pf[qt][k2] = __builtin_bit_cast(bf16x8, pk);
                }
            }
#pragma unroll
            for (int dt = 0; dt < 4; ++dt)
#pragma unroll
                for (int k2 = 0; k2 < 2; ++k2) {
                    const LAS bf16_t* vp = Vt + (16 * dt + fr) * VS + 32 * k2 + 4 * fq;
                    const u32x2 v0 = *(const LAS u32x2*)vp, v1 = *(const LAS u32x2*)(vp + 16);
                    u32x4 vv; vv.x = v0.x; vv.y = v0.y; vv.z = v1.x; vv.w = v1.y;
                    const bf16x8 vf = __builtin_bit_cast(bf16x8, vv);
#pragma unroll
                    for (int qt = 0; qt < 2; ++qt) Oa[dt][qt] = __builtin_amdgcn_mfma_f32_16x16x32_bf16(vf, Pf[qt][k2], Oa[dt][qt], 0, 0, 0);
                }
            ti = tn;
        }
#undef SWA_KPOS
#undef SWA_VALID
#undef SWA_KROW
#pragma unroll
        for (int qt = 0; qt < 2; ++qt) {
            float l = lrun[qt]; l += __shfl_xor(l, 16); l += __shfl_xor(l, 32);
            const float inv = 1.0f / l;
            bf16_t* op = O + (size_t)(qrow0 + 16 * qt + fr) * D + h * 64 + 4 * fq;
#pragma unroll
            for (int dt = 0; dt < 4; ++dt) { const f32x4 o = Oa[dt][qt] * inv; u32x2 pk; pk.x = cvt_pk_bf16(o[0], o[1]); pk.y = cvt_pk_bf16(o[2], o[3]); *(u32x2*)(op + 16 * dt) = pk; }
        }
    }
}

__device__ __forceinline__ void phase_nat(LAS unsigned char* lds, const bf16_t* QKV, const bf16_t* VT, bf16_t* O, const float* rpb, bool need_ctx) {
    constexpr int LDQ = 3072, KS = 264, VS = 72;
    LAS bf16_t* Ks = (LAS bf16_t*)lds;
    LAS bf16_t* Vt = Ks + 64 * KS;
    LAS float* rp = (LAS float*)(Vt + 256 * VS);
    const int tid = opaque_tid(), w = tid >> 6, lane = tid & 63, fr = lane & 15, fq = lane >> 4;
    const bool fast = gridDim.x == 256;
    const int xcd = blockIdx.x & 7, mloc = blockIdx.x >> 3;
    const int hg = fast ? (mloc & 3) : (blockIdx.x & 3);
    const int hw = w >> 1, h = 4 * hg + hw, qsub = (w & 1) * 32;
    __syncthreads();
    for (int e = tid; e < 4 * 465; e += 512) rp[e] = rpb[(size_t)(4 * hg) * 465 + e] * 1.4426950408889634f;
    int kc0[2], relb[2]; unsigned okm = 0u;
#pragma unroll
    for (int qt = 0; qt < 2; ++qt) {
        const int c0 = qsub + 16 * qt, c = c0 + fr;
        kc0[qt] = c0 - 8 < 0 ? 0 : (c0 - 8 > 32 ? 32 : c0 - 8);
        const int cst = c - 8 < 0 ? 0 : (c - 8 > 48 ? 48 : c - 8);
        relb[qt] = kc0[qt] + 4 * fq - c + 15;
#pragma unroll
        for (int i = 0; i < 2; ++i)
#pragma unroll
            for (int j = 0; j < 4; ++j) { const int kk = kc0[qt] + 16 * i + 4 * fq + j; if (kk >= cst && kk < cst + 16) okm |= 1u << (qt * 8 + i * 4 + j); }
    }
    const int n_items = 2048 + (need_ctx ? 32 : 0);
    for (int kk = 0; ; ++kk) {
        bool cq; int b, r, rs = 0;
        if (fast) {
            if (kk < 8) { const int G = kk * 8 + xcd; cq = false; b = G >> 5; r = ((G & 31) << 3) + (mloc >> 2); }
            else if (kk == 8 && need_ctx && blockIdx.x < 32) { const int it = ((blockIdx.x & 7) << 2) | (blockIdx.x >> 3); cq = true; b = it >> 4; r = (it >> 2) & 3; }
            else break;
        } else {
            const int item = blockIdx.x + kk * gridDim.x;
            if (item >= n_items) break;
            cq = item >= 2048;
            if (!cq) { r = (item >> 2) & 255; b = item >> 10; } else { const int it = item - 2048; r = (it >> 2) & 3; b = it >> 4; }
        }
        if (!cq) rs = r - 4 < 0 ? 0 : (r - 4 > 248 ? 248 : r - 4);
        const int qrow0 = cq ? (MX + b * CTXL + r * 64 + qsub) : (b * SEQ + r * 64 + qsub);
        const int ntiles = cq ? 4 : 12;
        bf16x8 Qf[2][2];
#pragma unroll
        for (int qt = 0; qt < 2; ++qt)
#pragma unroll
            for (int k2 = 0; k2 < 2; ++k2) Qf[qt][k2] = *(const bf16x8*)(QKV + (size_t)(qrow0 + 16 * qt + fr) * LDQ + h * 64 + 32 * k2 + 8 * fq);
        f32x4 Oa[4][2];
#pragma unroll
        for (int dt = 0; dt < 4; ++dt)
#pragma unroll
            for (int qt = 0; qt < 2; ++qt) Oa[dt][qt] = (f32x4){0.f, 0.f, 0.f, 0.f};
        float mrun[2] = {-INFINITY, -INFINITY}, lrun[2] = {0.f, 0.f};
        u32x4 kreg[4], vreg[4];
        const bf16_t* vtx = VT + (size_t)(b * 16 + 4 * hg) * 64 * SEQ;
        const bf16_t* vtc = VT + (size_t)2 * 16 * 64 * SEQ + (size_t)(b * 16 + 4 * hg) * 64 * CTXL;
#define NAT_LOAD(ti_) do { const int _ti = (ti_); \
            const bool _c = _ti < 4; const int _krow0 = _c ? (MX + b * CTXL + 64 * _ti) : (b * SEQ + (rs + _ti - 4) * 64); \
            const bf16_t* _vb = _c ? vtc + 64 * _ti : vtx + (rs + _ti - 4) * 64; const size_t _vs = _c ? (size_t)CTXL : (size_t)SEQ; \
            _Pragma("unroll") for (int _i = 0; _i < 4; ++_i) { const int _cx = tid + 512 * _i; \
                kreg[_i] = *(const u32x4*)(QKV + (size_t)(_krow0 + (_cx >> 5)) * LDQ + 1024 + hg * 256 + 8 * (_cx & 31)); \
                vreg[_i] = *(const u32x4*)(_vb + (size_t)(_cx >> 3) * _vs + 8 * (_cx & 7)); } } while (0)
        NAT_LOAD(0);
#pragma unroll 1
        for (int ti = 0; ti < ntiles; ++ti) {
            __syncthreads();
#pragma unroll
            for (int i = 0; i < 4; ++i) { const int cx = tid + 512 * i;
                *(LAS u32x4*)(Ks + (cx >> 5) * KS + 8 * (cx & 31)) = kreg[i];
                *(LAS u32x4*)(Vt + (cx >> 3) * VS + 8 * (cx & 7)) = vreg[i]; }
            __syncthreads();
            if (ti + 1 < ntiles) NAT_LOAD(ti + 1);
            if (ti < 4) {
#pragma unroll
                for (int qt = 0; qt < 2; ++qt) {
                    f32x4 s[4];
#pragma unroll
                    for (int kt = 0; kt < 4; ++kt) {
                        const bf16x8 k0 = *(const LAS bf16x8*)(Ks + (16 * kt + fr) * KS + hw * 64 + 8 * fq);
                        const bf16x8 k1 = *(const LAS bf16x8*)(Ks + (16 * kt + fr) * KS + hw * 64 + 32 + 8 * fq);
                        f32x4 z = (f32x4){0.f, 0.f, 0.f, 0.f};
                        z = __builtin_amdgcn_mfma_f32_16x16x32_bf16(k0, Qf[qt][0], z, 0, 0, 0);
                        s[kt] = __builtin_amdgcn_mfma_f32_16x16x32_bf16(k1, Qf[qt][1], z, 0, 0, 0);
                    }
                    float mx = -INFINITY;
#pragma unroll
                    for (int kt = 0; kt < 4; ++kt)
#pragma unroll
                        for (int j = 0; j < 4; ++j) mx = fmaxf(mx, s[kt][j]);
                    mx = fmaxf(mx, __shfl_xor(mx, 16)); mx = fmaxf(mx, __shfl_xor(mx, 32));
                    const float mnew = fmaxf(mrun[qt], mx), alpha = __builtin_amdgcn_exp2f(mrun[qt] - mnew);
                    mrun[qt] = mnew;
                    float ls = 0.f;
#pragma unroll
                    for (int kt = 0; kt < 4; ++kt)
#pragma unroll
                        for (int j = 0; j < 4; ++j) { s[kt][j] = __builtin_amdgcn_exp2f(s[kt][j] - mnew); ls += s[kt][j]; }
                    lrun[qt] = lrun[qt] * alpha + ls;
#pragma unroll
                    for (int dt = 0; dt < 4; ++dt) Oa[dt][qt] = Oa[dt][qt] * alpha;
#pragma unroll
                    for (int k2 = 0; k2 < 2; ++k2) {
                        u32x4 pk; pk.x = cvt_pk_bf16(s[2 * k2][0], s[2 * k2][1]); pk.y = cvt_pk_bf16(s[2 * k2][2], s[2 * k2][3]);
                        pk.z = cvt_pk_bf16(s[2 * k2 + 1][0], s[2 * k2 + 1][1]); pk.w = cvt_pk_bf16(s[2 * k2 + 1][2], s[2 * k2 + 1][3]);
                        const bf16x8 pf = __builtin_bit_cast(bf16x8, pk);
#pragma unroll
                        for (int dt = 0; dt < 4; ++dt) {
                            const LAS bf16_t* vp = Vt + (hw * 64 + 16 * dt + fr) * VS + 32 * k2 + 4 * fq;
                            const u32x2 v0 = *(const LAS u32x2*)vp, v1 = *(const LAS u32x2*)(vp + 16);
                            u32x4 vv; vv.x = v0.x; vv.y = v0.y; vv.z = v1.x; vv.w = v1.y;
                            Oa[dt][qt] = __builtin_amdgcn_mfma_f32_16x16x32_bf16(__builtin_bit_cast(bf16x8, vv), pf, Oa[dt][qt], 0, 0, 0);
                        }
                    }
                }
            } else {
                const LAS float* rrow = rp + hw * 465 + ((rs + ti - 4) - r + 7) * 31;
#pragma unroll
                for (int qt = 0; qt < 2; ++qt) {
                    f32x4 s[2];
#pragma unroll
                    for (int i = 0; i < 2; ++i) {
                        const LAS bf16_t* kp = Ks + (kc0[qt] + 16 * i + fr) * KS + hw * 64 + 8 * fq;
                        f32x4 z = (f32x4){0.f, 0.f, 0.f, 0.f};
                        z = __builtin_amdgcn_mfma_f32_16x16x32_bf16(*(const LAS bf16x8*)kp, Qf[qt][0], z, 0, 0, 0);
                        s[i] = __builtin_amdgcn_mfma_f32_16x16x32_bf16(*(const LAS bf16x8*)(kp + 32), Qf[qt][1], z, 0, 0, 0);
                    }
                    const LAS float* bp = rrow + relb[qt];
                    float mx = -INFINITY;
#pragma unroll
                    for (int i = 0; i < 2; ++i)
#pragma unroll
                        for (int j = 0; j < 4; ++j) { const bool ok = (okm >> (qt * 8 + i * 4 + j)) & 1u; const float bv = bp[16 * i + j];
                            s[i][j] = ok ? s[i][j] + bv : -INFINITY; mx = fmaxf(mx, s[i][j]); }
                    mx = fmaxf(mx, __shfl_xor(mx, 16)); mx = fmaxf(mx, __shfl_xor(mx, 32));
                    const float mnew = fmaxf(mrun[qt], mx), alpha = __builtin_amdgcn_exp2f(mrun[qt] - mnew);
                    mrun[qt] = mnew;
                    float ls = 0.f;
#pragma unroll
                    for (int i = 0; i < 2; ++i)
#pragma unroll
                        for (int j = 0; j < 4; ++j) { s[i][j] = __builtin_amdgcn_exp2f(s[i][j] - mnew); ls += s[i][j]; }
                    lrun[qt] = lrun[qt] * alpha + ls;
                    u32x4 pk; pk.x = cvt_pk_bf16(s[0][0], s[0][1]); pk.y = cvt_pk_bf16(s[0][2], s[0][3]); pk.z = cvt_pk_bf16(s[1][0], s[1][1]); pk.w = cvt_pk_bf16(s[1][2], s[1][3]);
                    const bf16x8 pf = __builtin_bit_cast(bf16x8, pk);
#pragma unroll
                    for (int dt = 0; dt < 4; ++dt) {
                        const LAS bf16_t* vp = Vt + (hw * 64 + 16 * dt + fr) * VS + kc0[qt] + 4 * fq;
                        const u32x2 v0 = *(const LAS u32x2*)vp, v1 = *(const LAS u32x2*)(vp + 16);
                        u32x4 vv; vv.x = v0.x; vv.y = v0.y; vv.z = v1.x; vv.w = v1.y;
                        Oa[dt][qt] = __builtin_amdgcn_mfma_f32_16x16x32_bf16(__builtin_bit_cast(bf16x8, vv), pf, Oa[dt][qt] * alpha, 0, 0, 0);
                    }
                }
            }
        }
#undef NAT_LOAD
#pragma unroll
        for (int qt = 0; qt < 2; ++qt) {
            float l = lrun[qt]; l += __shfl_xor(l, 16); l += __shfl_xor(l, 32);
            const float inv = 1.0f / l;
            bf16_t* op = O + (size_t)(qrow0 + 16 * qt + fr) * D + h * 64 + 4 * fq;
#pragma unroll
            for (int dt = 0; dt < 4; ++dt) { const f32x4 o = Oa[dt][qt] * inv; u32x2 pk; pk.x = cvt_pk_bf16(o[0], o[1]); pk.y = cvt_pk_bf16(o[2], o[3]); *(u32x2*)(op + 16 * dt) = pk; }
        }
    }
}

struct RnnP { const bf16_t* GXR; const bf16_t* Wg; const float* gate_b; const float* lam; const float* conv_w; const float* conv_b; float* PE; float* CIN; bf16_t* Y; };

template <int DIR>
__device__ __forceinline__ void rnn_dir(const RnnP& P, const LAS bf16_t* xc, LAS float* hfl, LAS bf16_t* cat, int nb, int b, int cc, int w, int fr, int fq) {
    const int ch = nb * 128 + 16 * w + fr;
    bf16x8 Bf[2][4];
#pragma unroll
    for (int gt = 0; gt < 2; ++gt)
#pragma unroll
        for (int ks = 0; ks < 4; ++ks) Bf[gt][ks] = *(const bf16x8*)(P.Wg + ((size_t)((DIR * 2 + gt) * 12 + nb) * 128 + 16 * w + fr) * 128 + 32 * ks + 8 * fq);
    constexpr float LOG2E = 1.4426950408889634f;
    const float nbr = -LOG2E * P.gate_b[(DIR * 2 + 0) * DRNN + ch], nbi = -LOG2E * P.gate_b[(DIR * 2 + 1) * DRNN + ch];
    const float nlam = -P.lam[DIR * DRNN + ch];
    const float sp = nlam > 20.0f ? nlam : log1pf(expf(nlam));
    const float c_la = -8.0f * LOG2E * sp, c_x2 = -16.0f * sp;
    float hrun = 0.f, prun = 1.f;
#pragma unroll
    for (int step = 0; step < 8; ++step) {
        const int mt = DIR == 0 ? step : 7 - step;
        f32x4 zr = (f32x4){0.f, 0.f, 0.f, 0.f}, zi = zr;
#pragma unroll
        for (int ks = 0; ks < 4; ++ks) {
            const bf16x8 af = *(const LAS bf16x8*)(xc + (16 * mt + fr) * 136 + 32 * ks + 8 * fq);
            zr = __builtin_amdgcn_mfma_f32_16x16x32_bf16(af, Bf[0][ks], zr, 0, 0, 0);
            zi = __builtin_amdgcn_mfma_f32_16x16x32_bf16(af, Bf[1][ks], zi, 0, 0, 0);
        }
        f32x4 xv4, er, ei, rg, ig, av, om, bv;
#pragma unroll
        for (int j = 0; j < 4; ++j) xv4[j] = bf2f(xc[(16 * mt + 4 * fq + j) * 136 + 16 * w + fr]);
        const f32x4 tr_ = zr * (-LOG2E) + nbr, ti_ = zi * (-LOG2E) + nbi;
#pragma unroll
        for (int j = 0; j < 4; ++j) { er[j] = __builtin_amdgcn_exp2f(tr_[j]); ei[j] = __builtin_amdgcn_exp2f(ti_[j]); }
        er = er + 1.0f; ei = ei + 1.0f;
#pragma unroll
        for (int j = 0; j < 4; ++j) { rg[j] = __builtin_amdgcn_rcpf(er[j]); ig[j] = __builtin_amdgcn_rcpf(ei[j]); }
        const f32x4 la2 = rg * c_la, x2 = rg * c_x2;
#pragma unroll
        for (int j = 0; j < 4; ++j) av[j] = __builtin_amdgcn_exp2f(la2[j]);
        const f32x4 xk = __builtin_elementwise_max(x2, (f32x4){-0.1f, -0.1f, -0.1f, -0.1f});
        const f32x4 ser = -xk * (xk * 0.5f * (xk * (1.0f / 3.0f) * (xk * 0.25f * (xk * 0.2f + 1.0f) + 1.0f) + 1.0f) + 1.0f);
        const f32x4 big = 1.0f - av * av;
        const f32x4 omv = (x2 > -0.1f) ? ser : big;
#pragma unroll
        for (int j = 0; j < 4; ++j) om[j] = __builtin_amdgcn_sqrtf(omv[j]);
        bv = om * (ig * xv4);
        float cumA[4], hl[4];
        if (DIR == 0) { cumA[0] = av[0]; hl[0] = bv[0];
#pragma unroll
            for (int j = 1; j < 4; ++j) { hl[j] = av[j] * hl[j - 1] + bv[j]; cumA[j] = av[j] * cumA[j - 1]; }
        } else { cumA[3] = av[3]; hl[3] = bv[3];
#pragma unroll
            for (int j = 2; j >= 0; --j) { hl[j] = av[j] * hl[j + 1] + bv[j]; cumA[j] = av[j] * cumA[j + 1]; }
        }
        const float PAl = DIR == 0 ? cumA[3] : cumA[0], HBl = DIR == 0 ? hl[3] : hl[0];
        float cin = hrun, mycin = 0.f, mypp = 1.f;
#pragma unroll
        for (int qq = 0; qq < 4; ++qq) {
            const int q = DIR == 0 ? qq : 3 - qq;
            const float pa = __shfl(PAl, fr + 16 * q), hb = __shfl(HBl, fr + 16 * q);
            if (q == fq) { mycin = cin; mypp = prun; }
            cin = pa * cin + hb; prun *= pa;
        }
        hrun = cin;
#pragma unroll
        for (int j = 0; j < 4; ++j) {
            const int tok = 16 * mt + 4 * fq + j;
            const float hv = hl[j] + cumA[j] * mycin;
            const unsigned cq = (unsigned)(cumA[j] * mypp * 255.0f + 0.5f);
            LAS float* hp = hfl + tok * 132 + 16 * w + fr;
            LAS bf16_t* cp = cat + tok * 136 + 16 * w + fr;
            if (DIR == 0) { *hp = hv; *cp = (bf16_t)cq; }
            else { *(LAS unsigned*)hp = cvt_pk_bf16(*hp + hv, 0.f) & 0xffffu; *cp = (bf16_t)((unsigned)*cp | (cq << 8)); }
        }
    }
    if (fq == 0) { float* Pp = P.PE + (size_t)((b * 2 + DIR) * NCHUNK + cc) * DRNN + ch; Pp[0] = prun; Pp[PE_HALF] = hrun; }
}

__device__ __forceinline__ void phase_rnn_carry(const RnnP& P) {
    const int tid = opaque_tid();
    if (tid >= 24) return;
    const int chain = blockIdx.x * 24 + tid;
    if (chain >= 2 * 2 * DRNN) return;
    const int ch = chain % DRNN, bd = chain / DRNN, dir = bd & 1;
    const float* Pp = P.PE + (size_t)(bd * NCHUNK) * DRNN + ch; const float* Ep = Pp + PE_HALF;
    float* Cp = P.CIN + (size_t)(bd * NCHUNK) * DRNN + ch;
    float h = 0.f;
#pragma unroll 1
    for (int p0 = 0; p0 < NCHUNK; p0 += 13) {
        float pv[13], ev[13];
#pragma unroll
        for (int k = 0; k < 13; ++k) { const int p = p0 + k; const int c2 = dir == 0 ? p : (p == 0 ? 1 : (p == 1 ? 0 : 131 - p)); pv[k] = Pp[(size_t)c2 * DRNN]; ev[k] = Ep[(size_t)c2 * DRNN]; }
#pragma unroll
        for (int k = 0; k < 13; ++k) { const int p = p0 + k; const int c2 = dir == 0 ? p : (p == 0 ? 1 : (p == 1 ? 0 : 131 - p)); Cp[(size_t)c2 * DRNN] = h; h = pv[k] * h + ev[k]; }
    }
}

__device__ __forceinline__ void phase_rnn(LAS unsigned char* lds, const RnnP& P, bf16_t* HS, bf16_t* CA) {
    LAS bf16_t* xc = (LAS bf16_t*)lds;
    LAS float* hfl = (LAS float*)(lds + 34816);
    LAS bf16_t* cat = (LAS bf16_t*)(lds + 102400);
    const int tid = opaque_tid(), w = tid >> 6, lane = tid & 63, fr = lane & 15, fq = lane >> 4;
    const int cg = tid & 15, tr = tid >> 4;
    u32x4 nx[7];
#define RNN_FETCH(item_) do { const int _it = (item_); const int _nb = _it % 12, _c = _it / 12, _b = _c / NCHUNK, _cc = _c % NCHUNK; \
        const int _seq0 = _cc < 2 ? MX + _b * CTXL : _b * SEQ, _len = _cc < 2 ? CTXL : SEQ, _t0 = _cc < 2 ? _cc * 128 : (_cc - 2) * 128; \
        _Pragma("unroll") for (int _r = 0; _r < 7; ++_r) { const int _tt = _t0 + 4 * tr + _r - 1; \
            nx[_r] = (_tt >= 0 && _tt < _len) ? *(const u32x4*)(P.GXR + (size_t)(_seq0 + _tt) * 3072 + DRNN + _nb * 128 + 8 * cg) : (u32x4){0u, 0u, 0u, 0u}; } } while (0)
    if ((int)blockIdx.x < 2 * NCHUNK * 12) RNN_FETCH((int)blockIdx.x);
    for (int item = blockIdx.x; item < 2 * NCHUNK * 12; item += gridDim.x) {
        const int nb = item % 12, c = item / 12, b = c / NCHUNK, cc = c % NCHUNK;
        const int seq0 = cc < 2 ? MX + b * CTXL : b * SEQ, t0 = cc < 2 ? cc * 128 : (cc - 2) * 128;
        __syncthreads();
        {
            const int ch0 = nb * 128 + 8 * cg;
            float cw[4][8], cb[8];
#pragma unroll
            for (int k = 0; k < 4; ++k) { const f32x4 a0 = *(const f32x4*)(P.conv_w + k * DRNN + ch0), a1 = *(const f32x4*)(P.conv_w + k * DRNN + ch0 + 4);
#pragma unroll
                for (int e = 0; e < 4; ++e) { cw[k][e] = a0[e]; cw[k][4 + e] = a1[e]; } }
            { const f32x4 a0 = *(const f32x4*)(P.conv_b + ch0), a1 = *(const f32x4*)(P.conv_b + ch0 + 4);
#pragma unroll
                for (int e = 0; e < 4; ++e) { cb[e] = a0[e]; cb[4 + e] = a1[e]; } }
#pragma unroll
            for (int q = 0; q < 4; ++q) {
                float acc[8];
#pragma unroll
                for (int e = 0; e < 8; ++e) acc[e] = cb[e];
#pragma unroll
                for (int k = 0; k < 4; ++k) {
                    const u32x4 v = nx[q + k];
                    acc[0] += bflo(v.x) * cw[k][0]; acc[1] += bfhi(v.x) * cw[k][1]; acc[2] += bflo(v.y) * cw[k][2]; acc[3] += bfhi(v.y) * cw[k][3];
                    acc[4] += bflo(v.z) * cw[k][4]; acc[5] += bfhi(v.z) * cw[k][5]; acc[6] += bflo(v.w) * cw[k][6]; acc[7] += bfhi(v.w) * cw[k][7];
                }
                u32x4 o; o.x = cvt_pk_bf16(acc[0], acc[1]); o.y = cvt_pk_bf16(acc[2], acc[3]); o.z = cvt_pk_bf16(acc[4], acc[5]); o.w = cvt_pk_bf16(acc[6], acc[7]);
                *(LAS u32x4*)(xc + (4 * tr + q) * 136 + 8 * cg) = o;
            }
        }
        __syncthreads();
        if (item + (int)gridDim.x < 2 * NCHUNK * 12) RNN_FETCH(item + (int)gridDim.x);
        rnn_dir<0>(P, xc, hfl, cat, nb, b, cc, w, fr, fq);
        rnn_dir<1>(P, xc, hfl, cat, nb, b, cc, w, fr, fq);
        __syncthreads();
#pragma unroll
        for (int i = 0; i < 4; ++i) {
            const int cidx = tid + 512 * i, t = cidx >> 4, cg = cidx & 15;
            const size_t go = (size_t)(seq0 + t0 + t) * DRNN + nb * 128 + 8 * cg;
            const u32x4 h0 = *(const LAS u32x4*)(hfl + t * 132 + 8 * cg), h1 = *(const LAS u32x4*)(hfl + t * 132 + 8 * cg + 4);
            u32x4 o; o.x = (h0.x & 0xffffu) | (h0.y << 16); o.y = (h0.z & 0xffffu) | (h0.w << 16); o.z = (h1.x & 0xffffu) | (h1.y << 16); o.w = (h1.z & 0xffffu) | (h1.w << 16);
            *(u32x4*)(HS + go) = o;
            *(u32x4*)(CA + go) = *(const LAS u32x4*)(cat + t * 136 + 8 * cg);
        }
    }
}

#undef RNN_FETCH
__device__ __forceinline__ void phase_rnn_out(const RnnP& P, bf16_t* HS, const bf16_t* CA, bool need_ctx) {
    const int tid_ = opaque_tid(), lane = tid_ & 63, gw = blockIdx.x * 8 + (tid_ >> 6), NGW = gridDim.x * 8;
    const int nrows = need_ctx ? MT : MX;
    for (int row = gw; row < nrows; row += NGW) {
        int b, cc;
        if (row < MX) { b = row >> 14; cc = 2 + ((row & (SEQ - 1)) >> 7); } else { const int rc = row - MX; b = rc >> 8; cc = (rc & 255) >> 7; }
        const float* cf = P.CIN + (size_t)((b * 2 + 0) * NCHUNK + cc) * DRNN; const float* cbk = P.CIN + (size_t)((b * 2 + 1) * NCHUNK + cc) * DRNN;
#pragma unroll
        for (int k = 0; k < 3; ++k) {
            const int ch0 = 8 * (lane + 64 * k);
            const u32x4 hs = *(const u32x4*)(HS + (size_t)row * DRNN + ch0), ca = *(const u32x4*)(CA + (size_t)row * DRNN + ch0), gg = *(const u32x4*)(P.GXR + (size_t)row * 3072 + ch0);
            const f32x4 f0 = *(const f32x4*)(cf + ch0), f1 = *(const f32x4*)(cf + ch0 + 4), b0 = *(const f32x4*)(cbk + ch0), b1 = *(const f32x4*)(cbk + ch0 + 4);
            const unsigned hsw[4] = {hs.x, hs.y, hs.z, hs.w}, caw[4] = {ca.x, ca.y, ca.z, ca.w}, ggw[4] = {gg.x, gg.y, gg.z, gg.w};
            unsigned ow[4];
#pragma unroll
            for (int e = 0; e < 4; ++e) {
                const float cfl = e < 2 ? f0[2 * e] : f1[2 * e - 4], cfh = e < 2 ? f0[2 * e + 1] : f1[2 * e - 3];
                const float cbl = e < 2 ? b0[2 * e] : b1[2 * e - 4], cbh = e < 2 ? b0[2 * e + 1] : b1[2 * e - 3];
                const unsigned cw_ = caw[e];
                const float hl_ = bflo(hsw[e]) + (float)(cw_ & 0xffu) * (1.0f / 255.0f) * cfl + (float)((cw_ >> 8) & 0xffu) * (1.0f / 255.0f) * cbl;
                const float hh_ = bfhi(hsw[e]) + (float)((cw_ >> 16) & 0xffu) * (1.0f / 255.0f) * cfh + (float)(cw_ >> 24) * (1.0f / 255.0f) * cbh;
                const float gl = bflo(ggw[e]), gh = bfhi(ggw[e]);
                const float yl = hl_ * gl * __builtin_amdgcn_rcpf(1.0f + __builtin_amdgcn_exp2f(gl * (-2.302208198f - 0.1029432397f * gl * gl)));
                const float yh = hh_ * gh * __builtin_amdgcn_rcpf(1.0f + __builtin_amdgcn_exp2f(gh * (-2.302208198f - 0.1029432397f * gh * gh)));
                ow[e] = cvt_pk_bf16(yl, yh);
            }
            u32x4 o; o.x = ow[0]; o.y = ow[1]; o.z = ow[2]; o.w = ow[3];
            *(u32x4*)(HS + (size_t)row * DRNN + ch0) = o;
        }
    }
}

#ifndef DBL
#define DBL 0
#endif
#ifndef PHM
#define PHM 0xFFFF
#endif
enum { OP_SKIP = 0, OP_NORM, OP_GS, OP_GR, OP_GB, OP_GROPE, OP_RNN1, OP_RNN2, OP_RNN3, OP_ATT0, OP_ATT1 };

__global__ void __launch_bounds__(512, 2) fwd_megakernel(Args a) {
    extern __shared__ __attribute__((aligned(16))) unsigned char shm[];
    LAS unsigned char* lds = (LAS unsigned char*)shm;
    cg::grid_group grid = cg::this_grid();

    if (blockIdx.x == 0) { unsigned* bw = (unsigned*)(a.ws + WS_BAR); for (int e = threadIdx.x; e < XCD_BAR_WORDS; e += 512) bw[e] = 0u; }
    volatile LAS unsigned* xbst = (volatile LAS unsigned*)(lds + LDS_XB);
    if (threadIdx.x == 0) { xbst[0] = 0u; xbst[1] = 0u; xbst[2] = 0u; xbst[3] = 0u; }
#if PHM & 1
    for (int rep = 0; rep < ((DBL & 1) ? 2 : 1); ++rep) { phase_prep(a, lds); __syncthreads(); }
#endif
    grid.sync();
    const XcdBarrier xb = xcd_barrier_post((unsigned*)(a.ws + WS_BAR), xbst);
#pragma unroll 1
    for (int i = 0; i < NLAYER; ++i) {
        const int kind = i % 3, j = i / 3;
        const bool need_ctx = i < NLAYER - 1;
        const int MO = need_ctx ? MT : MX;
#pragma unroll 1
        for (int op = 0; op < 12; ++op) {
            unsigned char* ws = a.ws + opaque_zero();
            float* xs = (float*)(ws + WS_XS);
            bf16_t* HN = (bf16_t*)(ws + WS_HN);
            bf16_t* ACT = (bf16_t*)(ws + WS_ACT);
            const float* modl = (const float*)(ws + WS_MOD) + (size_t)i * 3 * 9216;
            int type;
            switch (op) {
                case 0: case 3: case 9: type = OP_NORM; break;
                case 1: case 10: type = OP_GS; break;
                case 2: case 8: case 11: type = OP_GR; break;
                case 4: type = kind == 1 ? OP_GROPE : OP_GB; break;
                case 5: type = kind == 0 ? OP_RNN1 : (kind == 1 ? OP_ATT0 : OP_ATT1); break;
                case 6: type = kind == 0 ? OP_RNN2 : OP_SKIP; break;
                default: type = kind == 0 ? OP_RNN3 : OP_SKIP; break;
            }
            if (type == OP_SKIP) continue;
            if (type == OP_NORM) {
                const int sub = op == 0 ? 0 : (op == 3 ? 1 : 2);
#if PHM & 2
                for (int rep = 0; rep < ((DBL & 2) ? 2 : 1); ++rep) phase_norm(a, i, sub, (i == 0) && (op == 0), op == 9 ? MO : MT, !((i == 0) && (op == 0)), op == 9 ? (kind == 0 ? 6 : 4) : 11);
#endif
            } else if (type == OP_GS || type == OP_GR || type == OP_GB || type == OP_GROPE) {
                pg8::Gemm g; EpiAny E;
                E.e0.out = ACT;
                E.e1.slab = (float*)(ws + WS_SLAB); E.e1.y = (bf16_t*)(ws + WS_EXTRA); E.e1.gate = modl; E.e1.coef = 0.5f;
                E.e2.out = ACT; E.e2.ldc = 3072; E.e2.qcols = kind == 0 ? 0 : 1024; E.e2.qscale = 0.125f * 1.4426950408889634f; E.e2.vt = kind == 2 ? (bf16_t*)(ws + WS_EXTRA) : (bf16_t*)nullptr;
                E.e3.out = ACT; E.e3.rope = (const float*)(ws + WS_ROPE);
                if (type == OP_GS) {
                    const int which = op == 1 ? 0 : 1;
                    E.mode = 0; g.A = HN; g.Bt = (const bf16_t*)(ws + WS_WGU) + (size_t)(i * 2 + which) * 5632 * 1024; g.M = which == 0 ? MT : MO; g.N = 5632; g.K = 1024;
                } else if (type == OP_GR) {
                    E.mode = 1;
                    if (op == 8) {
                        g.A = HN; g.M = MO; g.N = 1024; g.K = kind == 0 ? 1536 : 1024;
                        g.Bt = kind == 0 ? (const bf16_t*)(ws + WS_WAOUT) + (size_t)j * 1024 * 1536 : (kind == 1 ? (const bf16_t*)(ws + WS_WBO) : (const bf16_t*)(ws + WS_WCO));
                        E.e1.gate = modl + (1 * 3 + 2) * 1024; E.e1.coef = 1.0f;
                    } else {
                        const int which = op == 2 ? 0 : 1;
                        g.A = ACT; g.M = which == 0 ? MT : MO; g.N = 1024; g.K = 2816;
                        g.Bt = (const bf16_t*)(ws + WS_WDN) + (size_t)(i * 2 + which) * 1024 * 2816;
                        E.e1.gate = modl + ((which == 0 ? 0 : 2) * 3 + 2) * 1024; E.e1.coef = 0.5f;
                    }
                } else if (type == OP_GB) {
                    E.mode = 2; g.A = HN; g.Bt = kind == 0 ? (const bf16_t*)(ws + WS_WAIN) + (size_t)j * 3072 * 1024 : (const bf16_t*)(ws + WS_WCQKV); g.M = MT; g.N = 3072; g.K = 1024;
                } else {
                    E.mode = 3; g.A = HN; g.Bt = (const bf16_t*)(ws + WS_WBQKV); g.M = MT; g.N = 1536; g.K = 1024;
                }
                pg8::StaticOrder S; S.init(g.M, g.N, g.K, (int)gridDim.x, (int)blockIdx.x, type == OP_GR);
#if PHM & 64
                { const int nrep = ((DBL & 64) || ((DBL & 256) && type == OP_GR) || ((DBL & 512) && type == OP_GS)) ? 2 : 1; const float coef_real = E.e1.coef;
                  for (int rep = 0; rep < nrep; ++rep) { E.e1.coef = rep == nrep - 1 ? coef_real : 0.f; pg8::gemm_phase(lds, g, S, E); } }
#endif
            } else if (type == OP_RNN1 || type == OP_RNN2 || type == OP_RNN3) {
                RnnP P{ACT, (const bf16_t*)(ws + WS_WAG) + (size_t)j * 48 * 128 * 128, a.in[I_AGATEB] + (size_t)j * 4 * DRNN, a.in[I_ALAM] + (size_t)j * 2 * DRNN,
                       a.in[I_ACONVW] + (size_t)j * 4 * DRNN, a.in[I_ACONVB] + (size_t)j * DRNN, (float*)(ws + WS_PE), (float*)(ws + WS_CIN), HN};
                if (type == OP_RNN2) phase_rnn_carry(P);
#if PHM & 4
                for (int rep = 0; rep < ((DBL & 4) ? 2 : 1); ++rep) if (type == OP_RNN1) phase_rnn(lds, P, HN, (bf16_t*)(ws + WS_EXTRA));
#endif
#if PHM & 8
                if (type == OP_RNN3) phase_rnn_out(P, HN, (const bf16_t*)(ws + WS_EXTRA), need_ctx);
#endif
            } else if (type == OP_ATT0) {
#if PHM & 16
                for (int rep = 0; rep < ((DBL & 16) ? 2 : 1); ++rep) phase_swa(lds, ACT, HN, a.in[I_BSINKS] + (size_t)j * 16, need_ctx);
#endif
            } else {
#if PHM & 32
                for (int rep = 0; rep < ((DBL & 32) ? 2 : 1); ++rep) phase_nat(lds, ACT, (const bf16_t*)(ws + WS_EXTRA), HN, a.in[I_CRPB] + (size_t)j * 16 * 465, need_ctx);
#endif
            }
            xcd_barrier(xb);
#if DBL & 128
            xcd_barrier(xb);
#endif
        }
    }
#if PHM & 2
    phase_final(a);
#endif
}

extern "C" void kernel_launch(void* const* d_in, const int* in_sizes, int n_in, void* d_out, int out_size, void* d_ws, size_t ws_size, hipStream_t stream) {
    static int grid_blocks = 0;
    if (grid_blocks == 0) {
        if (n_in != 23 || ws_size < WS_END) { fprintf(stderr, "kernel_launch: unexpected n_in %d or ws_size %zu (need %zu)\n", n_in, ws_size, (size_t)WS_END); grid_blocks = -1; return; }
        int dev = 0, cus = 0, per_cu = 0;
        (void)hipGetDevice(&dev);
        (void)hipDeviceGetAttribute(&cus, hipDeviceAttributeMultiprocessorCount, dev);
        if (hipFuncSetAttribute((const void*)fwd_megakernel, hipFuncAttributeMaxDynamicSharedMemorySize, LDS_BYTES) != hipSuccess) fprintf(stderr, "kernel_launch: hipFuncSetAttribute failed\n");
        (void)hipOccupancyMaxActiveBlocksPerMultiprocessor(&per_cu, (const void*)fwd_megakernel, 512, LDS_BYTES);
        (void)hipGetLastError();
        if (per_cu < 1) per_cu = 1;
        grid_blocks = cus * 1;
    }
    if (grid_blocks < 0) return;
    Args a{};
    for (int i = 0; i < 23; ++i) a.in[i] = (const float*)d_in[i];
    a.out = (float*)d_out; a.ws = (unsigned char*)d_ws;
    void* args[] = {&a};
    hipError_t e = hipLaunchCooperativeKernel((const void*)fwd_megakernel, dim3(grid_blocks), dim3(512), args, LDS_BYTES, stream);
    if (e != hipSuccess) fprintf(stderr, "cooperative launch failed: %s (grid %d)\n", hipGetErrorString(e), grid_blocks);
}
```

```cpp
#include <hip/hip_runtime.h>
#include <hip/hip_cooperative_groups.h>
#include <cstdio>
#include <cstdint>
namespace cg = cooperative_groups;

#define LAS __attribute__((address_space(3)))
typedef unsigned short bf16_t;
typedef short bf16x8 __attribute__((ext_vector_type(8)));
typedef short bf16x4 __attribute__((ext_vector_type(4)));
typedef float f32x4 __attribute__((ext_vector_type(4)));
typedef unsigned u32x4 __attribute__((ext_vector_type(4)));
typedef unsigned u32x2 __attribute__((ext_vector_type(2)));

constexpr int D = 1024, SEQ = 16384, CTXL = 256, MX = 32768, MCTX = 512, MT = MX + MCTX;
constexpr int DFF = 2816, DRNN = 1536, NLAYER = 4;
constexpr int NCHUNK = 130;
constexpr int LDS_XB = 137216;
constexpr int LDS_BYTES = LDS_XB + 256;

#define XCD_BAR_WORDS 3456
constexpr size_t al256(size_t x) { return (x + 255) & ~(size_t)255; }
constexpr size_t WS_WGU = 0;
constexpr size_t WS_WDN = al256(WS_WGU + (size_t)8 * 5632 * 1024 * 2);
constexpr size_t WS_WAIN = al256(WS_WDN + (size_t)8 * 1024 * 2816 * 2);
constexpr size_t WS_WAOUT = al256(WS_WAIN + (size_t)2 * 3072 * 1024 * 2);
constexpr size_t WS_WAG = al256(WS_WAOUT + (size_t)2 * 1024 * 1536 * 2);
constexpr size_t WS_WBQKV = al256(WS_WAG + (size_t)96 * 128 * 128 * 2);
constexpr size_t WS_WBO = al256(WS_WBQKV + (size_t)1536 * 1024 * 2);
constexpr size_t WS_WCQKV = al256(WS_WBO + (size_t)1024 * 1024 * 2);
constexpr size_t WS_WCO = al256(WS_WCQKV + (size_t)3072 * 1024 * 2);
constexpr size_t WS_MOD = al256(WS_WCO + (size_t)1024 * 1024 * 2);
constexpr size_t WS_ROPE = al256(WS_MOD + (size_t)4 * 3 * 9216 * 4);
constexpr size_t WS_PE = al256(WS_ROPE + (size_t)2 * 256 * 16 * 4);
constexpr size_t PE_HALF = (size_t)2 * 2 * NCHUNK * DRNN;
constexpr size_t WS_CIN = al256(WS_PE + 2 * PE_HALF * 4);
constexpr size_t WS_XS = al256(WS_CIN + PE_HALF * 4);
constexpr size_t WS_HN = al256(WS_XS + (size_t)MT * D * 4);
constexpr size_t WS_ACT = al256(WS_HN + (size_t)MT * 1536 * 2);
constexpr size_t WS_EXTRA = al256(WS_ACT + (size_t)MT * 3072 * 2);
constexpr size_t WS_SLAB = al256(WS_EXTRA + (size_t)MT * 1024 * 2);
constexpr size_t WS_BAR = al256(WS_EXTRA + (size_t)MT * 1536 * 2);
static_assert(WS_SLAB + (size_t)11 * MCTX * D * 4 <= WS_BAR, "slabs must fit in EXTRA's tail");
constexpr size_t WS_END = al256(WS_BAR + (size_t)XCD_BAR_WORDS * 4);

__device__ __forceinline__ int opaque_tid() { int t = threadIdx.x; asm volatile("" : "+v"(t)); return t; }
__device__ __forceinline__ size_t opaque_zero() { size_t z = 0; asm volatile("" : "+s"(z)); return z; }
__device__ __forceinline__ unsigned cvt_pk_bf16(float lo, float hi) { unsigned r; asm("v_cvt_pk_bf16_f32 %0, %1, %2" : "=v"(r) : "v"(lo), "v"(hi)); return r; }
__device__ __forceinline__ float bf2f(bf16_t b) { return __uint_as_float(((unsigned)b) << 16); }
__device__ __forceinline__ float bflo(unsigned u) { return __uint_as_float(u << 16); }
__device__ __forceinline__ float bfhi(unsigned u) { return __uint_as_float(u & 0xffff0000u); }
__device__ __forceinline__ float sigmoidf_(float z) { return __builtin_amdgcn_rcpf(1.0f + __expf(-z)); }
__device__ __forceinline__ float siluf_(float z) { return z * sigmoidf_(z); }
__device__ __forceinline__ float gelu_tanh(float x) { const float u = 0.7978845608028654f * (x + 0.044715f * x * x * x); return x * sigmoidf_(2.0f * u); }
__device__ __forceinline__ float wave_sum(float v) {
#pragma unroll
    for (int o = 1; o < 64; o <<= 1) v += __shfl_xor(v, o);
    return v;
}

#define XB_TMO      128
#define XB_XCNT(j)  (256  + 64 * (j))
#define XB_XSUB(j)  (1280 + 64 * (j))
#define XB_XGEN(j)  (2304 + 64 * (j))
#define XB_TOP      3328
#define XB_TOPGEN   3392
#define XB_SPIN_CAP (1u << 20)
__device__ __forceinline__ unsigned xb_ld(unsigned* p)              { return __hip_atomic_load(p, __ATOMIC_RELAXED, __HIP_MEMORY_SCOPE_AGENT); }
__device__ __forceinline__ unsigned xb_add(unsigned* p, unsigned v) { return __hip_atomic_fetch_add(p, v, __ATOMIC_RELAXED, __HIP_MEMORY_SCOPE_AGENT); }
__device__ __forceinline__ unsigned xb_xcc_id() { return (unsigned)__builtin_amdgcn_s_getreg((3 << 11) | 20) & 0xFu; }
#define XB_SPIN(cond, bar) do { unsigned _sp = 0; while (cond) { __builtin_amdgcn_s_sleep(1); \
    if ((++_sp & 255u) == 0u) { if (xb_ld(&(bar)[XB_TMO])) break; if (_sp > XB_SPIN_CAP) { atomicAdd(&(bar)[XB_TMO], 1u); break; } } } } while (0)
struct XcdBarrier { unsigned* bar; unsigned x; volatile LAS unsigned* st; };
__device__ __forceinline__ XcdBarrier xcd_barrier_post(unsigned* bar, volatile LAS unsigned* st) {
    XcdBarrier b; b.bar = bar; b.x = xb_xcc_id(); b.st = st;
    if (threadIdx.x == 0) (void)xb_add(&bar[XB_XCNT(b.x)], 1u);
    return b;
}
__device__ __forceinline__ void xcd_barrier_complete(unsigned* bar, unsigned x, unsigned& nloc, unsigned& nx) {
    const unsigned G = gridDim.x * gridDim.y * gridDim.z;
    unsigned sum, cnt, mine, sp = 0u;
    for (;;) {
        sum = 0u; cnt = 0u; mine = 0u;
#pragma unroll
        for (unsigned j = 0; j < 16; ++j) { const unsigned c = xb_ld(&bar[XB_XCNT(j)]); sum += c; cnt += (c > 0u) ? 1u : 0u; mine = (j == x) ? c : mine; }
        if (sum == G) break;
        __builtin_amdgcn_s_sleep(1);
        if ((++sp & 255u) == 0u) { if (xb_ld(&bar[XB_TMO])) break; if (sp > XB_SPIN_CAP) { atomicAdd(&bar[XB_TMO], 1u); break; } }
    }
    nloc = mine > 0u ? mine : 1u; nx = cnt > 0u ? cnt : 1u;
}
__device__ __forceinline__ void xcd_barrier(const XcdBarrier& b) {
    asm volatile("s_waitcnt vmcnt(0)" ::: "memory");
    __syncthreads();
    if (threadIdx.x == 0) {
        unsigned* bar = b.bar;
        __builtin_amdgcn_s_waitcnt(0);
        unsigned nloc = b.st[0], nx = b.st[1];
        if (nloc == 0u) { xcd_barrier_complete(bar, b.x, nloc, nx); b.st[0] = nloc; b.st[1] = nx; }
        const unsigned old = xb_add(&bar[XB_XSUB(b.x)], 1u);
        const unsigned gen = old / nloc;
        if (old + 1u == (gen + 1u) * nloc) {
            __builtin_amdgcn_fence(__ATOMIC_RELEASE, "agent");
            asm volatile("s_waitcnt vmcnt(0)" ::: "memory");
            const unsigned og = xb_add(&bar[XB_TOP], 1u);
            const unsigned tg = og / nx;
            if (og + 1u == (tg + 1u) * nx) xb_add(&bar[XB_TOPGEN], 1u);
            else XB_SPIN(xb_ld(&bar[XB_TOPGEN]) == tg, bar);
            __builtin_amdgcn_fence(__ATOMIC_ACQUIRE, "agent");
            xb_add(&bar[XB_XGEN(b.x)], 1u);
            asm volatile("s_waitcnt vmcnt(0)" ::: "memory");
        } else {
            XB_SPIN(xb_ld(&bar[XB_XGEN(b.x)]) == gen, bar);
            __builtin_amdgcn_fence(__ATOMIC_ACQUIRE, "agent");
            asm volatile("s_waitcnt vmcnt(0)" ::: "memory");
        }
    }
    __syncthreads();
}

namespace pg8 {
constexpr int BM = 256, BK = 64, HALF = 128, HTB = HALF * BK * 2, STAGE_BYTES = 8 * HTB, NXCD = 8, WGM = 8;
__device__ __forceinline__ int lds_byte(int r, int c) { const int st = (r >> 4) * 2 + (c >> 5), rr = r & 15, cc = c & 31, ob = rr * 64 + cc * 2; return st * 1024 + (ob ^ (((ob >> 9) & 1) << 5)); }
__device__ __forceinline__ void stage_rc(int b, int& R, int& C) { const int st = b / 1024, sb = b % 1024, swz = sb ^ (((sb >> 9) & 1) << 5); R = (st >> 1) * 16 + swz / 64; C = (st & 1) * 32 + (swz % 64) / 2; }
__device__ __forceinline__ int perm32(int rho) { const int n = rho >> 4, i = rho & 15; return 8 * (i >> 2) + 4 * n + (i & 3); }
struct Unit { int pm, pn, ks, nt, at; };
struct Gemm { const bf16_t* A; const bf16_t* Bt; int M, N, K; };
struct StaticOrder {
    int nM, nN, nwg, G, c, nctx, main_nt;
    __device__ void init(int M, int N, int K, int G_, int c_, bool splitctx) {
        nN = N / BM; G = G_; c = c_; main_nt = K / BK;
        if (splitctx && M == MT) { nM = MX / BM; nctx = 2 * nN * (K / 256); } else { nM = M / BM; nctx = 0; }
        nwg = nM * nN;
    }
    __device__ bool next(int i, Unit& u) const {
        long L = (long)i * G + c;
        if (L >= nwg) {
            L -= nwg; if (L >= nctx) return false;
            const int rem = (int)L % (2 * nN);
            u.ks = (int)L / (2 * nN); u.pm = 128 + (rem & 1); u.pn = rem >> 1; u.nt = 4; u.at = 1; return true;
        }
        int wgid = (int)L; { const int q = nwg / NXCD, r = nwg % NXCD, xcd = wgid % NXCD, off = wgid / NXCD; wgid = (xcd < r ? xcd * (q + 1) : r * (q + 1) + (xcd - r) * q) + off; }
        const int nig = WGM * nN, gid = wgid / nig, fm = gid * WGM, gsz = (nM - fm) < WGM ? (nM - fm) : WGM;
        u.pm = fm + ((wgid % nig) % gsz); u.pn = (wgid % nig) / gsz; u.ks = 0; u.nt = main_nt; u.at = 0; return true;
    }
};
template <class Epi>
__device__ __forceinline__ void gemm_phase(LAS unsigned char* lds, const Gemm g, const StaticOrder& S, const Epi& E) {
    const int tid = opaque_tid(), wid = __builtin_amdgcn_readfirstlane(tid >> 6), lane = tid & 63, wr = wid >> 2, wc = wid & 3, fr = lane & 15, fq = lane >> 4;
    const int K = g.K;
    unsigned voffA[2], voffB[2];
#pragma unroll
    for (int i = 0; i < 2; ++i) { int R, C; stage_rc(tid * 16 + i * 8192, R, C); const int Rb = E.perm() ? ((R & ~31) + perm32(R & 31)) : R;
        voffA[i] = (unsigned)(R * K + C) * 2u; voffB[i] = (unsigned)(Rb * K + C) * 2u; }
    const size_t kstep = (size_t)(BK * 2);
    const size_t hstep = (size_t)HALF * K * 2;
    const size_t tstep = 2 * hstep;
    const unsigned ldsw = (unsigned)wid * 1024u;
    const int aoff = lds_byte(wr * 64 + fr, fq * 8), boff = lds_byte(wc * 32 + fr, fq * 8);
#define PG8_SA(b, h) (((b) * 2 + (h)) * HTB)
#define PG8_SB(b, h) ((4 + (b) * 2 + (h)) * HTB)
#define PG8_STAGE(bufoff, gbase, voff) do { _Pragma("unroll") for (int _i = 0; _i < 2; ++_i) \
        __builtin_amdgcn_global_load_lds((const unsigned*)((const char*)(gbase) + (voff)[_i]), (LAS unsigned*)(lds + (bufoff) + ldsw + _i * 8192), 16, 0, 0); } while (0)
#define PG8_LDA(dst, b, h) do { _Pragma("unroll") for (int m = 0; m < 4; ++m) _Pragma("unroll") for (int k = 0; k < 2; ++k) dst[m][k] = *(const LAS bf16x8*)(lds + PG8_SA(b, h) + aoff + m * 2048 + k * 1024); } while (0)
#define PG8_LDB(dst, b, h) do { _Pragma("unroll") for (int n = 0; n < 2; ++n) _Pragma("unroll") for (int k = 0; k < 2; ++k) dst[n][k] = *(const LAS bf16x8*)(lds + PG8_SB(b, h) + boff + n * 2048 + k * 1024); } while (0)
#define PG8_MMA(ai, bj, At, Bt) do { __builtin_amdgcn_s_setprio(1); _Pragma("unroll") for (int m = 0; m < 4; ++m) _Pragma("unroll") for (int n = 0; n < 2; ++n) _Pragma("unroll") for (int k = 0; k < 2; ++k) \
        acc[ai][bj][m][n] = __builtin_amdgcn_mfma_f32_16x16x32_bf16(Bt[n][k], At[m][k], acc[ai][bj][m][n], 0, 0, 0); __builtin_amdgcn_s_setprio(0); } while (0)
#define PG8_WAIT_V(n) asm volatile("s_waitcnt vmcnt(" #n ")" ::: "memory")
#define PG8_WAIT_L(n) asm volatile("s_waitcnt lgkmcnt(" #n ")" ::: "memory")
#define PG8_BAR __builtin_amdgcn_s_barrier()
#define PG8_SCHED __builtin_amdgcn_sched_barrier(0)
    Unit cur, nxt; int ui = 0;
    if (!S.next(0, cur)) return;
    f32x4 acc[2][2][4][2];
#pragma unroll
    for (int a = 0; a < 2; ++a)
#pragma unroll
        for (int b = 0; b < 2; ++b)
#pragma unroll
            for (int m = 0; m < 4; ++m)
#pragma unroll
                for (int n = 0; n < 2; ++n) acc[a][b][m][n] = (f32x4){0.f, 0.f, 0.f, 0.f};
    bf16x8 At[4][2], B0[2][2], B1[2][2];
    const char* cA = (const char*)g.A + (size_t)cur.pm * tstep + (size_t)cur.ks * 512; const char* cB = (const char*)g.Bt + (size_t)cur.pn * tstep + (size_t)cur.ks * 512;
    PG8_STAGE(PG8_SB(0, 0), cB, voffB); PG8_STAGE(PG8_SA(0, 0), cA, voffA); PG8_STAGE(PG8_SB(0, 1), cB + hstep, voffB); PG8_STAGE(PG8_SA(0, 1), cA + hstep, voffA);
    if (wr == 1) PG8_BAR;
    PG8_WAIT_V(4); PG8_BAR;
    PG8_STAGE(PG8_SB(1, 0), cB + kstep, voffB); PG8_STAGE(PG8_SA(1, 0), cA + kstep, voffA); PG8_STAGE(PG8_SB(1, 1), cB + hstep + kstep, voffB);
    PG8_WAIT_V(6); PG8_BAR;
    for (;;) {
        const bool has_next = S.next(ui + 1, nxt);
        const char* nA = has_next ? (const char*)g.A + (size_t)nxt.pm * tstep + (size_t)nxt.ks * 512 : cA; const char* nB = has_next ? (const char*)g.Bt + (size_t)nxt.pn * tstep + (size_t)nxt.ks * 512 : cB;
        const int nt = cur.nt;
        for (int t = 0; t < nt; t += 2) {
            const bool last = (t == nt - 2);
            const char* a1 = cA + (size_t)(t + 1) * kstep;
            const char* a2 = last ? nA : cA + (size_t)(t + 2) * kstep; const char* b2 = last ? nB : cB + (size_t)(t + 2) * kstep;
            const char* a3 = a2 + kstep; const char* b3 = b2 + kstep;
            PG8_LDB(B0, 0, 0); PG8_SCHED; PG8_LDA(At, 0, 0); PG8_STAGE(PG8_SA(1, 1), a1 + hstep, voffA);
            PG8_WAIT_L(8); PG8_BAR; PG8_WAIT_L(0); PG8_MMA(0, 0, At, B0); PG8_BAR; PG8_SCHED;
            PG8_LDB(B1, 0, 1); PG8_STAGE(PG8_SB(0, 0), b2, voffB);
            PG8_BAR; PG8_WAIT_L(0); PG8_MMA(0, 1, At, B1); PG8_BAR;
            PG8_LDA(At, 0, 1); PG8_STAGE(PG8_SA(0, 0), a2, voffA);
            PG8_BAR; PG8_WAIT_L(0); PG8_MMA(1, 0, At, B0); PG8_BAR; PG8_SCHED;
            PG8_STAGE(PG8_SB(0, 1), b2 + hstep, voffB);
            PG8_WAIT_V(6); PG8_BAR; PG8_MMA(1, 1, At, B1); PG8_BAR;
            PG8_LDB(B0, 1, 0); PG8_SCHED; PG8_LDA(At, 1, 0); PG8_STAGE(PG8_SA(0, 1), a2 + hstep, voffA);
            PG8_WAIT_L(8); PG8_BAR; PG8_WAIT_L(0); PG8_MMA(0, 0, At, B0); PG8_BAR; PG8_SCHED;
            PG8_LDB(B1, 1, 1); PG8_STAGE(PG8_SB(1, 0), b3, voffB);
            PG8_BAR; PG8_WAIT_L(0); PG8_MMA(0, 1, At, B1); PG8_BAR;
            PG8_LDA(At, 1, 1); PG8_STAGE(PG8_SA(1, 0), a3, voffA);
            PG8_BAR; PG8_WAIT_L(0); PG8_MMA(1, 0, At, B0); PG8_BAR; PG8_SCHED;
            PG8_STAGE(PG8_SB(1, 1), b3 + hstep, voffB);
            PG8_WAIT_V(6); PG8_BAR; PG8_MMA(1, 1, At, B1); PG8_BAR;
        }
        if (wr == 0) PG8_BAR;
        E(acc, cur, wr, wc, fr, fq);
        if (!has_next) break;
#pragma unroll
        for (int a = 0; a < 2; ++a)
#pragma unroll
            for (int b = 0; b < 2; ++b)
#pragma unroll
                for (int m = 0; m < 4; ++m)
#pragma unroll
                    for (int n = 0; n < 2; ++n) acc[a][b][m][n] = (f32x4){0.f, 0.f, 0.f, 0.f};
        cur = nxt; cA = nA; cB = nB; ++ui;
        if (wr == 1) PG8_BAR;
    }
    PG8_WAIT_V(0);
    PG8_BAR;
#undef PG8_SA
#undef PG8_SB
#undef PG8_STAGE
#undef PG8_LDA
#undef PG8_LDB
#undef PG8_MMA
#undef PG8_WAIT_V
#undef PG8_WAIT_L
#undef PG8_BAR
#undef PG8_SCHED
}
}
using pg8::Unit;
typedef f32x4 AccT[2][2][4][2];

struct EpiSwiGLU {
    static constexpr bool PERM = true;
    bf16_t* out;
    __device__ __forceinline__ void operator()(const AccT& acc, const Unit& u, int wr, int wc, int fr, int fq) const {
        const int row0 = u.pm * 256 + wr * 64 + fr, col0 = u.pn * 128 + wc * 32 + 8 * fq;
#pragma unroll
        for (int ai = 0; ai < 2; ++ai)
#pragma unroll
            for (int m = 0; m < 4; ++m) {
                const f32x4 g0 = acc[ai][0][m][0], g1 = acc[ai][0][m][1], u0 = acc[ai][1][m][0], u1 = acc[ai][1][m][1];
                u32x4 o;
                o.x = cvt_pk_bf16(siluf_(g0[0]) * u0[0], siluf_(g0[1]) * u0[1]); o.y = cvt_pk_bf16(siluf_(g0[2]) * u0[2], siluf_(g0[3]) * u0[3]);
                o.z = cvt_pk_bf16(siluf_(g1[0]) * u1[0], siluf_(g1[1]) * u1[1]); o.w = cvt_pk_bf16(siluf_(g1[2]) * u1[2], siluf_(g1[3]) * u1[3]);
                *(u32x4*)(out + (size_t)(row0 + ai * 128 + m * 16) * DFF + col0) = o;
            }
    }
};
struct EpiResid {
    static constexpr bool PERM = true;
    float* slab; bf16_t* y; const float* gate; float coef;
    __device__ __forceinline__ void operator()(const AccT& acc, const Unit& u, int wr, int wc, int fr, int fq) const {
        const int mb = (u.pm >= 128) ? 2 : (u.pm >= 64 ? 1 : 0);
        const float* gp = gate + mb * 9216;
        const int row0 = u.pm * 256 + wr * 64 + fr, col0 = u.pn * 256 + wc * 32 + 8 * fq;
        f32x4 gv[2][2];
#pragma unroll
        for (int bj = 0; bj < 2; ++bj)
#pragma unroll
            for (int n = 0; n < 2; ++n) gv[bj][n] = *(const f32x4*)(gp + col0 + bj * 128 + 4 * n) * coef;
#pragma unroll
        for (int ai = 0; ai < 2; ++ai)
#pragma unroll
            for (int m = 0; m < 4; ++m) {
                const size_t ro = (size_t)(row0 + ai * 128 + m * 16) * D + col0;
#pragma unroll
                for (int bj = 0; bj < 2; ++bj) {
                    const f32x4 v0 = gv[bj][0] * acc[ai][bj][m][0], v1 = gv[bj][1] * acc[ai][bj][m][1];
                    if (u.at) {
                        float* pf = slab + (size_t)u.ks * MCTX * D + (ro - (size_t)MX * D) + bj * 128;
                        *(f32x4*)pf = v0; *(f32x4*)(pf + 4) = v1;
                    } else {
                        u32x4 o; o.x = cvt_pk_bf16(v0[0], v0[1]); o.y = cvt_pk_bf16(v0[2], v0[3]); o.z = cvt_pk_bf16(v1[0], v1[1]); o.w = cvt_pk_bf16(v1[2], v1[3]);
                        *(u32x4*)(y + ro + bj * 128) = o;
                    }
                }
            }
    }
};
struct EpiBf16 {
    static constexpr bool PERM = true;
    bf16_t* out; int ldc; int qcols; float qscale; bf16_t* vt;
    __device__ __forceinline__ void operator()(const AccT& acc, const Unit& u, int wr, int wc, int fr, int fq) const {
        const int row0 = u.pm * 256 + wr * 64 + fr, col0 = u.pn * 256 + wc * 32 + 8 * fq;
        const float sc = (u.pn * 256 < qcols) ? qscale : 1.0f;
        if (vt != nullptr && u.pn >= 8) {
            const bool isx = u.pm < 128;
            const int bb = isx ? (u.pm >> 6) : ((u.pm - 128));
            const size_t tstride = isx ? (size_t)SEQ : (size_t)CTXL;
            bf16_t* base = vt + (isx ? (size_t)0 : (size_t)2 * 16 * 64 * SEQ) + (size_t)bb * 16 * 64 * tstride;
            const int tok0 = (isx ? ((u.pm & 63) * 256) : 0) + wr * 64 + fr;
#pragma unroll
            for (int ai = 0; ai < 2; ++ai)
#pragma unroll
                for (int m = 0; m < 4; ++m) {
                    const int tok = tok0 + ai * 128 + m * 16;
#pragma unroll
                    for (int bj = 0; bj < 2; ++bj) {
                        const int hd = col0 - 2048 + bj * 128;
                        bf16_t* p = base + (size_t)hd * tstride + tok;
                        const f32x4 v0 = acc[ai][bj][m][0], v1 = acc[ai][bj][m][1];
                        const unsigned a0 = cvt_pk_bf16(v0[0], v0[1]), a1 = cvt_pk_bf16(v0[2], v0[3]), a2 = cvt_pk_bf16(v1[0], v1[1]), a3 = cvt_pk_bf16(v1[2], v1[3]);
                        p[0 * tstride] = (bf16_t)(a0 & 0xffff); p[1 * tstride] = (bf16_t)(a0 >> 16); p[2 * tstride] = (bf16_t)(a1 & 0xffff); p[3 * tstride] = (bf16_t)(a1 >> 16);
                        p[4 * tstride] = (bf16_t)(a2 & 0xffff); p[5 * tstride] = (bf16_t)(a2 >> 16); p[6 * tstride] = (bf16_t)(a3 & 0xffff); p[7 * tstride] = (bf16_t)(a3 >> 16);
                    }
                }
            return;
        }
#pragma unroll
        for (int ai = 0; ai < 2; ++ai)
#pragma unroll
            for (int m = 0; m < 4; ++m) {
                bf16_t* rowp = out + (size_t)(row0 + ai * 128 + m * 16) * ldc + col0;
#pragma unroll
                for (int bj = 0; bj < 2; ++bj) {
                    const f32x4 v0 = acc[ai][bj][m][0] * sc, v1 = acc[ai][bj][m][1] * sc;
                    u32x4 o; o.x = cvt_pk_bf16(v0[0], v0[1]); o.y = cvt_pk_bf16(v0[2], v0[3]); o.z = cvt_pk_bf16(v1[0], v1[1]); o.w = cvt_pk_bf16(v1[2], v1[3]);
                    *(u32x4*)(rowp + bj * 128) = o;
                }
            }
    }
};
struct EpiRope {
    static constexpr bool PERM = false;
    bf16_t* out; const float* rope;
    __device__ __forceinline__ void operator()(const AccT& acc, const Unit& u, int wr, int wc, int fr, int fq) const {
        const int row0 = u.pm * 256 + wr * 64 + fr, col0 = u.pn * 256 + wc * 32 + 4 * fq;
        const bool is_q = u.pn < 4, is_v = u.pn == 5, do_rope = (!is_v) && (u.pm < 128);
        const float sc = is_q ? 0.125f * 1.4426950408889634f : 1.0f;
#pragma unroll
        for (int ai = 0; ai < 2; ++ai)
#pragma unroll
            for (int m = 0; m < 4; ++m) {
                const int row = row0 + ai * 128 + m * 16;
                const int t = row & (SEQ - 1);
                const int pos = (wc & 1) ? (t & 63) : (t >> 6);
                f32x4 cs = (f32x4){1.f, 1.f, 1.f, 1.f}, sn = (f32x4){0.f, 0.f, 0.f, 0.f};
                if (do_rope) { cs = *(const f32x4*)(rope + pos * 16 + 4 * fq); sn = *(const f32x4*)(rope + 4096 + pos * 16 + 4 * fq); }
                bf16_t* rowp = out + (size_t)row * 1536 + col0;
#pragma unroll
                for (int bj = 0; bj < 2; ++bj) {
                    const f32x4 x1 = acc[ai][bj][m][0], x2 = acc[ai][bj][m][1];
                    const f32x4 o1 = (x1 * cs - x2 * sn) * sc, o2 = (x2 * cs + x1 * sn) * sc;
                    u32x2 a, b; a.x = cvt_pk_bf16(o1[0], o1[1]); a.y = cvt_pk_bf16(o1[2], o1[3]); b.x = cvt_pk_bf16(o2[0], o2[1]); b.y = cvt_pk_bf16(o2[2], o2[3]);
                    *(u32x2*)(rowp + bj * 128) = a; *(u32x2*)(rowp + bj * 128 + 16) = b;
                }
            }
    }
};

struct EpiAny {
    int mode;
    EpiSwiGLU e0; EpiResid e1; EpiBf16 e2; EpiRope e3;
    __device__ __forceinline__ bool perm() const { return mode != 3; }
    __device__ __forceinline__ void operator()(const AccT& acc, const Unit& u, int wr, int wc, int fr, int fq) const {
        if (mode == 0) e0(acc, u, wr, wc, fr, fq);
        else if (mode == 1) e1(acc, u, wr, wc, fr, fq);
        else if (mode == 2) e2(acc, u, wr, wc, fr, fq);
        else e3(acc, u, wr, wc, fr, fq);
    }
};

struct Args {
    const float* in[23];
    float* out;
    unsigned char* ws;
};
enum { I_X = 0, I_C, I_CTX, I_CCTX, I_WADA, I_BADA, I_NORMG, I_WGU, I_WDN, I_AWIN, I_ACONVW, I_ACONVB, I_AGATEW, I_AGATEB, I_ALAM, I_AWOUT,
       I_BWQKV, I_BSINKS, I_BWO, I_CWQKV, I_CRPB, I_CWO, I_FINALG };

__device__ __forceinline__ void transpose_item(const float* W, int K, int N, bf16_t* WT, int k0, int n0, int drow0, LAS float* scr, int lane) {
    f32x4 wv[8];
#pragma unroll
    for (int i = 0; i < 8; ++i) wv[i] = __builtin_nontemporal_load((const f32x4*)(W + (size_t)(k0 + (lane >> 3) + 8 * i) * N + n0 + 4 * (lane & 7)));
#pragma unroll
    for (int i = 0; i < 8; ++i) { LAS float* sp = scr + ((lane >> 3) + 8 * i) * 33 + 4 * (lane & 7); sp[0] = wv[i][0]; sp[1] = wv[i][1]; sp[2] = wv[i][2]; sp[3] = wv[i][3]; }
    asm volatile("s_waitcnt lgkmcnt(0)" ::: "memory");
    const int c = lane & 7;
#pragma unroll
    for (int j = 0; j < 4; ++j) { const int n = (lane >> 3) + 8 * j; const LAS float* s = scr + (8 * c) * 33 + n;
        u32x4 o; o.x = cvt_pk_bf16(s[0 * 33], s[1 * 33]); o.y = cvt_pk_bf16(s[2 * 33], s[3 * 33]); o.z = cvt_pk_bf16(s[4 * 33], s[5 * 33]); o.w = cvt_pk_bf16(s[6 * 33], s[7 * 33]);
        *(u32x4*)(WT + (size_t)(drow0 + n) * K + k0 + 8 * c) = o; }
    asm volatile("s_waitcnt lgkmcnt(0)" ::: "memory");
}
__device__ __forceinline__ bool transpose_family(int& it, const float* W, int cnt, int K, int N, bf16_t* WT, bool gu, LAS float* scr, int lane) {
    const int nblk = N / 32, kblk = K / 64, per = nblk * kblk, tot = per * cnt;
    if (it >= tot) { it -= tot; return false; }
    const int mi = it / per, r = it % per, kb = r / nblk, nb = r % nblk;
    const int n0 = 32 * nb; int drow0 = n0;
    if (gu) { const int half = n0 >= DFF ? 1 : 0, nn = n0 - half * DFF; drow0 = (nn >> 7) * 256 + half * 128 + (nn & 127); }
    transpose_item(W + (size_t)mi * K * N, K, N, WT + (size_t)mi * K * N, 64 * kb, n0, drow0, scr, lane);
    return true;
}
__device__ __forceinline__ void phase_prep(const Args& a, LAS unsigned char* lds) {
    const int tid = opaque_tid(), lane = tid & 63, wave = tid >> 6;
    unsigned char* ws = a.ws;
    {
        const int idx = blockIdx.x * 512 + tid;
        if (idx < 4096) {
            const int pos = idx >> 4, j = idx & 15;
            double inv = (j & 3) == 0 ? 1.0 : ((j & 3) == 1 ? 0.5623413251903491 : ((j & 3) == 2 ? 0.31622776601683794 : 0.1778279410038923));
            const int dec = j >> 2; inv *= (dec == 0 ? 1.0 : dec == 1 ? 0.1 : dec == 2 ? 0.01 : 0.001);
            double rev = (double)pos * inv * 0.15915494309189535; rev -= floor(rev);
            float* rope = (float*)(ws + WS_ROPE);
            rope[idx] = __builtin_amdgcn_cosf((float)rev); rope[4096 + idx] = __builtin_amdgcn_sinf((float)rev);
        }
    }
    {
        LAS float* sv = (LAS float*)lds;
        LAS float* red = sv + 3 * 1024;
        for (int e = tid; e < 3 * 1024; e += 512) { const int v = e >> 10, k = e & 1023; const float cv = v < 2 ? a.in[I_C][v * 1024 + k] : a.in[I_CCTX][k]; sv[e] = siluf_(cv); }
        __syncthreads();
        float* mod = (float*)(ws + WS_MOD);
        for (int task = blockIdx.x; task < 4 * 72; task += gridDim.x) {
            const int i = task / 72, col0 = (task % 72) * 128;
            const int cg4 = tid & 31, kg = tid >> 5;
            const float* wp = a.in[I_WADA] + ((size_t)i * 1024 + kg * 64) * 9216 + col0 + 4 * cg4;
            f32x4 s0 = (f32x4){0, 0, 0, 0}, s1 = s0, s2 = s0;
#pragma unroll 8
            for (int k = 0; k < 64; ++k) { const f32x4 w = *(const f32x4*)(wp + (size_t)k * 9216); const int kk = kg * 64 + k; s0 += w * sv[kk]; s1 += w * sv[1024 + kk]; s2 += w * sv[2048 + kk]; }
#pragma unroll
            for (int e = 0; e < 4; ++e) { red[(kg * 3 + 0) * 128 + 4 * cg4 + e] = s0[e]; red[(kg * 3 + 1) * 128 + 4 * cg4 + e] = s1[e]; red[(kg * 3 + 2) * 128 + 4 * cg4 + e] = s2[e]; }
            __syncthreads();
            if (tid < 384) { const int v = tid >> 7, cc = tid & 127; float s = 0.f;
#pragma unroll
                for (int q = 0; q < 16; ++q) s += red[(q * 3 + v) * 128 + cc];
                mod[((size_t)i * 3 + v) * 9216 + col0 + cc] = s + a.in[I_BADA][(size_t)i * 9216 + col0 + cc]; }
            __syncthreads();
        }
    }
    {
        LAS float* scr = (LAS float*)(lds + wave * 8448);
        const int gw = blockIdx.x * 8 + wave, NGW = gridDim.x * 8;
        constexpr int TOT = 8 * 16 * 176 + 8 * 44 * 32 + 2 * 16 * 96 + 2 * 24 * 32 + 96 * 2 * 4 + 16 * 48 + 16 * 32 + 16 * 96 + 16 * 32;
        for (int item = gw; item < TOT; item += NGW) {
            int it = item;
            if (transpose_family(it, a.in[I_WGU], 8, 1024, 5632, (bf16_t*)(ws + WS_WGU), true, scr, lane)) continue;
            if (transpose_family(it, a.in[I_WDN], 8, 2816, 1024, (bf16_t*)(ws + WS_WDN), false, scr, lane)) continue;
            if (transpose_family(it, a.in[I_AWIN], 2, 1024, 3072, (bf16_t*)(ws + WS_WAIN), false, scr, lane)) continue;
            if (transpose_family(it, a.in[I_AWOUT], 2, 1536, 1024, (bf16_t*)(ws + WS_WAOUT), false, scr, lane)) continue;
            if (transpose_family(it, a.in[I_AGATEW], 96, 128, 128, (bf16_t*)(ws + WS_WAG), false, scr, lane)) continue;
            if (transpose_family(it, a.in[I_BWQKV], 1, 1024, 1536, (bf16_t*)(ws + WS_WBQKV), false, scr, lane)) continue;
            if (transpose_family(it, a.in[I_BWO], 1, 1024, 1024, (bf16_t*)(ws + WS_WBO), false, scr, lane)) continue;
            if (transpose_family(it, a.in[I_CWQKV], 1, 1024, 3072, (bf16_t*)(ws + WS_WCQKV), false, scr, lane)) continue;
            transpose_family(it, a.in[I_CWO], 1, 1024, 1024, (bf16_t*)(ws + WS_WCO), false, scr, lane);
        }
    }
}

__device__ __forceinline__ void phase_norm(const Args& a, int layer, int sub, bool first, int nrows, bool addy, int nsplit) {
    const int tid_ = opaque_tid(), lane = tid_ & 63, gw = blockIdx.x * 8 + (tid_ >> 6), NGW = gridDim.x * 8;
    bf16_t* xs = (bf16_t*)(a.ws + WS_XS); bf16_t* hn = (bf16_t*)(a.ws + WS_HN);
    const float* mod = (const float*)(a.ws + WS_MOD) + (size_t)layer * 3 * 9216;
    const float* ng = a.in[I_NORMG] + ((size_t)layer * 3 + sub) * 1024;
    const bf16_t* yb = (const bf16_t*)(a.ws + WS_EXTRA);
    f32x4 gv[4];
#pragma unroll
    for (int j = 0; j < 4; ++j) gv[j] = *(const f32x4*)(ng + 4 * lane + 256 * j);
    constexpr int R = 4;
    for (int r0 = gw; r0 < MX; r0 += R * NGW) {
        f32x4 v[R][4]; u32x2 xx[R][4], yy[R][4]; int rowq[R]; bool okq[R];
#pragma unroll
        for (int q = 0; q < R; ++q) {
            okq[q] = r0 + q * NGW < MX; rowq[q] = okq[q] ? r0 + q * NGW : r0;
            if (first) {
#pragma unroll
                for (int j = 0; j < 4; ++j) v[q][j] = __builtin_nontemporal_load((const f32x4*)(a.in[I_X] + (size_t)rowq[q] * D + 4 * lane + 256 * j));
            } else {
#pragma unroll
                for (int j = 0; j < 4; ++j) xx[q][j] = __builtin_nontemporal_load((const u32x2*)(xs + (size_t)rowq[q] * D + 4 * lane + 256 * j));
            }
            if (addy) {
#pragma unroll
                for (int j = 0; j < 4; ++j) yy[q][j] = __builtin_nontemporal_load((const u32x2*)(yb + (size_t)rowq[q] * D + 4 * lane + 256 * j));
            }
        }
#pragma unroll
        for (int q = 0; q < R; ++q) {
            const int row = rowq[q];
            float s = 0.f;
#pragma unroll
            for (int j = 0; j < 4; ++j) {
                if (!first) { v[q][j][0] = bflo(xx[q][j].x); v[q][j][1] = bfhi(xx[q][j].x); v[q][j][2] = bflo(xx[q][j].y); v[q][j][3] = bfhi(xx[q][j].y); }
                if (addy) { v[q][j][0] += bflo(yy[q][j].x); v[q][j][1] += bfhi(yy[q][j].x); v[q][j][2] += bflo(yy[q][j].y); v[q][j][3] += bfhi(yy[q][j].y); }
                s += (v[q][j][0] * v[q][j][0] + v[q][j][1] * v[q][j][1]) + (v[q][j][2] * v[q][j][2] + v[q][j][3] * v[q][j][3]);
            }
            if ((first || addy) && okq[q]) {
#pragma unroll
                for (int j = 0; j < 4; ++j) { u32x2 o; o.x = cvt_pk_bf16(v[q][j][0], v[q][j][1]); o.y = cvt_pk_bf16(v[q][j][2], v[q][j][3]); __builtin_nontemporal_store(o, (u32x2*)(xs + (size_t)row * D + 4 * lane + 256 * j)); }
            }
            const float rstd = rsqrtf(wave_sum(s) * (1.0f / D) + 1e-6f);
            const float* shp = mod + (row >= SEQ ? 1 : 0) * 9216 + (sub * 3 + 0) * 1024; const float* scp = shp + 1024;
            if (okq[q]) {
#pragma unroll
                for (int j = 0; j < 4; ++j) {
                    const f32x4 sh = *(const f32x4*)(shp + 4 * lane + 256 * j), sc = *(const f32x4*)(scp + 4 * lane + 256 * j);
                    const f32x4 y = v[q][j] * rstd * gv[j] * (sc + 1.0f) + sh;
                    u32x2 o; o.x = cvt_pk_bf16(y[0], y[1]); o.y = cvt_pk_bf16(y[2], y[3]);
                    __builtin_nontemporal_store(o, (u32x2*)(hn + (size_t)row * D + 4 * lane + 256 * j));
                }
            }
        }
    }
    for (int row = MX + gw; row < nrows; row += NGW) {
        f32x4 v[4]; float s = 0.f;
        if (first) {
#pragma unroll
            for (int j = 0; j < 4; ++j) v[j] = *(const f32x4*)(a.in[I_CTX] + (size_t)(row - MX) * D + 4 * lane + 256 * j);
        } else {
#pragma unroll
            for (int j = 0; j < 4; ++j) { const u32x2 x2 = *(const u32x2*)(xs + (size_t)row * D + 4 * lane + 256 * j); v[j][0] = bflo(x2.x); v[j][1] = bfhi(x2.x); v[j][2] = bflo(x2.y); v[j][3] = bfhi(x2.y); }
        }
        if (addy) {
            const float* sr = (const float*)(a.ws + WS_SLAB) + (size_t)(row - MX) * D;
#pragma unroll 1
            for (int ks = 0; ks < nsplit; ++ks) {
#pragma unroll
                for (int j = 0; j < 4; ++j) v[j] += *(const f32x4*)(sr + (size_t)ks * MCTX * D + 4 * lane + 256 * j);
            }
        }
#pragma unroll
        for (int j = 0; j < 4; ++j) s += (v[j][0] * v[j][0] + v[j][1] * v[j][1]) + (v[j][2] * v[j][2] + v[j][3] * v[j][3]);
        if (first || addy) {
#pragma unroll
            for (int j = 0; j < 4; ++j) { u32x2 o; o.x = cvt_pk_bf16(v[j][0], v[j][1]); o.y = cvt_pk_bf16(v[j][2], v[j][3]); *(u32x2*)(xs + (size_t)row * D + 4 * lane + 256 * j) = o; }
        }
        const float rstd = rsqrtf(wave_sum(s) * (1.0f / D) + 1e-6f);
        const float* shp = mod + 2 * 9216 + (sub * 3 + 0) * 1024; const float* scp = shp + 1024;
#pragma unroll
        for (int j = 0; j < 4; ++j) {
            const f32x4 sh = *(const f32x4*)(shp + 4 * lane + 256 * j), sc = *(const f32x4*)(scp + 4 * lane + 256 * j);
            const f32x4 y = v[j] * rstd * gv[j] * (sc + 1.0f) + sh;
            u32x2 o; o.x = cvt_pk_bf16(y[0], y[1]); o.y = cvt_pk_bf16(y[2], y[3]);
            *(u32x2*)(hn + (size_t)row * D + 4 * lane + 256 * j) = o;
        }
    }
}
__device__ __forceinline__ void phase_final(const Args& a) {
    const int tid_ = opaque_tid(), lane = tid_ & 63, gw = blockIdx.x * 8 + (tid_ >> 6), NGW = gridDim.x * 8;
    const bf16_t* xs = (const bf16_t*)(a.ws + WS_XS);
    const bf16_t* yb = (const bf16_t*)(a.ws + WS_EXTRA);
    f32x4 gv[4];
#pragma unroll
    for (int j = 0; j < 4; ++j) gv[j] = *(const f32x4*)(a.in[I_FINALG] + 4 * lane + 256 * j);
    constexpr int R = 4;
    for (int r0 = gw; r0 < MX; r0 += R * NGW) {
        u32x2 xx[R][4], yy[R][4]; int rowq[R]; bool okq[R];
#pragma unroll
        for (int q = 0; q < R; ++q) {
            okq[q] = r0 + q * NGW < MX; rowq[q] = okq[q] ? r0 + q * NGW : r0;
#pragma unroll
            for (int j = 0; j < 4; ++j) { xx[q][j] = *(const u32x2*)(xs + (size_t)rowq[q] * D + 4 * lane + 256 * j); yy[q][j] = *(const u32x2*)(yb + (size_t)rowq[q] * D + 4 * lane + 256 * j); }
        }
#pragma unroll
        for (int q = 0; q < R; ++q) {
            float s = 0.f; f32x4 v[4];
#pragma unroll
            for (int j = 0; j < 4; ++j) {
                v[j][0] = bflo(xx[q][j].x) + bflo(yy[q][j].x); v[j][1] = bfhi(xx[q][j].x) + bfhi(yy[q][j].x); v[j][2] = bflo(xx[q][j].y) + bflo(yy[q][j].y); v[j][3] = bfhi(xx[q][j].y) + bfhi(yy[q][j].y);
                s += (v[j][0] * v[j][0] + v[j][1] * v[j][1]) + (v[j][2] * v[j][2] + v[j][3] * v[j][3]);
            }
            const float rstd = rsqrtf(wave_sum(s) * (1.0f / D) + 1e-6f);
            if (okq[q]) {
#pragma unroll
                for (int j = 0; j < 4; ++j) *(f32x4*)(a.out + (size_t)rowq[q] * D + 4 * lane + 256 * j) = v[j] * rstd * gv[j];
            }
        }
    }
}

__device__ __forceinline__ void phase_swa(LAS unsigned char* lds, const bf16_t* QKV, bf16_t* O, const float* sinks, bool need_ctx) {
    constexpr int LDQ = 1536, KS = 72, VS = 72;
    LAS bf16_t* Ks = (LAS bf16_t*)lds;
    LAS bf16_t* Vt = Ks + 64 * KS;
    const int tid = opaque_tid(), w = tid >> 6, lane = tid & 63, fr = lane & 15, fq = lane >> 4;
    const int lrow = tid >> 3, lcg = tid & 7;
    const int n_items = 2048 + (need_ctx ? 32 : 0);
    for (int item = blockIdx.x; item < n_items; item += gridDim.x) {
        const bool cq = item >= 2048;
        int b, hp, g, jb;
        if (!cq) { hp = item & 1; g = (item >> 1) & 3; jb = (item >> 3) & 127; b = item >> 10; }
        else { const int it = item - 2048; hp = it & 1; g = (it >> 1) & 3; jb = (it >> 3) & 1; b = it >> 4; }
        const int h = 4 * g + 2 * hp + (w >> 2), qsub = (w & 3) * 32;
        const int qrow0 = cq ? (MX + b * CTXL + jb * 128 + qsub) : (b * SEQ + jb * 128 + qsub);
        const int kcol0 = 1024 + g * 64, vcol0 = 1280 + g * 64;
        bf16x8 Qf[2][2];
#pragma unroll
        for (int qt = 0; qt < 2; ++qt)
#pragma unroll
            for (int k2 = 0; k2 < 2; ++k2) Qf[qt][k2] = *(const bf16x8*)(QKV + (size_t)(qrow0 + 16 * qt + fr) * LDQ + h * 64 + 32 * k2 + 8 * fq);
        f32x4 Oa[4][2];
#pragma unroll
        for (int dt = 0; dt < 4; ++dt)
#pragma unroll
            for (int qt = 0; qt < 2; ++qt) Oa[dt][qt] = (f32x4){0.f, 0.f, 0.f, 0.f};
        float mrun[2], lrun[2];
        { const float sk = sinks[h] * 1.4426950408889634f; mrun[0] = mrun[1] = sk; lrun[0] = lrun[1] = (fq == 0) ? 1.0f : 0.0f; }
        const int ntiles = cq ? 4 : 10;
#define SWA_KPOS(t_) (jb * 128 - 128 + 64 * ((t_) - 4))
#define SWA_VALID(t_) ((t_) < 4 || (SWA_KPOS(t_) >= 0 && SWA_KPOS(t_) < SEQ))
#define SWA_KROW(t_) ((t_) < 4 ? (MX + b * CTXL + 64 * (t_)) : (b * SEQ + SWA_KPOS(t_)))
        u32x4 kreg, vreg;
        int ti = 0;
        { const size_t ro = (size_t)(SWA_KROW(0) + lrow) * LDQ + 8 * lcg; kreg = *(const u32x4*)(QKV + ro + kcol0); vreg = *(const u32x4*)(QKV + ro + vcol0); }
        while (ti < ntiles) {
            __syncthreads();
            *(LAS u32x4*)(Ks + lrow * KS + 8 * lcg) = kreg;
            { LAS bf16_t* vp = Vt + (8 * lcg) * VS + lrow;
              vp[0 * VS] = (bf16_t)(vreg.x & 0xffff); vp[1 * VS] = (bf16_t)(vreg.x >> 16); vp[2 * VS] = (bf16_t)(vreg.y & 0xffff); vp[3 * VS] = (bf16_t)(vreg.y >> 16);
              vp[4 * VS] = (bf16_t)(vreg.z & 0xffff); vp[5 * VS] = (bf16_t)(vreg.z >> 16); vp[6 * VS] = (bf16_t)(vreg.w & 0xffff); vp[7 * VS] = (bf16_t)(vreg.w >> 16); }
            __syncthreads();
            int tn = ti + 1;
            while (tn < ntiles && !SWA_VALID(tn)) ++tn;
            if (tn < ntiles) { const size_t ro = (size_t)(SWA_KROW(tn) + lrow) * LDQ + 8 * lcg; kreg = *(const u32x4*)(QKV + ro + kcol0); vreg = *(const u32x4*)(QKV + ro + vcol0); }
            const int kpos0 = SWA_KPOS(ti);
            f32x4 s[4][2];
#pragma unroll
            for (int kt = 0; kt < 4; ++kt) {
                const bf16x8 k0 = *(const LAS bf16x8*)(Ks + (16 * kt + fr) * KS + 8 * fq);
                const bf16x8 k1 = *(const LAS bf16x8*)(Ks + (16 * kt + fr) * KS + 32 + 8 * fq);
#pragma unroll
                for (int qt = 0; qt < 2; ++qt) {
                    f32x4 z = (f32x4){0.f, 0.f, 0.f, 0.f};
                    z = __builtin_amdgcn_mfma_f32_16x16x32_bf16(k0, Qf[qt][0], z, 0, 0, 0);
                    s[kt][qt] = __builtin_amdgcn_mfma_f32_16x16x32_bf16(k1, Qf[qt][1], z, 0, 0, 0);
                }
            }
            if (ti >= 4) {
#pragma unroll
                for (int qt = 0; qt < 2; ++qt) {
                    const int qpos = jb * 128 + qsub + 16 * qt + fr;
#pragma unroll
                    for (int kt = 0; kt < 4; ++kt)
#pragma unroll
                        for (int j = 0; j < 4; ++j) { const int dlt = qpos - (kpos0 + 16 * kt + 4 * fq + j); if (dlt > 128 || dlt < -128) s[kt][qt][j] = -INFINITY; }
                }
            }
            bf16x8 Pf[2][2];
#pragma unroll
            for (int qt = 0; qt < 2; ++qt) {
                float mx = -INFINITY;
#pragma unroll
                for (int kt = 0; kt < 4; ++kt)
#pragma unroll
                    for (int j = 0; j < 4; ++j) mx = fmaxf(mx, s[kt][qt][j]);
                mx = fmaxf(mx, __shfl_xor(mx, 16)); mx = fmaxf(mx, __shfl_xor(mx, 32));
                const float mnew = fmaxf(mrun[qt], mx);
                const float alpha = __builtin_amdgcn_exp2f(mrun[qt] - mnew);
                mrun[qt] = mnew;
                float ls = 0.f;
                float p[4][4];
#pragma unroll
                for (int kt = 0; kt < 4; ++kt)
#pragma unroll
                    for (int j = 0; j < 4; ++j) { p[kt][j] = __builtin_amdgcn_exp2f(s[kt][qt][j] - mnew); ls += p[kt][j]; }
                lrun[qt] = lrun[qt] * alpha + ls;
#pragma unroll
                for (int dt = 0; dt < 4; ++dt) Oa[dt][qt] = Oa[dt][qt] * alpha;
#pragma unroll
                for (int k2 = 0; k2 < 2; ++k2) {
                    u32x4 pk; pk.x = cvt_pk_bf16(p[2 * k2][0], p[2 * k2][1]); pk.y = cvt_pk_bf16(p[2 * k2][2], p[2 * k2][3]);
                    pk.z = cvt_pk_bf16(p[2 * k2 + 1][0], p[2 * k2 + 1][1]); pk.w = cvt_pk_bf16(p[2 * k2 + 1][2], p[2 * k2 + 1][3]);
                    Pf[qt][k2] = __builtin_bit_cast(bf16x8, pk);
                }
            }
#pragma unroll
            for (int dt = 0; dt < 4; ++dt)
#pragma unroll
                for (int k2 = 0; k2 < 2; ++k2) {
                    const LAS bf16_t* vp = Vt + (16 * dt + fr) * VS + 32 * k2 + 4 * fq;
                    const u32x2 v0 = *(const LAS u32x2*)vp, v1 = *(const LAS u32x2*)(vp + 16);
                    u32x4 vv; vv.x = v0.x; vv.y = v0.y; vv.z = v1.x; vv.w = v1.y;
                    const bf16x8 vf = __builtin_bit_cast(bf16x8, vv);
#pragma unroll
                    for (int qt = 0; qt < 2; ++qt) Oa[dt][qt] = __builtin_amdgcn_mfma_f32_16x16x32_bf16(vf, Pf[qt][k2], Oa[dt][qt], 0, 0, 0);
                }
            ti = tn;
        }
#undef SWA_KPOS
#undef SWA_VALID
#undef SWA_KROW
#pragma unroll
        for (int qt = 0; qt < 2; ++qt) {
            float l = lrun[qt]; l += __shfl_xor(l, 16); l += __shfl_xor(l, 32);
            const float inv = 1.0f / l;
            bf16_t* op = O + (size_t)(qrow0 + 16 * qt + fr) * D + h * 64 + 4 * fq;
#pragma unroll
            for (int dt = 0; dt < 4; ++dt) { const f32x4 o = Oa[dt][qt] * inv; u32x2 pk; pk.x = cvt_pk_bf16(o[0], o[1]); pk.y = cvt_pk_bf16(o[2], o[3]); *(u32x2*)(op + 16 * dt) = pk; }
        }
    }
}

__device__ __forceinline__ void phase_nat(LAS unsigned char* lds, const bf16_t* QKV, const bf16_t* VT, bf16_t* O, const float* rpb, bool need_ctx) {
    constexpr int LDQ = 3072, KS = 264, VS = 72;
    LAS bf16_t* Ks = (LAS bf16_t*)lds;
    LAS bf16_t* Vt = Ks + 64 * KS;
    LAS float* rp = (LAS float*)(Vt + 256 * VS);
    const int tid = opaque_tid(), w = tid >> 6, lane = tid & 63, fr = lane & 15, fq = lane >> 4;
    const bool fast = gridDim.x == 256;
    const int xcd = blockIdx.x & 7, mloc = blockIdx.x >> 3;
    const int hg = fast ? (mloc & 3) : (blockIdx.x & 3);
    const int hw = w >> 1, h = 4 * hg + hw, qsub = (w & 1) * 32;
    __syncthreads();
    for (int e = tid; e < 4 * 465; e += 512) rp[e] = rpb[(size_t)(4 * hg) * 465 + e] * 1.4426950408889634f;
    int kc0[2], relb[2]; unsigned okm = 0u;
#pragma unroll
    for (int qt = 0; qt < 2; ++qt) {
        const int c0 = qsub + 16 * qt, c = c0 + fr;
        kc0[qt] = c0 - 8 < 0 ? 0 : (c0 - 8 > 32 ? 32 : c0 - 8);
        const int cst = c - 8 < 0 ? 0 : (c - 8 > 48 ? 48 : c - 8);
        relb[qt] = kc0[qt] + 4 * fq - c + 15;
#pragma unroll
        for (int i = 0; i < 2; ++i)
#pragma unroll
            for (int j = 0; j < 4; ++j) { const int kk = kc0[qt] + 16 * i + 4 * fq + j; if (kk >= cst && kk < cst + 16) okm |= 1u << (qt * 8 + i * 4 + j); }
    }
    const int n_items = 2048 + (need_ctx ? 32 : 0);
    for (int kk = 0; ; ++kk) {
        bool cq; int b, r, rs = 0;
        if (fast) {
            if (kk < 8) { const int G = kk * 8 + xcd; cq = false; b = G >> 5; r = ((G & 31) << 3) + (mloc >> 2); }
            else if (kk == 8 && need_ctx && blockIdx.x < 32) { const int it = ((blockIdx.x & 7) << 2) | (blockIdx.x >> 3); cq = true; b = it >> 4; r = (it >> 2) & 3; }
            else break;
        } else {
            const int item = blockIdx.x + kk * gridDim.x;
            if (item >= n_items) break;
            cq = item >= 2048;
            if (!cq) { r = (item >> 2) & 255; b = item >> 10; } else { const int it = item - 2048; r = (it >> 2) & 3; b = it >> 4; }
        }
        if (!cq) rs = r - 4 < 0 ? 0 : (r - 4 > 248 ? 248 : r - 4);
        const int qrow0 = cq ? (MX + b * CTXL + r * 64 + qsub) : (b * SEQ + r * 64 + qsub);
        const int ntiles = cq ? 4 : 12;
        bf16x8 Qf[2][2];
#pragma unroll
        for (int qt = 0; qt < 2; ++qt)
#pragma unroll
            for (int k2 = 0; k2 < 2; ++k2) Qf[qt][k2] = *(const bf16x8*)(QKV + (size_t)(qrow0 + 16 * qt + fr) * LDQ + h * 64 + 32 * k2 + 8 * fq);
        f32x4 Oa[4][2];
#pragma unroll
        for (int dt = 0; dt < 4; ++dt)
#pragma unroll
            for (int qt = 0; qt < 2; ++qt) Oa[dt][qt] = (f32x4){0.f, 0.f, 0.f, 0.f};
        float mrun[2] = {-INFINITY, -INFINITY}, lrun[2] = {0.f, 0.f};
        u32x4 kreg[4], vreg[4];
        const bf16_t* vtx = VT + (size_t)(b * 16 + 4 * hg) * 64 * SEQ;
        const bf16_t* vtc = VT + (size_t)2 * 16 * 64 * SEQ + (size_t)(b * 16 + 4 * hg) * 64 * CTXL;
#define NAT_LOAD(ti_) do { const int _ti = (ti_); \
            const bool _c = _ti < 4; const int _krow0 = _c ? (MX + b * CTXL + 64 * _ti) : (b * SEQ + (rs + _ti - 4) * 64); \
            const bf16_t* _vb = _c ? vtc + 64 * _ti : vtx + (rs + _ti - 4) * 64; const size_t _vs = _c ? (size_t)CTXL : (size_t)SEQ; \
            _Pragma("unroll") for (int _i = 0; _i < 4; ++_i) { const int _cx = tid + 512 * _i; \
                kreg[_i] = *(const u32x4*)(QKV + (size_t)(_krow0 + (_cx >> 5)) * LDQ + 1024 + hg * 256 + 8 * (_cx & 31)); \
                vreg[_i] = *(const u32x4*)(_vb + (size_t)(_cx >> 3) * _vs + 8 * (_cx & 7)); } } while (0)
        NAT_LOAD(0);
#pragma unroll 1
        for (int ti = 0; ti < ntiles; ++ti) {
            __syncthreads();
#pragma unroll
            for (int i = 0; i < 4; ++i) { const int cx = tid + 512 * i;
                *(LAS u32x4*)(Ks + (cx >> 5) * KS + 8 * (cx & 31)) = kreg[i];
                *(LAS u32x4*)(Vt + (cx >> 3) * VS + 8 * (cx & 7)) = vreg[i]; }
            __syncthreads();
            if (ti + 1 < ntiles) NAT_LOAD(ti + 1);
            if (ti < 4) {
#pragma unroll
                for (int qt = 0; qt < 2; ++qt) {
                    f32x4 s[4];
#pragma unroll
                    for (int kt = 0; kt < 4; ++kt) {
                        const bf16x8 k0 = *(const LAS bf16x8*)(Ks + (16 * kt + fr) * KS + hw * 64 + 8 * fq);
                        const bf16x8 k1 = *(const LAS bf16x8*)(Ks + (16 * kt + fr) * KS + hw * 64 + 32 + 8 * fq);
                        f32x4 z = (f32x4){0.f, 0.f, 0.f, 0.f};
                        z = __builtin_amdgcn_mfma_f32_16x16x32_bf16(k0, Qf[qt][0], z, 0, 0, 0);
                        s[kt] = __builtin_amdgcn_mfma_f32_16x16x32_bf16(k1, Qf[qt][1], z, 0, 0, 0);
                    }
                    float mx = -INFINITY;
#pragma unroll
                    for (int kt = 0; kt < 4; ++kt)
#pragma unroll
                        for (int j = 0; j < 4; ++j) mx = fmaxf(mx, s[kt][j]);
                    mx = fmaxf(mx, __shfl_xor(mx, 16)); mx = fmaxf(mx, __shfl_xor(mx, 32));
                    const float mnew = fmaxf(mrun[qt], mx), alpha = __builtin_amdgcn_exp2f(mrun[qt] - mnew);
                    mrun[qt] = mnew;
                    float ls = 0.f;
#pragma unroll
                    for (int kt = 0; kt < 4; ++kt)
#pragma unroll
                        for (int j = 0; j < 4; ++j) { s[kt][j] = __builtin_amdgcn_exp2f(s[kt][j] - mnew); ls += s[kt][j]; }
                    lrun[qt] = lrun[qt] * alpha + ls;
#pragma unroll
                    for (int dt = 0; dt < 4; ++dt) Oa[dt][qt] = Oa[dt][qt] * alpha;
#pragma unroll
                    for (int k2 = 0; k2 < 2; ++k2) {
                        u32x4 pk; pk.x = cvt_pk_bf16(s[2 * k2][0], s[2 * k2][1]); pk.y = cvt_pk_bf16(s[2 * k2][2], s[2 * k2][3]);
                        pk.z = cvt_pk_bf16(s[2 * k2 + 1][0], s[2 * k2 + 1][1]); pk.w = cvt_pk_bf16(s[2 * k2 + 1][2], s[2 * k2 + 1][3]);
                        const bf16x8 pf = __builtin_bit_cast(bf16x8, pk);
#pragma unroll
                        for (int dt = 0; dt < 4; ++dt) {
                            const LAS bf16_t* vp = Vt + (hw * 64 + 16 * dt + fr) * VS + 32 * k2 + 4 * fq;
                            const u32x2 v0 = *(const LAS u32x2*)vp, v1 = *(const LAS u32x2*)(vp + 16);
                            u32x4 vv; vv.x = v0.x; vv.y = v0.y; vv.z = v1.x; vv.w = v1.y;
                            Oa[dt][qt] = __builtin_amdgcn_mfma_f32_16x16x32_bf16(__builtin_bit_cast(bf16x8, vv), pf, Oa[dt][qt], 0, 0, 0);
                        }
                    }
                }
            } else {
                const LAS float* rrow = rp + hw * 465 + ((rs + ti - 4) - r + 7) * 31;
#pragma unroll
                for (int qt = 0; qt < 2; ++qt) {
                    f32x4 s[2];
#pragma unroll
                    for (int i = 0; i < 2; ++i) {
                        const LAS bf16_t* kp = Ks + (kc0[qt] + 16 * i + fr) * KS + hw * 64 + 8 * fq;
                        f32x4 z = (f32x4){0.f, 0.f, 0.f, 0.f};
                        z = __builtin_amdgcn_mfma_f32_16x16x32_bf16(*(const LAS bf16x8*)kp, Qf[qt][0], z, 0, 0, 0);
                        s[i] = __builtin_amdgcn_mfma_f32_16x16x32_bf16(*(const LAS bf16x8*)(kp + 32), Qf[qt][1], z, 0, 0, 0);
                    }
                    const LAS float* bp = rrow + relb[qt];
                    float mx = -INFINITY;
#pragma unroll
                    for (int i = 0; i < 2; ++i)
#pragma unroll
                        for (int j = 0; j < 4; ++j) { const bool ok = (okm >> (qt * 8 + i * 4 + j)) & 1u; const float bv = bp[16 * i + j];
                            s[i][j] = ok ? s[i][j] + bv : -INFINITY; mx = fmaxf(mx, s[i][j]); }
                    mx = fmaxf(mx, __shfl_xor(mx, 16)); mx = fmaxf(mx, __shfl_xor(mx, 32));
                    const float mnew = fmaxf(mrun[qt], mx), alpha = __builtin_amdgcn_exp2f(mrun[qt] - mnew);
                    mrun[qt] = mnew;
                    float ls = 0.f;
#pragma unroll
                    for (int i = 0; i < 2; ++i)
#pragma unroll
                        for (int j = 0; j < 4; ++j) { s[i][j] = __builtin_amdgcn_exp2f(s[i][j] - mnew); ls += s[i][j]; }
                    lrun[qt] = lrun[qt] * alpha + ls;
                    u32x4 pk; pk.x = cvt_pk_bf16(s[0][0], s[0][1]); pk.y = cvt_pk_bf16(s[0][2], s[0][3]); pk.z = cvt_pk_bf16(s[1][0], s[1][1]); pk.w = cvt_pk_bf16(s[1][2], s[1][3]);
                    const bf16x8 pf = __builtin_bit_cast(bf16x8, pk);
#pragma unroll
                    for (int dt = 0; dt < 4; ++dt) {
                        const LAS bf16_t* vp = Vt + (hw * 64 + 16 * dt + fr) * VS + kc0[qt] + 4 * fq;
                        const u32x2 v0 = *(const LAS u32x2*)vp, v1 = *(const LAS u32x2*)(vp + 16);
                        u32x4 vv; vv.x = v0.x; vv.y = v0.y; vv.z = v1.x; vv.w = v1.y;
                        Oa[dt][qt] = __builtin_amdgcn_mfma_f32_16x16x32_bf16(__builtin_bit_cast(bf16x8, vv), pf, Oa[dt][qt] * alpha, 0, 0, 0);
                    }
                }
            }
        }
#undef NAT_LOAD
#pragma unroll
        for (int qt = 0; qt < 2; ++qt) {
            float l = lrun[qt]; l += __shfl_xor(l, 16); l += __shfl_xor(l, 32);
            const float inv = 1.0f / l;
            bf16_t* op = O + (size_t)(qrow0 + 16 * qt + fr) * D + h * 64 + 4 * fq;
#pragma unroll
            for (int dt = 0; dt < 4; ++dt) { const f32x4 o = Oa[dt][qt] * inv; u32x2 pk; pk.x = cvt_pk_bf16(o[0], o[1]); pk.y = cvt_pk_bf16(o[2], o[3]); *(u32x2*)(op + 16 * dt) = pk; }
        }
    }
}

struct RnnP { const bf16_t* GXR; const bf16_t* Wg; const float* gate_b; const float* lam; const float* conv_w; const float* conv_b; float* PE; float* CIN; bf16_t* Y; };

template <int DIR>
__device__ __forceinline__ void rnn_dir(const RnnP& P, const LAS bf16_t* xc, LAS float* hfl, LAS bf16_t* cat, int nb, int b, int cc, int w, int fr, int fq) {
    const int ch = nb * 128 + 16 * w + fr;
    bf16x8 Bf[2][4];
#pragma unroll
    for (int gt = 0; gt < 2; ++gt)
#pragma unroll
        for (int ks = 0; ks < 4; ++ks) Bf[gt][ks] = *(const bf16x8*)(P.Wg + ((size_t)((DIR * 2 + gt) * 12 + nb) * 128 + 16 * w + fr) * 128 + 32 * ks + 8 * fq);
    constexpr float LOG2E = 1.4426950408889634f;
    const float nbr = -LOG2E * P.gate_b[(DIR * 2 + 0) * DRNN + ch], nbi = -LOG2E * P.gate_b[(DIR * 2 + 1) * DRNN + ch];
    const float nlam = -P.lam[DIR * DRNN + ch];
    const float sp = nlam > 20.0f ? nlam : log1pf(expf(nlam));
    const float c_la = -8.0f * LOG2E * sp, c_x2 = -16.0f * sp;
    float hrun = 0.f, prun = 1.f;
#pragma unroll
    for (int step = 0; step < 8; ++step) {
        const int mt = DIR == 0 ? step : 7 - step;
        f32x4 zr = (f32x4){0.f, 0.f, 0.f, 0.f}, zi = zr;
#pragma unroll
        for (int ks = 0; ks < 4; ++ks) {
            const bf16x8 af = *(const LAS bf16x8*)(xc + (16 * mt + fr) * 136 + 32 * ks + 8 * fq);
            zr = __builtin_amdgcn_mfma_f32_16x16x32_bf16(af, Bf[0][ks], zr, 0, 0, 0);
            zi = __builtin_amdgcn_mfma_f32_16x16x32_bf16(af, Bf[1][ks], zi, 0, 0, 0);
        }
        f32x4 xv4, er, ei, rg, ig, av, om, bv;
#pragma unroll
        for (int j = 0; j < 4; ++j) xv4[j] = bf2f(xc[(16 * mt + 4 * fq + j) * 136 + 16 * w + fr]);
        const f32x4 tr_ = zr * (-LOG2E) + nbr, ti_ = zi * (-LOG2E) + nbi;
#pragma unroll
        for (int j = 0; j < 4; ++j) { er[j] = __builtin_amdgcn_exp2f(tr_[j]); ei[j] = __builtin_amdgcn_exp2f(ti_[j]); }
        er = er + 1.0f; ei = ei + 1.0f;
#pragma unroll
        for (int j = 0; j < 4; ++j) { rg[j] = __builtin_amdgcn_rcpf(er[j]); ig[j] = __builtin_amdgcn_rcpf(ei[j]); }
        const f32x4 la2 = rg * c_la, x2 = rg * c_x2;
#pragma unroll
        for (int j = 0; j < 4; ++j) av[j] = __builtin_amdgcn_exp2f(la2[j]);
        const f32x4 xk = __builtin_elementwise_max(x2, (f32x4){-0.1f, -0.1f, -0.1f, -0.1f});
        const f32x4 ser = -xk * (xk * 0.5f * (xk * (1.0f / 3.0f) * (xk * 0.25f * (xk * 0.2f + 1.0f) + 1.0f) + 1.0f) + 1.0f);
        const f32x4 big = 1.0f - av * av;
        const f32x4 omv = (x2 > -0.1f) ? ser : big;
#pragma unroll
        for (int j = 0; j < 4; ++j) om[j] = __builtin_amdgcn_sqrtf(omv[j]);
        bv = om * (ig * xv4);
        float cumA[4], hl[4];
        if (DIR == 0) { cumA[0] = av[0]; hl[0] = bv[0];
#pragma unroll
            for (int j = 1; j < 4; ++j) { hl[j] = av[j] * hl[j - 1] + bv[j]; cumA[j] = av[j] * cumA[j - 1]; }
        } else { cumA[3] = av[3]; hl[3] = bv[3];
#pragma unroll
            for (int j = 2; j >= 0; --j) { hl[j] = av[j] * hl[j + 1] + bv[j]; cumA[j] = av[j] * cumA[j + 1]; }
        }
        const float PAl = DIR == 0 ? cumA[3] : cumA[0], HBl = DIR == 0 ? hl[3] : hl[0];
        float cin = hrun, mycin = 0.f, mypp = 1.f;
#pragma unroll
        for (int qq = 0; qq < 4; ++qq) {
            const int q = DIR == 0 ? qq : 3 - qq;
            const float pa = __shfl(PAl, fr + 16 * q), hb = __shfl(HBl, fr + 16 * q);
            if (q == fq) { mycin = cin; mypp = prun; }
            cin = pa * cin + hb; prun *= pa;
        }
        hrun = cin;
#pragma unroll
        for (int j = 0; j < 4; ++j) {
            const int tok = 16 * mt + 4 * fq + j;
            const float hv = hl[j] + cumA[j] * mycin;
            const unsigned cq = (unsigned)(cumA[j] * mypp * 255.0f + 0.5f);
            LAS float* hp = hfl + tok * 132 + 16 * w + fr;
            LAS bf16_t* cp = cat + tok * 136 + 16 * w + fr;
            if (DIR == 0) { *hp = hv; *cp = (bf16_t)cq; }
            else { *(LAS unsigned*)hp = cvt_pk_bf16(*hp + hv, 0.f) & 0xffffu; *cp = (bf16_t)((unsigned)*cp | (cq << 8)); }
        }
    }
    if (fq == 0) { float* Pp = P.PE + (size_t)((b * 2 + DIR) * NCHUNK + cc) * DRNN + ch; Pp[0] = prun; Pp[PE_HALF] = hrun; }
}

__device__ __forceinline__ void phase_rnn_carry(const RnnP& P) {
    const int tid = opaque_tid();
    if (tid >= 192) return;
    const int seg = tid & 7, chain = blockIdx.x * 24 + (tid >> 3);
    const bool live = chain < 2 * 2 * DRNN;
    const int chn = live ? chain : 0;
    const int ch = chn % DRNN, bd = chn / DRNN, dir = bd & 1;
    const float* Pp = P.PE + (size_t)(bd * NCHUNK) * DRNN + ch; const float* Ep = Pp + PE_HALF;
    float* Cp = P.CIN + (size_t)(bd * NCHUNK) * DRNN + ch;
    float pv[17], ev[17];
#pragma unroll
    for (int k = 0; k < 17; ++k) { const int p = 17 * seg + k; const bool ok = p < NCHUNK; const int pc = ok ? p : 0;
        const int c2 = dir == 0 ? pc : (pc == 0 ? 1 : (pc == 1 ? 0 : 131 - pc));
        pv[k] = ok ? Pp[(size_t)c2 * DRNN] : 1.0f; ev[k] = ok ? Ep[(size_t)c2 * DRNN] : 0.0f; }
    float PA = 1.f, HB = 0.f;
#pragma unroll
    for (int k = 0; k < 17; ++k) { HB = pv[k] * HB + ev[k]; PA *= pv[k]; }
    const int base = (tid & 63) & ~7;
    float cin = 0.f, h = 0.f;
#pragma unroll
    for (int s = 0; s < 8; ++s) { const float pa = __shfl(PA, base + s), hb = __shfl(HB, base + s); if (s == seg) h = cin; cin = pa * cin + hb; }
    if (live) {
#pragma unroll
        for (int k = 0; k < 17; ++k) { const int p = 17 * seg + k;
            if (p < NCHUNK) { const int c2 = dir == 0 ? p : (p == 0 ? 1 : (p == 1 ? 0 : 131 - p)); Cp[(size_t)c2 * DRNN] = h; h = pv[k] * h + ev[k]; } }
    }
}

__device__ __forceinline__ void phase_rnn(LAS unsigned char* lds, const RnnP& P, bf16_t* HS, bf16_t* CA) {
    LAS bf16_t* xc = (LAS bf16_t*)lds;
    LAS float* hfl = (LAS float*)(lds + 34816);
    LAS bf16_t* cat = (LAS bf16_t*)(lds + 102400);
    const int tid = opaque_tid(), w = tid >> 6, lane = tid & 63, fr = lane & 15, fq = lane >> 4;
    const int cg = tid & 15, tr = tid >> 4;
    u32x4 nx[7];
#define RNN_FETCH(item_) do { const int _it = (item_); const int _nb = _it % 12, _c = _it / 12, _b = _c / NCHUNK, _cc = _c % NCHUNK; \
        const int _seq0 = _cc < 2 ? MX + _b * CTXL : _b * SEQ, _len = _cc < 2 ? CTXL : SEQ, _t0 = _cc < 2 ? _cc * 128 : (_cc - 2) * 128; \
        _Pragma("unroll") for (int _r = 0; _r < 7; ++_r) { const int _tt = _t0 + 4 * tr + _r - 1; \
            nx[_r] = (_tt >= 0 && _tt < _len) ? *(const u32x4*)(P.GXR + (size_t)(_seq0 + _tt) * 3072 + DRNN + _nb * 128 + 8 * cg) : (u32x4){0u, 0u, 0u, 0u}; } } while (0)
    if ((int)blockIdx.x < 2 * NCHUNK * 12) RNN_FETCH((int)blockIdx.x);
    for (int item = blockIdx.x; item < 2 * NCHUNK * 12; item += gridDim.x) {
        const int nb = item % 12, c = item / 12, b = c / NCHUNK, cc = c % NCHUNK;
        const int seq0 = cc < 2 ? MX + b * CTXL : b * SEQ, t0 = cc < 2 ? cc * 128 : (cc - 2) * 128;
        __syncthreads();
        {
            const int ch0 = nb * 128 + 8 * cg;
            float cw[4][8], cb[8];
#pragma unroll
            for (int k = 0; k < 4; ++k) { const f32x4 a0 = *(const f32x4*)(P.conv_w + k * DRNN + ch0), a1 = *(const f32x4*)(P.conv_w + k * DRNN + ch0 + 4);
#pragma unroll
                for (int e = 0; e < 4; ++e) { cw[k][e] = a0[e]; cw[k][4 + e] = a1[e]; } }
            { const f32x4 a0 = *(const f32x4*)(P.conv_b + ch0), a1 = *(const f32x4*)(P.conv_b + ch0 + 4);
#pragma unroll
                for (int e = 0; e < 4; ++e) { cb[e] = a0[e]; cb[4 + e] = a1[e]; } }
#pragma unroll
            for (int q = 0; q < 4; ++q) {
                float acc[8];
#pragma unroll
                for (int e = 0; e < 8; ++e) acc[e] = cb[e];
#pragma unroll
                for (int k = 0; k < 4; ++k) {
                    const u32x4 v = nx[q + k];
                    acc[0] += bflo(v.x) * cw[k][0]; acc[1] += bfhi(v.x) * cw[k][1]; acc[2] += bflo(v.y) * cw[k][2]; acc[3] += bfhi(v.y) * cw[k][3];
                    acc[4] += bflo(v.z) * cw[k][4]; acc[5] += bfhi(v.z) * cw[k][5]; acc[6] += bflo(v.w) * cw[k][6]; acc[7] += bfhi(v.w) * cw[k][7];
                }
                u32x4 o; o.x = cvt_pk_bf16(acc[0], acc[1]); o.y = cvt_pk_bf16(acc[2], acc[3]); o.z = cvt_pk_bf16(acc[4], acc[5]); o.w = cvt_pk_bf16(acc[6], acc[7]);
                *(LAS u32x4*)(xc + (4 * tr + q) * 136 + 8 * cg) = o;
            }
        }
        __syncthreads();
        if (item + (int)gridDim.x < 2 * NCHUNK * 12) RNN_FETCH(item + (int)gridDim.x);
        rnn_dir<0>(P, xc, hfl, cat, nb, b, cc, w, fr, fq);
        rnn_dir<1>(P, xc, hfl, cat, nb, b, cc, w, fr, fq);
        __syncthreads();
#pragma unroll
        for (int i = 0; i < 4; ++i) {
            const int cidx = tid + 512 * i, t = cidx >> 4, cg = cidx & 15;
            const size_t go = (size_t)(seq0 + t0 + t) * DRNN + nb * 128 + 8 * cg;
            const u32x4 h0 = *(const LAS u32x4*)(hfl + t * 132 + 8 * cg), h1 = *(const LAS u32x4*)(hfl + t * 132 + 8 * cg + 4);
            u32x4 o; o.x = (h0.x & 0xffffu) | (h0.y << 16); o.y = (h0.z & 0xffffu) | (h0.w << 16); o.z = (h1.x & 0xffffu) | (h1.y << 16); o.w = (h1.z & 0xffffu) | (h1.w << 16);
            *(u32x4*)(HS + go) = o;
            *(u32x4*)(CA + go) = *(const LAS u32x4*)(cat + t * 136 + 8 * cg);
        }
    }
}

#undef RNN_FETCH
__device__ __forceinline__ void phase_rnn_out(const RnnP& P, bf16_t* HS, const bf16_t* CA, bool need_ctx) {
    const int tid_ = opaque_tid(), lane = tid_ & 63, gw = blockIdx.x * 8 + (tid_ >> 6), NGW = gridDim.x * 8;
    const int nrows = need_ctx ? MT : MX;
    for (int row = gw; row < nrows; row += NGW) {
        int b, cc;
        if (row < MX) { b = row >> 14; cc = 2 + ((row & (SEQ - 1)) >> 7); } else { const int rc = row - MX; b = rc >> 8; cc = (rc & 255) >> 7; }
        const float* cf = P.CIN + (size_t)((b * 2 + 0) * NCHUNK + cc) * DRNN; const float* cbk = P.CIN + (size_t)((b * 2 + 1) * NCHUNK + cc) * DRNN;
#pragma unroll
        for (int k = 0; k < 3; ++k) {
            const int ch0 = 8 * (lane + 64 * k);
            const u32x4 hs = *(const u32x4*)(HS + (size_t)row * DRNN + ch0), ca = *(const u32x4*)(CA + (size_t)row * DRNN + ch0), gg = *(const u32x4*)(P.GXR + (size_t)row * 3072 + ch0);
            const f32x4 f0 = *(const f32x4*)(cf + ch0), f1 = *(const f32x4*)(cf + ch0 + 4), b0 = *(const f32x4*)(cbk + ch0), b1 = *(const f32x4*)(cbk + ch0 + 4);
            const unsigned hsw[4] = {hs.x, hs.y, hs.z, hs.w}, caw[4] = {ca.x, ca.y, ca.z, ca.w}, ggw[4] = {gg.x, gg.y, gg.z, gg.w};
            unsigned ow[4];
#pragma unroll
            for (int e = 0; e < 4; ++e) {
                const float cfl = e < 2 ? f0[2 * e] : f1[2 * e - 4], cfh = e < 2 ? f0[2 * e + 1] : f1[2 * e - 3];
                const float cbl = e < 2 ? b0[2 * e] : b1[2 * e - 4], cbh = e < 2 ? b0[2 * e + 1] : b1[2 * e - 3];
                const unsigned cw_ = caw[e];
                const float hl_ = bflo(hsw[e]) + (float)(cw_ & 0xffu) * (1.0f / 255.0f) * cfl + (float)((cw_ >> 8) & 0xffu) * (1.0f / 255.0f) * cbl;
                const float hh_ = bfhi(hsw[e]) + (float)((cw_ >> 16) & 0xffu) * (1.0f / 255.0f) * cfh + (float)(cw_ >> 24) * (1.0f / 255.0f) * cbh;
                const float gl = bflo(ggw[e]), gh = bfhi(ggw[e]);
                const float yl = hl_ * gl * __builtin_amdgcn_rcpf(1.0f + __builtin_amdgcn_exp2f(gl * (-2.302208198f - 0.1029432397f * gl * gl)));
                const float yh = hh_ * gh * __builtin_amdgcn_rcpf(1.0f + __builtin_amdgcn_exp2f(gh * (-2.302208198f - 0.1029432397f * gh * gh)));
                ow[e] = cvt_pk_bf16(yl, yh);
            }
            u32x4 o; o.x = ow[0]; o.y = ow[1]; o.z = ow[2]; o.w = ow[3];
            *(u32x4*)(HS + (size_t)row * DRNN + ch0) = o;
        }
    }
}

#ifndef DBL
#define DBL 0
#endif
#ifndef PHM
#define PHM 0xFFFF
#endif
enum { OP_SKIP = 0, OP_NORM, OP_GS, OP_GR, OP_GB, OP_GROPE, OP_RNN1, OP_RNN2, OP_RNN3, OP_ATT0, OP_ATT1 };

__global__ void __launch_bounds__(512, 2) fwd_megakernel(Args a) {
    extern __shared__ __attribute__((aligned(16))) unsigned char shm[];
    LAS unsigned char* lds = (LAS unsigned char*)shm;
    cg::grid_group grid = cg::this_grid();

    if (blockIdx.x == 0) { unsigned* bw = (unsigned*)(a.ws + WS_BAR); for (int e = threadIdx.x; e < XCD_BAR_WORDS; e += 512) bw[e] = 0u; }
    volatile LAS unsigned* xbst = (volatile LAS unsigned*)(lds + LDS_XB);
    if (threadIdx.x == 0) { xbst[0] = 0u; xbst[1] = 0u; xbst[2] = 0u; xbst[3] = 0u; }
#if PHM & 1
    for (int rep = 0; rep < ((DBL & 1) ? 2 : 1); ++rep) { phase_prep(a, lds); __syncthreads(); }
#endif
    grid.sync();
    const XcdBarrier xb = xcd_barrier_post((unsigned*)(a.ws + WS_BAR), xbst);
#pragma unroll 1
    for (int i = 0; i < NLAYER; ++i) {
        const int kind = i % 3, j = i / 3;
        const bool need_ctx = i < NLAYER - 1;
        const int MO = need_ctx ? MT : MX;
#pragma unroll 1
        for (int op = 0; op < 12; ++op) {
            unsigned char* ws = a.ws + opaque_zero();
            float* xs = (float*)(ws + WS_XS);
            bf16_t* HN = (bf16_t*)(ws + WS_HN);
            bf16_t* ACT = (bf16_t*)(ws + WS_ACT);
            const float* modl = (const float*)(ws + WS_MOD) + (size_t)i * 3 * 9216;
            int type;
            switch (op) {
                case 0: case 3: case 9: type = OP_NORM; break;
                case 1: case 10: type = OP_GS; break;
                case 2: case 8: case 11: type = OP_GR; break;
                case 4: type = kind == 1 ? OP_GROPE : OP_GB; break;
                case 5: type = kind == 0 ? OP_RNN1 : (kind == 1 ? OP_ATT0 : OP_ATT1); break;
                case 6: type = kind == 0 ? OP_RNN2 : OP_SKIP; break;
                default: type = kind == 0 ? OP_RNN3 : OP_SKIP; break;
            }
            if (type == OP_SKIP) continue;
            if (type == OP_NORM) {
                const int sub = op == 0 ? 0 : (op == 3 ? 1 : 2);
#if PHM & 2
                for (int rep = 0; rep < ((DBL & 2) ? 2 : 1); ++rep) phase_norm(a, i, sub, (i == 0) && (op == 0), op == 9 ? MO : MT, !((i == 0) && (op == 0)), op == 9 ? (kind == 0 ? 6 : 4) : 11);
#endif
            } else if (type == OP_GS || type == OP_GR || type == OP_GB || type == OP_GROPE) {
                pg8::Gemm g; EpiAny E;
                E.e0.out = ACT;
                E.e1.slab = (float*)(ws + WS_SLAB); E.e1.y = (bf16_t*)(ws + WS_EXTRA); E.e1.gate = modl; E.e1.coef = 0.5f;
                E.e2.out = ACT; E.e2.ldc = 3072; E.e2.qcols = kind == 0 ? 0 : 1024; E.e2.qscale = 0.125f * 1.4426950408889634f; E.e2.vt = kind == 2 ? (bf16_t*)(ws + WS_EXTRA) : (bf16_t*)nullptr;
                E.e3.out = ACT; E.e3.rope = (const float*)(ws + WS_ROPE);
                if (type == OP_GS) {
                    const int which = op == 1 ? 0 : 1;
                    E.mode = 0; g.A = HN; g.Bt = (const bf16_t*)(ws + WS_WGU) + (size_t)(i * 2 + which) * 5632 * 1024; g.M = which == 0 ? MT : MO; g.N = 5632; g.K = 1024;
                } else if (type == OP_GR) {
                    E.mode = 1;
                    if (op == 8) {
                        g.A = HN; g.M = MO; g.N = 1024; g.K = kind == 0 ? 1536 : 1024;
                        g.Bt = kind == 0 ? (const bf16_t*)(ws + WS_WAOUT) + (size_t)j * 1024 * 1536 : (kind == 1 ? (const bf16_t*)(ws + WS_WBO) : (const bf16_t*)(ws + WS_WCO));
                        E.e1.gate = modl + (1 * 3 + 2) * 1024; E.e1.coef = 1.0f;
                    } else {
                        const int which = op == 2 ? 0 : 1;
                        g.A = ACT; g.M = which == 0 ? MT : MO; g.N = 1024; g.K = 2816;
                        g.Bt = (const bf16_t*)(ws + WS_WDN) + (size_t)(i * 2 + which) * 1024 * 2816;
                        E.e1.gate = modl + ((which == 0 ? 0 : 2) * 3 + 2) * 1024; E.e1.coef = 0.5f;
                    }
                } else if (type == OP_GB) {
                    E.mode = 2; g.A = HN; g.Bt = kind == 0 ? (const bf16_t*)(ws + WS_WAIN) + (size_t)j * 3072 * 1024 : (const bf16_t*)(ws + WS_WCQKV); g.M = MT; g.N = 3072; g.K = 1024;
                } else {
                    E.mode = 3; g.A = HN; g.Bt = (const bf16_t*)(ws + WS_WBQKV); g.M = MT; g.N = 1536; g.K = 1024;
                }
                pg8::StaticOrder S; S.init(g.M, g.N, g.K, (int)gridDim.x, (int)blockIdx.x, type == OP_GR);
#if PHM & 64
                { const int nrep = ((DBL & 64) || ((DBL & 256) && type == OP_GR) || ((DBL & 512) && type == OP_GS)) ? 2 : 1; const float coef_real = E.e1.coef;
                  for (int rep = 0; rep < nrep; ++rep) { E.e1.coef = rep == nrep - 1 ? coef_real : 0.f; pg8::gemm_phase(lds, g, S, E); } }
#endif
            } else if (type == OP_RNN1 || type == OP_RNN2 || type == OP_RNN3) {
                RnnP P{ACT, (const bf16_t*)(ws + WS_WAG) + (size_t)j * 48 * 128 * 128, a.in[I_AGATEB] + (size_t)j * 4 * DRNN, a.in[I_ALAM] + (size_t)j * 2 * DRNN,
                       a.in[I_ACONVW] + (size_t)j * 4 * DRNN, a.in[I_ACONVB] + (size_t)j * DRNN, (float*)(ws + WS_PE), (float*)(ws + WS_CIN), HN};
                if (type == OP_RNN2) phase_rnn_carry(P);
#if PHM & 4
                for (int rep = 0; rep < ((DBL & 4) ? 2 : 1); ++rep) if (type == OP_RNN1) phase_rnn(lds, P, HN, (bf16_t*)(ws + WS_EXTRA));
#endif
#if PHM & 8
                if (type == OP_RNN3) phase_rnn_out(P, HN, (const bf16_t*)(ws + WS_EXTRA), need_ctx);
#endif
            } else if (type == OP_ATT0) {
#if PHM & 16
                for (int rep = 0; rep < ((DBL & 16) ? 2 : 1); ++rep) phase_swa(lds, ACT, HN, a.in[I_BSINKS] + (size_t)j * 16, need_ctx);
#endif
            } else {
#if PHM & 32
                for (int rep = 0; rep < ((DBL & 32) ? 2 : 1); ++rep) phase_nat(lds, ACT, (const bf16_t*)(ws + WS_EXTRA), HN, a.in[I_CRPB] + (size_t)j * 16 * 465, need_ctx);
#endif
            }
            xcd_barrier(xb);
#if DBL & 128
            xcd_barrier(xb);
#endif
        }
    }
#if PHM & 2
    phase_final(a);
#endif
}

extern "C" void kernel_launch(void* const* d_in, const int* in_sizes, int n_in, void* d_out, int out_size, void* d_ws, size_t ws_size, hipStream_t stream) {
    static int grid_blocks = 0;
    if (grid_blocks == 0) {
        if (n_in != 23 || ws_size < WS_END) { fprintf(stderr, "kernel_launch: unexpected n_in %d or ws_size %zu (need %zu)\n", n_in, ws_size, (size_t)WS_END); grid_blocks = -1; return; }
        int dev = 0, cus = 0, per_cu = 0;
        (void)hipGetDevice(&dev);
        (void)hipDeviceGetAttribute(&cus, hipDeviceAttributeMultiprocessorCount, dev);
        if (hipFuncSetAttribute((const void*)fwd_megakernel, hipFuncAttributeMaxDynamicSharedMemorySize, LDS_BYTES) != hipSuccess) fprintf(stderr, "kernel_launch: hipFuncSetAttribute failed\n");
        (void)hipOccupancyMaxActiveBlocksPerMultiprocessor(&per_cu, (const void*)fwd_megakernel, 512, LDS_BYTES);
        (void)hipGetLastError();
        if (per_cu < 1) per_cu = 1;
        grid_blocks = cus * 1;
    }
    if (grid_blocks < 0) return;
    Args a{};
    for (int i = 0; i < 23; ++i) a.in[i] = (const float*)d_in[i];
    a.out = (float*)d_out; a.ws = (unsigned char*)d_ws;
    void* args[] = {&a};
    hipError_t e = hipLaunchCooperativeKernel((const void*)fwd_megakernel, dim3(grid_blocks), dim3(512), args, LDS_BYTES, stream);
    if (e != hipSuccess) fprintf(stderr, "cooperative launch failed: %s (grid %d)\n", hipGetErrorString(e), grid_blocks);
}
```

```cpp
#include <hip/hip_runtime.h>
#include <hip/hip_cooperative_groups.h>
#include <cstdio>
#include <cstdint>
namespace cg = cooperative_groups;

#define LAS __attribute__((address_space(3)))
typedef unsigned short bf16_t;
typedef short bf16x8 __attribute__((ext_vector_type(8)));
typedef short bf16x4 __attribute__((ext_vector_type(4)));
typedef float f32x4 __attribute__((ext_vector_type(4)));
typedef unsigned u32x4 __attribute__((ext_vector_type(4)));
typedef unsigned u32x2 __attribute__((ext_vector_type(2)));

constexpr int D = 1024, SEQ = 16384, CTXL = 256, MX = 32768, MCTX = 512, MT = MX + MCTX;
constexpr int DFF = 2816, DRNN = 1536, NLAYER = 4;
constexpr int NCHUNK = 130;
constexpr int LDS_XB = 137216;
constexpr int LDS_BYTES = LDS_XB + 256;

#define XCD_BAR_WORDS 3456
constexpr size_t al256(size_t x) { return (x + 255) & ~(size_t)255; }
constexpr size_t WS_WGU = 0;
constexpr size_t WS_WDN = al256(WS_WGU + (size_t)8 * 5632 * 1024 * 2);
constexpr size_t WS_WAIN = al256(WS_WDN + (size_t)8 * 1024 * 2816 * 2);
constexpr size_t WS_WAOUT = al256(WS_WAIN + (size_t)2 * 3072 * 1024 * 2);
constexpr size_t WS_WAG = al256(WS_WAOUT + (size_t)2 * 1024 * 1536 * 2);
constexpr size_t WS_WBQKV = al256(WS_WAG + (size_t)96 * 128 * 128 * 2);
constexpr size_t WS_WBO = al256(WS_WBQKV + (size_t)1536 * 1024 * 2);
constexpr size_t WS_WCQKV = al256(WS_WBO + (size_t)1024 * 1024 * 2);
constexpr size_t WS_WCO = al256(WS_WCQKV + (size_t)3072 * 1024 * 2);
constexpr size_t WS_MOD = al256(WS_WCO + (size_t)1024 * 1024 * 2);
constexpr size_t WS_ROPE = al256(WS_MOD + (size_t)4 * 3 * 9216 * 4);
constexpr size_t WS_PE = al256(WS_ROPE + (size_t)2 * 256 * 16 * 4);
constexpr size_t PE_HALF = (size_t)2 * 2 * NCHUNK * DRNN;
constexpr size_t WS_CIN = al256(WS_PE + 2 * PE_HALF * 4);
constexpr size_t WS_XS = al256(WS_CIN + PE_HALF * 4);
constexpr size_t WS_HN = al256(WS_XS + (size_t)MT * D * 4);
constexpr size_t WS_ACT = al256(WS_HN + (size_t)MT * 1536 * 2);
constexpr size_t WS_EXTRA = al256(WS_ACT + (size_t)MT * 3072 * 2);
constexpr size_t WS_SLAB = al256(WS_EXTRA + (size_t)MT * 1024 * 2);
constexpr size_t WS_BAR = al256(WS_EXTRA + (size_t)MT * 1536 * 2);
static_assert(WS_SLAB + (size_t)11 * MCTX * D * 4 <= WS_BAR, "slabs must fit in EXTRA's tail");
constexpr size_t WS_END = al256(WS_BAR + (size_t)XCD_BAR_WORDS * 4);

__device__ __forceinline__ int opaque_tid() { int t = threadIdx.x; asm volatile("" : "+v"(t)); return t; }
__device__ __forceinline__ size_t opaque_zero() { size_t z = 0; asm volatile("" : "+s"(z)); return z; }
__device__ __forceinline__ unsigned cvt_pk_bf16(float lo, float hi) { unsigned r; asm("v_cvt_pk_bf16_f32 %0, %1, %2" : "=v"(r) : "v"(lo), "v"(hi)); return r; }
__device__ __forceinline__ float bf2f(bf16_t b) { return __uint_as_float(((unsigned)b) << 16); }
__device__ __forceinline__ float bflo(unsigned u) { return __uint_as_float(u << 16); }
__device__ __forceinline__ float bfhi(unsigned u) { return __uint_as_float(u & 0xffff0000u); }
__device__ __forceinline__ float sigmoidf_(float z) { return __builtin_amdgcn_rcpf(1.0f + __expf(-z)); }
__device__ __forceinline__ float siluf_(float z) { return z * sigmoidf_(z); }
__device__ __forceinline__ float gelu_tanh(float x) { const float u = 0.7978845608028654f * (x + 0.044715f * x * x * x); return x * sigmoidf_(2.0f * u); }
__device__ __forceinline__ float wave_sum(float v) {
#pragma unroll
    for (int o = 1; o < 64; o <<= 1) v += __shfl_xor(v, o);
    return v;
}

#define XB_TMO      128
#define XB_XCNT(j)  (256  + 64 * (j))
#define XB_XSUB(j)  (1280 + 64 * (j))
#define XB_XGEN(j)  (2304 + 64 * (j))
#define XB_TOP      3328
#define XB_TOPGEN   3392
#define XB_SPIN_CAP (1u << 20)
__device__ __forceinline__ unsigned xb_ld(unsigned* p)              { return __hip_atomic_load(p, __ATOMIC_RELAXED, __HIP_MEMORY_SCOPE_AGENT); }
__device__ __forceinline__ unsigned xb_add(unsigned* p, unsigned v) { return __hip_atomic_fetch_add(p, v, __ATOMIC_RELAXED, __HIP_MEMORY_SCOPE_AGENT); }
__device__ __forceinline__ unsigned xb_xcc_id() { return (unsigned)__builtin_amdgcn_s_getreg((3 << 11) | 20) & 0xFu; }
#define XB_SPIN(cond, bar) do { unsigned _sp = 0; while (cond) { __builtin_amdgcn_s_sleep(1); \
    if ((++_sp & 255u) == 0u) { if (xb_ld(&(bar)[XB_TMO])) break; if (_sp > XB_SPIN_CAP) { atomicAdd(&(bar)[XB_TMO], 1u); break; } } } } while (0)
struct XcdBarrier { unsigned* bar; unsigned x; volatile LAS unsigned* st; };
__device__ __forceinline__ XcdBarrier xcd_barrier_post(unsigned* bar, volatile LAS unsigned* st) {
    XcdBarrier b; b.bar = bar; b.x = xb_xcc_id(); b.st = st;
    if (threadIdx.x == 0) (void)xb_add(&bar[XB_XCNT(b.x)], 1u);
    return b;
}
__device__ __forceinline__ void xcd_barrier_complete(unsigned* bar, unsigned x, unsigned& nloc, unsigned& nx) {
    const unsigned G = gridDim.x * gridDim.y * gridDim.z;
    unsigned sum, cnt, mine, sp = 0u;
    for (;;) {
        sum = 0u; cnt = 0u; mine = 0u;
#pragma unroll
        for (unsigned j = 0; j < 16; ++j) { const unsigned c = xb_ld(&bar[XB_XCNT(j)]); sum += c; cnt += (c > 0u) ? 1u : 0u; mine = (j == x) ? c : mine; }
        if (sum == G) break;
        __builtin_amdgcn_s_sleep(1);
        if ((++sp & 255u) == 0u) { if (xb_ld(&bar[XB_TMO])) break; if (sp > XB_SPIN_CAP) { atomicAdd(&bar[XB_TMO], 1u); break; } }
    }
    nloc = mine > 0u ? mine : 1u; nx = cnt > 0u ? cnt : 1u;
}
__device__ __forceinline__ void xcd_barrier(const XcdBarrier& b) {
    asm volatile("s_waitcnt vmcnt(0)" ::: "memory");
    __syncthreads();
    if (threadIdx.x == 0) {
        unsigned* bar = b.bar;
        __builtin_amdgcn_s_waitcnt(0);
        unsigned nloc = b.st[0], nx = b.st[1];
        if (nloc == 0u) { xcd_barrier_complete(bar, b.x, nloc, nx); b.st[0] = nloc; b.st[1] = nx; }
        const unsigned old = xb_add(&bar[XB_XSUB(b.x)], 1u);
        const unsigned gen = old / nloc;
        if (old + 1u == (gen + 1u) * nloc) {
            __builtin_amdgcn_fence(__ATOMIC_RELEASE, "agent");
            asm volatile("s_waitcnt vmcnt(0)" ::: "memory");
            const unsigned og = xb_add(&bar[XB_TOP], 1u);
            const unsigned tg = og / nx;
            if (og + 1u == (tg + 1u) * nx) xb_add(&bar[XB_TOPGEN], 1u);
            else XB_SPIN(xb_ld(&bar[XB_TOPGEN]) == tg, bar);
            __builtin_amdgcn_fence(__ATOMIC_ACQUIRE, "agent");
            xb_add(&bar[XB_XGEN(b.x)], 1u);
            asm volatile("s_waitcnt vmcnt(0)" ::: "memory");
        } else {
            XB_SPIN(xb_ld(&bar[XB_XGEN(b.x)]) == gen, bar);
            __builtin_amdgcn_fence(__ATOMIC_ACQUIRE, "agent");
            asm volatile("s_waitcnt vmcnt(0)" ::: "memory");
        }
    }
    __syncthreads();
}

namespace pg8 {
constexpr int BM = 256, BK = 64, HALF = 128, HTB = HALF * BK * 2, STAGE_BYTES = 8 * HTB, NXCD = 8, WGM = 8;
__device__ __forceinline__ int lds_byte(int r, int c) { const int st = (r >> 4) * 2 + (c >> 5), rr = r & 15, cc = c & 31, ob = rr * 64 + cc * 2; return st * 1024 + (ob ^ (((ob >> 9) & 1) << 5)); }
__device__ __forceinline__ void stage_rc(int b, int& R, int& C) { const int st = b / 1024, sb = b % 1024, swz = sb ^ (((sb >> 9) & 1) << 5); R = (st >> 1) * 16 + swz / 64; C = (st & 1) * 32 + (swz % 64) / 2; }
__device__ __forceinline__ int perm32(int rho) { const int n = rho >> 4, i = rho & 15; return 8 * (i >> 2) + 4 * n + (i & 3); }
struct Unit { int pm, pn, ks, nt, at; };
struct Gemm { const bf16_t* A; const bf16_t* Bt; int M, N, K; };
struct StaticOrder {
    int nM, nN, nwg, G, c, nctx, main_nt;
    __device__ void init(int M, int N, int K, int G_, int c_, bool splitctx) {
        nN = N / BM; G = G_; c = c_; main_nt = K / BK;
        if (splitctx && M == MT) { nM = MX / BM; nctx = 2 * nN * (K / 256); } else { nM = M / BM; nctx = 0; }
        nwg = nM * nN;
    }
    __device__ bool next(int i, Unit& u) const {
        long L = (long)i * G + c;
        if (L >= nwg) {
            L -= nwg; if (L >= nctx) return false;
            const int rem = (int)L % (2 * nN);
            u.ks = (int)L / (2 * nN); u.pm = 128 + (rem & 1); u.pn = rem >> 1; u.nt = 4; u.at = 1; return true;
        }
        int wgid = (int)L; { const int q = nwg / NXCD, r = nwg % NXCD, xcd = wgid % NXCD, off = wgid / NXCD; wgid = (xcd < r ? xcd * (q + 1) : r * (q + 1) + (xcd - r) * q) + off; }
        const int nig = WGM * nN, gid = wgid / nig, fm = gid * WGM, gsz = (nM - fm) < WGM ? (nM - fm) : WGM;
        u.pm = fm + ((wgid % nig) % gsz); u.pn = (wgid % nig) / gsz; u.ks = 0; u.nt = main_nt; u.at = 0; return true;
    }
};
template <class Epi>
__device__ __forceinline__ void gemm_phase(LAS unsigned char* lds, const Gemm g, const StaticOrder& S, const Epi& E) {
    const int tid = opaque_tid(), wid = __builtin_amdgcn_readfirstlane(tid >> 6), lane = tid & 63, wr = wid >> 2, wc = wid & 3, fr = lane & 15, fq = lane >> 4;
    const int K = g.K;
    unsigned voffA[2], voffB[2];
#pragma unroll
    for (int i = 0; i < 2; ++i) { int R, C; stage_rc(tid * 16 + i * 8192, R, C); const int Rb = E.perm() ? ((R & ~31) + perm32(R & 31)) : R;
        voffA[i] = (unsigned)(R * K + C) * 2u; voffB[i] = (unsigned)(Rb * K + C) * 2u; }
    const size_t kstep = (size_t)(BK * 2);
    const size_t hstep = (size_t)HALF * K * 2;
    const size_t tstep = 2 * hstep;
    const unsigned ldsw = (unsigned)wid * 1024u;
    const int aoff = lds_byte(wr * 64 + fr, fq * 8), boff = lds_byte(wc * 32 + fr, fq * 8);
#define PG8_SA(b, h) (((b) * 2 + (h)) * HTB)
#define PG8_SB(b, h) ((4 + (b) * 2 + (h)) * HTB)
#define PG8_STAGE(bufoff, gbase, voff) do { _Pragma("unroll") for (int _i = 0; _i < 2; ++_i) \
        __builtin_amdgcn_global_load_lds((const unsigned*)((const char*)(gbase) + (voff)[_i]), (LAS unsigned*)(lds + (bufoff) + ldsw + _i * 8192), 16, 0, 0); } while (0)
#define PG8_LDA(dst, b, h) do { _Pragma("unroll") for (int m = 0; m < 4; ++m) _Pragma("unroll") for (int k = 0; k < 2; ++k) dst[m][k] = *(const LAS bf16x8*)(lds + PG8_SA(b, h) + aoff + m * 2048 + k * 1024); } while (0)
#define PG8_LDB(dst, b, h) do { _Pragma("unroll") for (int n = 0; n < 2; ++n) _Pragma("unroll") for (int k = 0; k < 2; ++k) dst[n][k] = *(const LAS bf16x8*)(lds + PG8_SB(b, h) + boff + n * 2048 + k * 1024); } while (0)
#define PG8_MMA(ai, bj, At, Bt) do { __builtin_amdgcn_s_setprio(1); _Pragma("unroll") for (int m = 0; m < 4; ++m) _Pragma("unroll") for (int n = 0; n < 2; ++n) _Pragma("unroll") for (int k = 0; k < 2; ++k) \
        acc[ai][bj][m][n] = __builtin_amdgcn_mfma_f32_16x16x32_bf16(Bt[n][k], At[m][k], acc[ai][bj][m][n], 0, 0, 0); __builtin_amdgcn_s_setprio(0); } while (0)
#define PG8_WAIT_V(n) asm volatile("s_waitcnt vmcnt(" #n ")" ::: "memory")
#define PG8_WAIT_L(n) asm volatile("s_waitcnt lgkmcnt(" #n ")" ::: "memory")
#define PG8_BAR __builtin_amdgcn_s_barrier()
#define PG8_SCHED __builtin_amdgcn_sched_barrier(0)
    Unit cur, nxt; int ui = 0;
    if (!S.next(0, cur)) return;
    f32x4 acc[2][2][4][2];
#pragma unroll
    for (int a = 0; a < 2; ++a)
#pragma unroll
        for (int b = 0; b < 2; ++b)
#pragma unroll
            for (int m = 0; m < 4; ++m)
#pragma unroll
                for (int n = 0; n < 2; ++n) acc[a][b][m][n] = (f32x4){0.f, 0.f, 0.f, 0.f};
    bf16x8 At[4][2], B0[2][2], B1[2][2];
    const char* cA = (const char*)g.A + (size_t)cur.pm * tstep + (size_t)cur.ks * 512; const char* cB = (const char*)g.Bt + (size_t)cur.pn * tstep + (size_t)cur.ks * 512;
    PG8_STAGE(PG8_SB(0, 0), cB, voffB); PG8_STAGE(PG8_SA(0, 0), cA, voffA); PG8_STAGE(PG8_SB(0, 1), cB + hstep, voffB); PG8_STAGE(PG8_SA(0, 1), cA + hstep, voffA);
    if (wr == 1) PG8_BAR;
    PG8_WAIT_V(4); PG8_BAR;
    PG8_STAGE(PG8_SB(1, 0), cB + kstep, voffB); PG8_STAGE(PG8_SA(1, 0), cA + kstep, voffA); PG8_STAGE(PG8_SB(1, 1), cB + hstep + kstep, voffB);
    PG8_WAIT_V(6); PG8_BAR;
    for (;;) {
        const bool has_next = S.next(ui + 1, nxt);
        const char* nA = has_next ? (const char*)g.A + (size_t)nxt.pm * tstep + (size_t)nxt.ks * 512 : cA; const char* nB = has_next ? (const char*)g.Bt + (size_t)nxt.pn * tstep + (size_t)nxt.ks * 512 : cB;
        const int nt = cur.nt;
        for (int t = 0; t < nt; t += 2) {
            const bool last = (t == nt - 2);
            const char* a1 = cA + (size_t)(t + 1) * kstep;
            const char* a2 = last ? nA : cA + (size_t)(t + 2) * kstep; const char* b2 = last ? nB : cB + (size_t)(t + 2) * kstep;
            const char* a3 = a2 + kstep; const char* b3 = b2 + kstep;
            PG8_LDB(B0, 0, 0); PG8_SCHED; PG8_LDA(At, 0, 0); PG8_STAGE(PG8_SA(1, 1), a1 + hstep, voffA);
            PG8_WAIT_L(8); PG8_BAR; PG8_WAIT_L(0); PG8_MMA(0, 0, At, B0); PG8_BAR; PG8_SCHED;
            PG8_LDB(B1, 0, 1); PG8_STAGE(PG8_SB(0, 0), b2, voffB);
            PG8_BAR; PG8_WAIT_L(0); PG8_MMA(0, 1, At, B1); PG8_BAR;
            PG8_LDA(At, 0, 1); PG8_STAGE(PG8_SA(0, 0), a2, voffA);
            PG8_BAR; PG8_WAIT_L(0); PG8_MMA(1, 0, At, B0); PG8_BAR; PG8_SCHED;
            PG8_STAGE(PG8_SB(0, 1), b2 + hstep, voffB);
            PG8_WAIT_V(6); PG8_BAR; PG8_MMA(1, 1, At, B1); PG8_BAR;
            PG8_LDB(B0, 1, 0); PG8_SCHED; PG8_LDA(At, 1, 0); PG8_STAGE(PG8_SA(0, 1), a2 + hstep, voffA);
            PG8_WAIT_L(8); PG8_BAR; PG8_WAIT_L(0); PG8_MMA(0, 0, At, B0); PG8_BAR; PG8_SCHED;
            PG8_LDB(B1, 1, 1); PG8_STAGE(PG8_SB(1, 0), b3, voffB);
            PG8_BAR; PG8_WAIT_L(0); PG8_MMA(0, 1, At, B1); PG8_BAR;
            PG8_LDA(At, 1, 1); PG8_STAGE(PG8_SA(1, 0), a3, voffA);
            PG8_BAR; PG8_WAIT_L(0); PG8_MMA(1, 0, At, B0); PG8_BAR; PG8_SCHED;
            PG8_STAGE(PG8_SB(1, 1), b3 + hstep, voffB);
            PG8_WAIT_V(6); PG8_BAR; PG8_MMA(1, 1, At, B1); PG8_BAR;
        }
        if (wr == 0) PG8_BAR;
        E(acc, cur, wr, wc, fr, fq);
        if (!has_next) break;
#pragma unroll
        for (int a = 0; a < 2; ++a)
#pragma unroll
            for (int b = 0; b < 2; ++b)
#pragma unroll
                for (int m = 0; m < 4; ++m)
#pragma unroll
                    for (int n = 0; n < 2; ++n) acc[a][b][m][n] = (f32x4){0.f, 0.f, 0.f, 0.f};
        cur = nxt; cA = nA; cB = nB; ++ui;
        if (wr == 1) PG8_BAR;
    }
    PG8_WAIT_V(0);
    PG8_BAR;
#undef PG8_SA
#undef PG8_SB
#undef PG8_STAGE
#undef PG8_LDA
#undef PG8_LDB
#undef PG8_MMA
#undef PG8_WAIT_V
#undef PG8_WAIT_L
#undef PG8_BAR
#undef PG8_SCHED
}
}
using pg8::Unit;
typedef f32x4 AccT[2][2][4][2];

struct EpiSwiGLU {
    static constexpr bool PERM = true;
    bf16_t* out;
    __device__ __forceinline__ void operator()(const AccT& acc, const Unit& u, int wr, int wc, int fr, int fq) const {
        const int row0 = u.pm * 256 + wr * 64 + fr, col0 = u.pn * 128 + wc * 32 + 8 * fq;
#pragma unroll
        for (int ai = 0; ai < 2; ++ai)
#pragma unroll
            for (int m = 0; m < 4; ++m) {
                const f32x4 g0 = acc[ai][0][m][0], g1 = acc[ai][0][m][1], u0 = acc[ai][1][m][0], u1 = acc[ai][1][m][1];
                u32x4 o;
                o.x = cvt_pk_bf16(siluf_(g0[0]) * u0[0], siluf_(g0[1]) * u0[1]); o.y = cvt_pk_bf16(siluf_(g0[2]) * u0[2], siluf_(g0[3]) * u0[3]);
                o.z = cvt_pk_bf16(siluf_(g1[0]) * u1[0], siluf_(g1[1]) * u1[1]); o.w = cvt_pk_bf16(siluf_(g1[2]) * u1[2], siluf_(g1[3]) * u1[3]);
                *(u32x4*)(out + (size_t)(row0 + ai * 128 + m * 16) * DFF + col0) = o;
            }
    }
};
struct EpiResid {
    static constexpr bool PERM = true;
    float* slab; bf16_t* y; const float* gate; float coef;
    __device__ __forceinline__ void operator()(const AccT& acc, const Unit& u, int wr, int wc, int fr, int fq) const {
        const int mb = (u.pm >= 128) ? 2 : (u.pm >= 64 ? 1 : 0);
        const float* gp = gate + mb * 9216;
        const int row0 = u.pm * 256 + wr * 64 + fr, col0 = u.pn * 256 + wc * 32 + 8 * fq;
        f32x4 gv[2][2];
#pragma unroll
        for (int bj = 0; bj < 2; ++bj)
#pragma unroll
            for (int n = 0; n < 2; ++n) gv[bj][n] = *(const f32x4*)(gp + col0 + bj * 128 + 4 * n) * coef;
#pragma unroll
        for (int ai = 0; ai < 2; ++ai)
#pragma unroll
            for (int m = 0; m < 4; ++m) {
                const size_t ro = (size_t)(row0 + ai * 128 + m * 16) * D + col0;
#pragma unroll
                for (int bj = 0; bj < 2; ++bj) {
                    const f32x4 v0 = gv[bj][0] * acc[ai][bj][m][0], v1 = gv[bj][1] * acc[ai][bj][m][1];
                    if (u.at) {
                        float* pf = slab + (size_t)u.ks * MCTX * D + (ro - (size_t)MX * D) + bj * 128;
                        *(f32x4*)pf = v0; *(f32x4*)(pf + 4) = v1;
                    } else {
                        u32x4 o; o.x = cvt_pk_bf16(v0[0], v0[1]); o.y = cvt_pk_bf16(v0[2], v0[3]); o.z = cvt_pk_bf16(v1[0], v1[1]); o.w = cvt_pk_bf16(v1[2], v1[3]);
                        *(u32x4*)(y + ro + bj * 128) = o;
                    }
                }
            }
    }
};
struct EpiBf16 {
    static constexpr bool PERM = true;
    bf16_t* out; int ldc; int qcols; float qscale; bf16_t* vt;
    __device__ __forceinline__ void operator()(const AccT& acc, const Unit& u, int wr, int wc, int fr, int fq) const {
        const int row0 = u.pm * 256 + wr * 64 + fr, col0 = u.pn * 256 + wc * 32 + 8 * fq;
        const float sc = (u.pn * 256 < qcols) ? qscale : 1.0f;
        if (vt != nullptr && u.pn >= 8) {
            const bool isx = u.pm < 128;
            const int bb = isx ? (u.pm >> 6) : ((u.pm - 128));
            const size_t tstride = isx ? (size_t)SEQ : (size_t)CTXL;
            bf16_t* base = vt + (isx ? (size_t)0 : (size_t)2 * 16 * 64 * SEQ) + (size_t)bb * 16 * 64 * tstride;
            const int tok0 = (isx ? ((u.pm & 63) * 256) : 0) + wr * 64 + fr;
#pragma unroll
            for (int ai = 0; ai < 2; ++ai)
#pragma unroll
                for (int m = 0; m < 4; ++m) {
                    const int tok = tok0 + ai * 128 + m * 16;
#pragma unroll
                    for (int bj = 0; bj < 2; ++bj) {
                        const int hd = col0 - 2048 + bj * 128;
                        bf16_t* p = base + (size_t)hd * tstride + tok;
                        const f32x4 v0 = acc[ai][bj][m][0], v1 = acc[ai][bj][m][1];
                        const unsigned a0 = cvt_pk_bf16(v0[0], v0[1]), a1 = cvt_pk_bf16(v0[2], v0[3]), a2 = cvt_pk_bf16(v1[0], v1[1]), a3 = cvt_pk_bf16(v1[2], v1[3]);
                        p[0 * tstride] = (bf16_t)(a0 & 0xffff); p[1 * tstride] = (bf16_t)(a0 >> 16); p[2 * tstride] = (bf16_t)(a1 & 0xffff); p[3 * tstride] = (bf16_t)(a1 >> 16);
                        p[4 * tstride] = (bf16_t)(a2 & 0xffff); p[5 * tstride] = (bf16_t)(a2 >> 16); p[6 * tstride] = (bf16_t)(a3 & 0xffff); p[7 * tstride] = (bf16_t)(a3 >> 16);
                    }
                }
            return;
        }
#pragma unroll
        for (int ai = 0; ai < 2; ++ai)
#pragma unroll
            for (int m = 0; m < 4; ++m) {
                bf16_t* rowp = out + (size_t)(row0 + ai * 128 + m * 16) * ldc + col0;
#pragma unroll
                for (int bj = 0; bj < 2; ++bj) {
                    const f32x4 v0 = acc[ai][bj][m][0] * sc, v1 = acc[ai][bj][m][1] * sc;
                    u32x4 o; o.x = cvt_pk_bf16(v0[0], v0[1]); o.y = cvt_pk_bf16(v0[2], v0[3]); o.z = cvt_pk_bf16(v1[0], v1[1]); o.w = cvt_pk_bf16(v1[2], v1[3]);
                    *(u32x4*)(rowp + bj * 128) = o;
                }
            }
    }
};
struct EpiRope {
    static constexpr bool PERM = false;
    bf16_t* out; const float* rope;
    __device__ __forceinline__ void operator()(const AccT& acc, const Unit& u, int wr, int wc, int fr, int fq) const {
        const int row0 = u.pm * 256 + wr * 64 + fr, col0 = u.pn * 256 + wc * 32 + 4 * fq;
        const bool is_q = u.pn < 4, is_v = u.pn == 5, do_rope = (!is_v) && (u.pm < 128);
        const float sc = is_q ? 0.125f * 1.4426950408889634f : 1.0f;
#pragma unroll
        for (int ai = 0; ai < 2; ++ai)
#pragma unroll
            for (int m = 0; m < 4; ++m) {
                const int row = row0 + ai * 128 + m * 16;
                const int t = row & (SEQ - 1);
                const int pos = (wc & 1) ? (t & 63) : (t >> 6);
                f32x4 cs = (f32x4){1.f, 1.f, 1.f, 1.f}, sn = (f32x4){0.f, 0.f, 0.f, 0.f};
                if (do_rope) { cs = *(const f32x4*)(rope + pos * 16 + 4 * fq); sn = *(const f32x4*)(rope + 4096 + pos * 16 + 4 * fq); }
                bf16_t* rowp = out + (size_t)row * 1536 + col0;
#pragma unroll
                for (int bj = 0; bj < 2; ++bj) {
                    const f32x4 x1 = acc[ai][bj][m][0], x2 = acc[ai][bj][m][1];
                    const f32x4 o1 = (x1 * cs - x2 * sn) * sc, o2 = (x2 * cs + x1 * sn) * sc;
                    u32x2 a, b; a.x = cvt_pk_bf16(o1[0], o1[1]); a.y = cvt_pk_bf16(o1[2], o1[3]); b.x = cvt_pk_bf16(o2[0], o2[1]); b.y = cvt_pk_bf16(o2[2], o2[3]);
                    *(u32x2*)(rowp + bj * 128) = a; *(u32x2*)(rowp + bj * 128 + 16) = b;
                }
            }
    }
};

struct EpiAny {
    int mode;
    EpiSwiGLU e0; EpiResid e1; EpiBf16 e2; EpiRope e3;
    __device__ __forceinline__ bool perm() const { return mode != 3; }
    __device__ __forceinline__ void operator()(const AccT& acc, const Unit& u, int wr, int wc, int fr, int fq) const {
        if (mode == 0) e0(acc, u, wr, wc, fr, fq);
        else if (mode == 1) e1(acc, u, wr, wc, fr, fq);
        else if (mode == 2) e2(acc, u, wr, wc, fr, fq);
        else e3(acc, u, wr, wc, fr, fq);
    }
};

struct Args {
    const float* in[23];
    float* out;
    unsigned char* ws;
};
enum { I_X = 0, I_C, I_CTX, I_CCTX, I_WADA, I_BADA, I_NORMG, I_WGU, I_WDN, I_AWIN, I_ACONVW, I_ACONVB, I_AGATEW, I_AGATEB, I_ALAM, I_AWOUT,
       I_BWQKV, I_BSINKS, I_BWO, I_CWQKV, I_CRPB, I_CWO, I_FINALG };

__device__ __forceinline__ void transpose_item(const float* W, int K, int N, bf16_t* WT, int k0, int n0, int drow0, LAS float* scr, int lane) {
    f32x4 wv[8];
#pragma unroll
    for (int i = 0; i < 8; ++i) wv[i] = __builtin_nontemporal_load((const f32x4*)(W + (size_t)(k0 + (lane >> 3) + 8 * i) * N + n0 + 4 * (lane & 7)));
#pragma unroll
    for (int i = 0; i < 8; ++i) { LAS float* sp = scr + ((lane >> 3) + 8 * i) * 33 + 4 * (lane & 7); sp[0] = wv[i][0]; sp[1] = wv[i][1]; sp[2] = wv[i][2]; sp[3] = wv[i][3]; }
    asm volatile("s_waitcnt lgkmcnt(0)" ::: "memory");
    const int c = lane & 7;
#pragma unroll
    for (int j = 0; j < 4; ++j) { const int n = (lane >> 3) + 8 * j; const LAS float* s = scr + (8 * c) * 33 + n;
        u32x4 o; o.x = cvt_pk_bf16(s[0 * 33], s[1 * 33]); o.y = cvt_pk_bf16(s[2 * 33], s[3 * 33]); o.z = cvt_pk_bf16(s[4 * 33], s[5 * 33]); o.w = cvt_pk_bf16(s[6 * 33], s[7 * 33]);
        *(u32x4*)(WT + (size_t)(drow0 + n) * K + k0 + 8 * c) = o; }
    asm volatile("s_waitcnt lgkmcnt(0)" ::: "memory");
}
__device__ __forceinline__ bool transpose_family(int& it, const float* W, int cnt, int K, int N, bf16_t* WT, bool gu, LAS float* scr, int lane) {
    const int nblk = N / 32, kblk = K / 64, per = nblk * kblk, tot = per * cnt;
    if (it >= tot) { it -= tot; return false; }
    const int mi = it / per, r = it % per, kb = r / nblk, nb = r % nblk;
    const int n0 = 32 * nb; int drow0 = n0;
    if (gu) { const int half = n0 >= DFF ? 1 : 0, nn = n0 - half * DFF; drow0 = (nn >> 7) * 256 + half * 128 + (nn & 127); }
    transpose_item(W + (size_t)mi * K * N, K, N, WT + (size_t)mi * K * N, 64 * kb, n0, drow0, scr, lane);
    return true;
}
__device__ __forceinline__ void phase_prep(const Args& a, LAS unsigned char* lds) {
    const int tid = opaque_tid(), lane = tid & 63, wave = tid >> 6;
    unsigned char* ws = a.ws;
    {
        const int idx = blockIdx.x * 512 + tid;
        if (idx < 4096) {
            const int pos = idx >> 4, j = idx & 15;
            double inv = (j & 3) == 0 ? 1.0 : ((j & 3) == 1 ? 0.5623413251903491 : ((j & 3) == 2 ? 0.31622776601683794 : 0.1778279410038923));
            const int dec = j >> 2; inv *= (dec == 0 ? 1.0 : dec == 1 ? 0.1 : dec == 2 ? 0.01 : 0.001);
            double rev = (double)pos * inv * 0.15915494309189535; rev -= floor(rev);
            float* rope = (float*)(ws + WS_ROPE);
            rope[idx] = __builtin_amdgcn_cosf((float)rev); rope[4096 + idx] = __builtin_amdgcn_sinf((float)rev);
        }
    }
    {
        LAS float* sv = (LAS float*)lds;
        LAS float* red = sv + 3 * 1024;
        for (int e = tid; e < 3 * 1024; e += 512) { const int v = e >> 10, k = e & 1023; const float cv = v < 2 ? a.in[I_C][v * 1024 + k] : a.in[I_CCTX][k]; sv[e] = siluf_(cv); }
        __syncthreads();
        float* mod = (float*)(ws + WS_MOD);
        for (int task = blockIdx.x; task < 4 * 72; task += gridDim.x) {
            const int i = task / 72, col0 = (task % 72) * 128;
            const int cg4 = tid & 31, kg = tid >> 5;
            const float* wp = a.in[I_WADA] + ((size_t)i * 1024 + kg * 64) * 9216 + col0 + 4 * cg4;
            f32x4 s0 = (f32x4){0, 0, 0, 0}, s1 = s0, s2 = s0;
#pragma unroll 8
            for (int k = 0; k < 64; ++k) { const f32x4 w = *(const f32x4*)(wp + (size_t)k * 9216); const int kk = kg * 64 + k; s0 += w * sv[kk]; s1 += w * sv[1024 + kk]; s2 += w * sv[2048 + kk]; }
#pragma unroll
            for (int e = 0; e < 4; ++e) { red[(kg * 3 + 0) * 128 + 4 * cg4 + e] = s0[e]; red[(kg * 3 + 1) * 128 + 4 * cg4 + e] = s1[e]; red[(kg * 3 + 2) * 128 + 4 * cg4 + e] = s2[e]; }
            __syncthreads();
            if (tid < 384) { const int v = tid >> 7, cc = tid & 127; float s = 0.f;
#pragma unroll
                for (int q = 0; q < 16; ++q) s += red[(q * 3 + v) * 128 + cc];
                mod[((size_t)i * 3 + v) * 9216 + col0 + cc] = s + a.in[I_BADA][(size_t)i * 9216 + col0 + cc]; }
            __syncthreads();
        }
    }
    {
        LAS float* scr = (LAS float*)(lds + wave * 8448);
        const int gw = blockIdx.x * 8 + wave, NGW = gridDim.x * 8;
        constexpr int TOT = 8 * 16 * 176 + 8 * 44 * 32 + 2 * 16 * 96 + 2 * 24 * 32 + 96 * 2 * 4 + 16 * 48 + 16 * 32 + 16 * 96 + 16 * 32;
        for (int item = gw; item < TOT; item += NGW) {
            int it = item;
            if (transpose_family(it, a.in[I_WGU], 8, 1024, 5632, (bf16_t*)(ws + WS_WGU), true, scr, lane)) continue;
            if (transpose_family(it, a.in[I_WDN], 8, 2816, 1024, (bf16_t*)(ws + WS_WDN), false, scr, lane)) continue;
            if (transpose_family(it, a.in[I_AWIN], 2, 1024, 3072, (bf16_t*)(ws + WS_WAIN), false, scr, lane)) continue;
            if (transpose_family(it, a.in[I_AWOUT], 2, 1536, 1024, (bf16_t*)(ws + WS_WAOUT), false, scr, lane)) continue;
            if (transpose_family(it, a.in[I_AGATEW], 96, 128, 128, (bf16_t*)(ws + WS_WAG), false, scr, lane)) continue;
            if (transpose_family(it, a.in[I_BWQKV], 1, 1024, 1536, (bf16_t*)(ws + WS_WBQKV), false, scr, lane)) continue;
            if (transpose_family(it, a.in[I_BWO], 1, 1024, 1024, (bf16_t*)(ws + WS_WBO), false, scr, lane)) continue;
            if (transpose_family(it, a.in[I_CWQKV], 1, 1024, 3072, (bf16_t*)(ws + WS_WCQKV), false, scr, lane)) continue;
            transpose_family(it, a.in[I_CWO], 1, 1024, 1024, (bf16_t*)(ws + WS_WCO), false, scr, lane);
        }
    }
}

__device__ __forceinline__ void phase_norm(const Args& a, int layer, int sub, bool first, int nrows, bool addy, int nsplit) {
    const int tid_ = opaque_tid(), lane = tid_ & 63, gw = blockIdx.x * 8 + (tid_ >> 6), NGW = gridDim.x * 8;
    bf16_t* xs = (bf16_t*)(a.ws + WS_XS); bf16_t* hn = (bf16_t*)(a.ws + WS_HN);
    const float* mod = (const float*)(a.ws + WS_MOD) + (size_t)layer * 3 * 9216;
    const float* ng = a.in[I_NORMG] + ((size_t)layer * 3 + sub) * 1024;
    const bf16_t* yb = (const bf16_t*)(a.ws + WS_EXTRA);
    f32x4 gv[4];
#pragma unroll
    for (int j = 0; j < 4; ++j) gv[j] = *(const f32x4*)(ng + 4 * lane + 256 * j);
    constexpr int R = 4;
    for (int r0 = gw; r0 < MX; r0 += R * NGW) {
        f32x4 v[R][4]; u32x2 xx[R][4], yy[R][4]; int rowq[R]; bool okq[R];
#pragma unroll
        for (int q = 0; q < R; ++q) {
            okq[q] = r0 + q * NGW < MX; rowq[q] = okq[q] ? r0 + q * NGW : r0;
            if (first) {
#pragma unroll
                for (int j = 0; j < 4; ++j) v[q][j] = __builtin_nontemporal_load((const f32x4*)(a.in[I_X] + (size_t)rowq[q] * D + 4 * lane + 256 * j));
            } else {
#pragma unroll
                for (int j = 0; j < 4; ++j) xx[q][j] = __builtin_nontemporal_load((const u32x2*)(xs + (size_t)rowq[q] * D + 4 * lane + 256 * j));
            }
            if (addy) {
#pragma unroll
                for (int j = 0; j < 4; ++j) yy[q][j] = __builtin_nontemporal_load((const u32x2*)(yb + (size_t)rowq[q] * D + 4 * lane + 256 * j));
            }
        }
#pragma unroll
        for (int q = 0; q < R; ++q) {
            const int row = rowq[q];
            float s = 0.f;
#pragma unroll
            for (int j = 0; j < 4; ++j) {
                if (!first) { v[q][j][0] = bflo(xx[q][j].x); v[q][j][1] = bfhi(xx[q][j].x); v[q][j][2] = bflo(xx[q][j].y); v[q][j][3] = bfhi(xx[q][j].y); }
                if (addy) { v[q][j][0] += bflo(yy[q][j].x); v[q][j][1] += bfhi(yy[q][j].x); v[q][j][2] += bflo(yy[q][j].y); v[q][j][3] += bfhi(yy[q][j].y); }
                s += (v[q][j][0] * v[q][j][0] + v[q][j][1] * v[q][j][1]) + (v[q][j][2] * v[q][j][2] + v[q][j][3] * v[q][j][3]);
            }
            if ((first || addy) && okq[q]) {
#pragma unroll
                for (int j = 0; j < 4; ++j) { u32x2 o; o.x = cvt_pk_bf16(v[q][j][0], v[q][j][1]); o.y = cvt_pk_bf16(v[q][j][2], v[q][j][3]); __builtin_nontemporal_store(o, (u32x2*)(xs + (size_t)row * D + 4 * lane + 256 * j)); }
            }
            const float rstd = rsqrtf(wave_sum(s) * (1.0f / D) + 1e-6f);
            const float* shp = mod + (row >= SEQ ? 1 : 0) * 9216 + (sub * 3 + 0) * 1024; const float* scp = shp + 1024;
            if (okq[q]) {
#pragma unroll
                for (int j = 0; j < 4; ++j) {
                    const f32x4 sh = *(const f32x4*)(shp + 4 * lane + 256 * j), sc = *(const f32x4*)(scp + 4 * lane + 256 * j);
                    const f32x4 y = v[q][j] * rstd * gv[j] * (sc + 1.0f) + sh;
                    u32x2 o; o.x = cvt_pk_bf16(y[0], y[1]); o.y = cvt_pk_bf16(y[2], y[3]);
                    __builtin_nontemporal_store(o, (u32x2*)(hn + (size_t)row * D + 4 * lane + 256 * j));
                }
            }
        }
    }
    for (int row = MX + gw; row < nrows; row += NGW) {
        f32x4 v[4]; float s = 0.f;
        if (first) {
#pragma unroll
            for (int j = 0; j < 4; ++j) v[j] = *(const f32x4*)(a.in[I_CTX] + (size_t)(row - MX) * D + 4 * lane + 256 * j);
        } else {
#pragma unroll
            for (int j = 0; j < 4; ++j) { const u32x2 x2 = *(const u32x2*)(xs + (size_t)row * D + 4 * lane + 256 * j); v[j][0] = bflo(x2.x); v[j][1] = bfhi(x2.x); v[j][2] = bflo(x2.y); v[j][3] = bfhi(x2.y); }
        }
        if (addy) {
            const float* sr = (const float*)(a.ws + WS_SLAB) + (size_t)(row - MX) * D;
            f32x4 pv[11][4];
#pragma unroll
            for (int ks = 0; ks < 11; ++ks) {
                if (ks < nsplit) {
#pragma unroll
                    for (int j = 0; j < 4; ++j) pv[ks][j] = *(const f32x4*)(sr + (size_t)ks * MCTX * D + 4 * lane + 256 * j);
                }
            }
#pragma unroll
            for (int ks = 0; ks < 11; ++ks) {
                if (ks < nsplit) {
#pragma unroll
                    for (int j = 0; j < 4; ++j) v[j] += pv[ks][j];
                }
            }
        }
#pragma unroll
        for (int j = 0; j < 4; ++j) s += (v[j][0] * v[j][0] + v[j][1] * v[j][1]) + (v[j][2] * v[j][2] + v[j][3] * v[j][3]);
        if (first || addy) {
#pragma unroll
            for (int j = 0; j < 4; ++j) { u32x2 o; o.x = cvt_pk_bf16(v[j][0], v[j][1]); o.y = cvt_pk_bf16(v[j][2], v[j][3]); *(u32x2*)(xs + (size_t)row * D + 4 * lane + 256 * j) = o; }
        }
        const float rstd = rsqrtf(wave_sum(s) * (1.0f / D) + 1e-6f);
        const float* shp = mod + 2 * 9216 + (sub * 3 + 0) * 1024; const float* scp = shp + 1024;
#pragma unroll
        for (int j = 0; j < 4; ++j) {
            const f32x4 sh = *(const f32x4*)(shp + 4 * lane + 256 * j), sc = *(const f32x4*)(scp + 4 * lane + 256 * j);
            const f32x4 y = v[j] * rstd * gv[j] * (sc + 1.0f) + sh;
            u32x2 o; o.x = cvt_pk_bf16(y[0], y[1]); o.y = cvt_pk_bf16(y[2], y[3]);
            *(u32x2*)(hn + (size_t)row * D + 4 * lane + 256 * j) = o;
        }
    }
}
__device__ __forceinline__ void phase_final(const Args& a) {
    const int tid_ = opaque_tid(), lane = tid_ & 63, gw = blockIdx.x * 8 + (tid_ >> 6), NGW = gridDim.x * 8;
    const bf16_t* xs = (const bf16_t*)(a.ws + WS_XS);
    const bf16_t* yb = (const bf16_t*)(a.ws + WS_EXTRA);
    f32x4 gv[4];
#pragma unroll
    for (int j = 0; j < 4; ++j) gv[j] = *(const f32x4*)(a.in[I_FINALG] + 4 * lane + 256 * j);
    constexpr int R = 4;
    for (int r0 = gw; r0 < MX; r0 += R * NGW) {
        u32x2 xx[R][4], yy[R][4]; int rowq[R]; bool okq[R];
#pragma unroll
        for (int q = 0; q < R; ++q) {
            okq[q] = r0 + q * NGW < MX; rowq[q] = okq[q] ? r0 + q * NGW : r0;
#pragma unroll
            for (int j = 0; j < 4; ++j) { xx[q][j] = *(const u32x2*)(xs + (size_t)rowq[q] * D + 4 * lane + 256 * j); yy[q][j] = *(const u32x2*)(yb + (size_t)rowq[q] * D + 4 * lane + 256 * j); }
        }
#pragma unroll
        for (int q = 0; q < R; ++q) {
            float s = 0.f; f32x4 v[4];
#pragma unroll
            for (int j = 0; j < 4; ++j) {
                v[j][0] = bflo(xx[q][j].x) + bflo(yy[q][j].x); v[j][1] = bfhi(xx[q][j].x) + bfhi(yy[q][j].x); v[j][2] = bflo(xx[q][j].y) + bflo(yy[q][j].y); v[j][3] = bfhi(xx[q][j].y) + bfhi(yy[q][j].y);
                s += (v[j][0] * v[j][0] + v[j][1] * v[j][1]) + (v[j][2] * v[j][2] + v[j][3] * v[j][3]);
            }
            const float rstd = rsqrtf(wave_sum(s) * (1.0f / D) + 1e-6f);
            if (okq[q]) {
#pragma unroll
                for (int j = 0; j < 4; ++j) *(f32x4*)(a.out + (size_t)rowq[q] * D + 4 * lane + 256 * j) = v[j] * rstd * gv[j];
            }
        }
    }
}

__device__ __forceinline__ void phase_swa(LAS unsigned char* lds, const bf16_t* QKV, bf16_t* O, const float* sinks, bool need_ctx) {
    constexpr int LDQ = 1536, KS = 72, VS = 72;
    LAS bf16_t* Ks = (LAS bf16_t*)lds;
    LAS bf16_t* Vt = Ks + 64 * KS;
    const int tid = opaque_tid(), w = tid >> 6, lane = tid & 63, fr = lane & 15, fq = lane >> 4;
    const int lrow = tid >> 3, lcg = tid & 7;
    const int n_items = 2048 + (need_ctx ? 32 : 0);
    for (int item = blockIdx.x; item < n_items; item += gridDim.x) {
        const bool cq = item >= 2048;
        int b, hp, g, jb;
        if (!cq) { hp = item & 1; g = (item >> 1) & 3; jb = (item >> 3) & 127; b = item >> 10; }
        else { const int it = item - 2048; hp = it & 1; g = (it >> 1) & 3; jb = (it >> 3) & 1; b = it >> 4; }
        const int h = 4 * g + 2 * hp + (w >> 2), qsub = (w & 3) * 32;
        const int qrow0 = cq ? (MX + b * CTXL + jb * 128 + qsub) : (b * SEQ + jb * 128 + qsub);
        const int kcol0 = 1024 + g * 64, vcol0 = 1280 + g * 64;
        bf16x8 Qf[2][2];
#pragma unroll
        for (int qt = 0; qt < 2; ++qt)
#pragma unroll
            for (int k2 = 0; k2 < 2; ++k2) Qf[qt][k2] = *(const bf16x8*)(QKV + (size_t)(qrow0 + 16 * qt + fr) * LDQ + h * 64 + 32 * k2 + 8 * fq);
        f32x4 Oa[4][2];
#pragma unroll
        for (int dt = 0; dt < 4; ++dt)
#pragma unroll
            for (int qt = 0; qt < 2; ++qt) Oa[dt][qt] = (f32x4){0.f, 0.f, 0.f, 0.f};
        float mrun[2], lrun[2];
        { const float sk = sinks[h] * 1.4426950408889634f; mrun[0] = mrun[1] = sk; lrun[0] = lrun[1] = (fq == 0) ? 1.0f : 0.0f; }
        const int ntiles = cq ? 4 : 10;
#define SWA_KPOS(t_) (jb * 128 - 128 + 64 * ((t_) - 4))
#define SWA_VALID(t_) ((t_) < 4 || (SWA_KPOS(t_) >= 0 && SWA_KPOS(t_) < SEQ))
#define SWA_KROW(t_) ((t_) < 4 ? (MX + b * CTXL + 64 * (t_)) : (b * SEQ + SWA_KPOS(t_)))
        u32x4 kreg, vreg;
        int ti = 0;
        { const size_t ro = (size_t)(SWA_KROW(0) + lrow) * LDQ + 8 * lcg; kreg = *(const u32x4*)(QKV + ro + kcol0); vreg = *(const u32x4*)(QKV + ro + vcol0); }
        while (ti < ntiles) {
            __syncthreads();
            *(LAS u32x4*)(Ks + lrow * KS + 8 * lcg) = kreg;
            { LAS bf16_t* vp = Vt + (8 * lcg) * VS + lrow;
              vp[0 * VS] = (bf16_t)(vreg.x & 0xffff); vp[1 * VS] = (bf16_t)(vreg.x >> 16); vp[2 * VS] = (bf16_t)(vreg.y & 0xffff); vp[3 * VS] = (bf16_t)(vreg.y >> 16);
              vp[4 * VS] = (bf16_t)(vreg.z & 0xffff); vp[5 * VS] = (bf16_t)(vreg.z >> 16); vp[6 * VS] = (bf16_t)(vreg.w & 0xffff); vp[7 * VS] = (bf16_t)(vreg.w >> 16); }
            __syncthreads();
            int tn = ti + 1;
            while (tn < ntiles && !SWA_VALID(tn)) ++tn;
            if (tn < ntiles) { const size_t ro = (size_t)(SWA_KROW(tn) + lrow) * LDQ + 8 * lcg; kreg = *(const u32x4*)(QKV + ro + kcol0); vreg = *(const u32x4*)(QKV + ro + vcol0); }
            const int kpos0 = SWA_KPOS(ti);
            f32x4 s[4][2];
#pragma unroll
            for (int kt = 0; kt < 4; ++kt) {
                const bf16x8 k0 = *(const LAS bf16x8*)(Ks + (16 * kt + fr) * KS + 8 * fq);
                const bf16x8 k1 = *(const LAS bf16x8*)(Ks + (16 * kt + fr) * KS + 32 + 8 * fq);
#pragma unroll
                for (int qt = 0; qt < 2; ++qt) {
                    f32x4 z = (f32x4){0.f, 0.f, 0.f, 0.f};
                    z = __builtin_amdgcn_mfma_f32_16x16x32_bf16(k0, Qf[qt][0], z, 0, 0, 0);
                    s[kt][qt] = __builtin_amdgcn_mfma_f32_16x16x32_bf16(k1, Qf[qt][1], z, 0, 0, 0);
                }
            }
            if (ti >= 4) {
#pragma unroll
                for (int qt = 0; qt < 2; ++qt) {
                    const int qpos = jb * 128 + qsub + 16 * qt + fr;
#pragma unroll
                    for (int kt = 0; kt < 4; ++kt)
#pragma unroll
                        for (int j = 0; j < 4; ++j) { const int dlt = qpos - (kpos0 + 16 * kt + 4 * fq + j); if (dlt > 128 || dlt < -128) s[kt][qt][j] = -INFINITY; }
                }
            }
            bf16x8 Pf[2][2];
#pragma unroll
            for (int qt = 0; qt < 2; ++qt) {
                float mx = -INFINITY;
#pragma unroll
                for (int kt = 0; kt < 4; ++kt)
#pragma unroll
                    for (int j = 0; j < 4; ++j) mx = fmaxf(mx, s[kt][qt][j]);
                mx = fmaxf(mx, __shfl_xor(mx, 16)); mx = fmaxf(mx, __shfl_xor(mx, 32));
                const float mnew = fmaxf(mrun[qt], mx);
                const float alpha = __builtin_amdgcn_exp2f(mrun[qt] - mnew);
                mrun[qt] = mnew;
                float ls = 0.f;
                float p[4][4];
#pragma unroll
                for (int kt = 0; kt < 4; ++kt)
#pragma unroll
                    for (int j = 0; j < 4; ++j) { p[kt][j] = __builtin_amdgcn_exp2f(s[kt][qt][j] - mnew); ls += p[kt][j]; }
                lrun[qt] = lrun[qt] * alpha + ls;
#pragma unroll
                for (int dt = 0; dt < 4; ++dt) Oa[dt][qt] = Oa[dt][qt] * alpha;
#pragma unroll
                for (int k2 = 0; k2 < 2; ++k2) {
                    u32x4 pk; pk.x = cvt_pk_bf16(p[2 * k2][0], p[2 * k2][1]); pk.y = cvt_pk_bf16(p[2 * k2][2], p[2 * k2][3]);
                    pk.z = cvt_pk_bf16(p[2 * k2 + 1][0], p[2 * k2 + 1][1]); pk.w = cvt_pk_bf16(p[2 * k2 + 1][2], p[2 * k2 + 1][3]);
                    Pf[qt][k2] = __builtin_bit_cast(bf16x8, pk);
                }
            }
#pragma unroll
            for (int dt = 0; dt < 4; ++dt)
#pragma unroll
                for (int k2 = 0; k2 < 2; ++k2) {
                    const LAS bf16_t* vp = Vt + (16 * dt + fr) * VS + 32 * k2 + 4 * fq;
                    const u32x2 v0 = *(const LAS u32x2*)vp, v1 = *(const LAS u32x2*)(vp + 16);
                    u32x4 vv; vv.x = v0.x; vv.y = v0.y; vv.z = v1.x; vv.w = v1.y;
                    const bf16x8 vf = __builtin_bit_cast(bf16x8, vv);
#pragma unroll
                    for (int qt = 0; qt < 2; ++qt) Oa[dt][qt] = __builtin_amdgcn_mfma_f32_16x16x32_bf16(vf, Pf[qt][k2], Oa[dt][qt], 0, 0, 0);
                }
            ti = tn;
        }
#undef SWA_KPOS
#undef SWA_VALID
#undef SWA_KROW
#pragma unroll
        for (int qt = 0; qt < 2; ++qt) {
            float l = lrun[qt]; l += __shfl_xor(l, 16); l += __shfl_xor(l, 32);
            const float inv = 1.0f / l;
            bf16_t* op = O + (size_t)(qrow0 + 16 * qt + fr) * D + h * 64 + 4 * fq;
#pragma unroll
            for (int dt = 0; dt < 4; ++dt) { const f32x4 o = Oa[dt][qt] * inv; u32x2 pk; pk.x = cvt_pk_bf16(o[0], o[1]); pk.y = cvt_pk_bf16(o[2], o[3]); *(u32x2*)(op + 16 * dt) = pk; }
        }
    }
}

__device__ __forceinline__ void phase_nat(LAS unsigned char* lds, const bf16_t* QKV, const bf16_t* VT, bf16_t* O, const float* rpb, bool need_ctx) {
    constexpr int LDQ = 3072, KS = 264, VS = 72;
    LAS bf16_t* Ks = (LAS bf16_t*)lds;
    LAS bf16_t* Vt = Ks + 64 * KS;
    LAS float* rp = (LAS float*)(Vt + 256 * VS);
    const int tid = opaque_tid(), w = tid >> 6, lane = tid & 63, fr = lane & 15, fq = lane >> 4;
    const bool fast = gridDim.x == 256;
    const int xcd = blockIdx.x & 7, mloc = blockIdx.x >> 3;
    const int hg = fast ? (mloc & 3) : (blockIdx.x & 3);
    const int hw = w >> 1, h = 4 * hg + hw, qsub = (w & 1) * 32;
    __syncthreads();
    for (int e = tid; e < 4 * 465; e += 512) rp[e] = rpb[(size_t)(4 * hg) * 465 + e] * 1.4426950408889634f;
    int kc0[2], relb[2]; unsigned okm = 0u;
#pragma unroll
    for (int qt = 0; qt < 2; ++qt) {
        const int c0 = qsub + 16 * qt, c = c0 + fr;
        kc0[qt] = c0 - 8 < 0 ? 0 : (c0 - 8 > 32 ? 32 : c0 - 8);
        const int cst = c - 8 < 0 ? 0 : (c - 8 > 48 ? 48 : c - 8);
        relb[qt] = kc0[qt] + 4 * fq - c + 15;
#pragma unroll
        for (int i = 0; i < 2; ++i)
#pragma unroll
            for (int j = 0; j < 4; ++j) { const int kk = kc0[qt] + 16 * i + 4 * fq + j; if (kk >= cst && kk < cst + 16) okm |= 1u << (qt * 8 + i * 4 + j); }
    }
    const int n_items = 2048 + (need_ctx ? 32 : 0);
    for (int kk = 0; ; ++kk) {
        bool cq; int b, r, rs = 0;
        if (fast) {
            if (kk < 8) { const int G = kk * 8 + xcd; cq = false; b = G >> 5; r = ((G & 31) << 3) + (mloc >> 2); }
            else if (kk == 8 && need_ctx && blockIdx.x < 32) { const int it = ((blockIdx.x & 7) << 2) | (blockIdx.x >> 3); cq = true; b = it >> 4; r = (it >> 2) & 3; }
            else break;
        } else {
            const int item = blockIdx.x + kk * gridDim.x;
            if (item >= n_items) break;
            cq = item >= 2048;
            if (!cq) { r = (item >> 2) & 255; b = item >> 10; } else { const int it = item - 2048; r = (it >> 2) & 3; b = it >> 4; }
        }
        if (!cq) rs = r - 4 < 0 ? 0 : (r - 4 > 248 ? 248 : r - 4);
        const int qrow0 = cq ? (MX + b * CTXL + r * 64 + qsub) : (b * SEQ + r * 64 + qsub);
        const int ntiles = cq ? 4 : 12;
        bf16x8 Qf[2][2];
#pragma unroll
        for (int qt = 0; qt < 2; ++qt)
#pragma unroll
            for (int k2 = 0; k2 < 2; ++k2) Qf[qt][k2] = *(const bf16x8*)(QKV + (size_t)(qrow0 + 16 * qt + fr) * LDQ + h * 64 + 32 * k2 + 8 * fq);
        f32x4 Oa[4][2];
#pragma unroll
        for (int dt = 0; dt < 4; ++dt)
#pragma unroll
            for (int qt = 0; qt < 2; ++qt) Oa[dt][qt] = (f32x4){0.f, 0.f, 0.f, 0.f};
        float mrun[2] = {-INFINITY, -INFINITY}, lrun[2] = {0.f, 0.f};
        u32x4 kreg[4], vreg[4];
        const bf16_t* vtx = VT + (size_t)(b * 16 + 4 * hg) * 64 * SEQ;
        const bf16_t* vtc = VT + (size_t)2 * 16 * 64 * SEQ + (size_t)(b * 16 + 4 * hg) * 64 * CTXL;
#define NAT_LOAD(ti_) do { const int _ti = (ti_); \
            const bool _c = _ti < 4; const int _krow0 = _c ? (MX + b * CTXL + 64 * _ti) : (b * SEQ + (rs + _ti - 4) * 64); \
            const bf16_t* _vb = _c ? vtc + 64 * _ti : vtx + (rs + _ti - 4) * 64; const size_t _vs = _c ? (size_t)CTXL : (size_t)SEQ; \
            _Pragma("unroll") for (int _i = 0; _i < 4; ++_i) { const int _cx = tid + 512 * _i; \
                kreg[_i] = *(const u32x4*)(QKV + (size_t)(_krow0 + (_cx >> 5)) * LDQ + 1024 + hg * 256 + 8 * (_cx & 31)); \
                vreg[_i] = *(const u32x4*)(_vb + (size_t)(_cx >> 3) * _vs + 8 * (_cx & 7)); } } while (0)
        NAT_LOAD(0);
#pragma unroll 1
        for (int ti = 0; ti < ntiles; ++ti) {
            __syncthreads();
#pragma unroll
            for (int i = 0; i < 4; ++i) { const int cx = tid + 512 * i;
                *(LAS u32x4*)(Ks + (cx >> 5) * KS + 8 * (cx & 31)) = kreg[i];
                *(LAS u32x4*)(Vt + (cx >> 3) * VS + 8 * (cx & 7)) = vreg[i]; }
            __syncthreads();
            if (ti + 1 < ntiles) NAT_LOAD(ti + 1);
            if (ti < 4) {
#pragma unroll
                for (int qt = 0; qt < 2; ++qt) {
                    f32x4 s[4];
#pragma unroll
                    for (int kt = 0; kt < 4; ++kt) {
                        const bf16x8 k0 = *(const LAS bf16x8*)(Ks + (16 * kt + fr) * KS + hw * 64 + 8 * fq);
                        const bf16x8 k1 = *(const LAS bf16x8*)(Ks + (16 * kt + fr) * KS + hw * 64 + 32 + 8 * fq);
                        f32x4 z = (f32x4){0.f, 0.f, 0.f, 0.f};
                        z = __builtin_amdgcn_mfma_f32_16x16x32_bf16(k0, Qf[qt][0], z, 0, 0, 0);
                        s[kt] = __builtin_amdgcn_mfma_f32_16x16x32_bf16(k1, Qf[qt][1], z, 0, 0, 0);
                    }
                    float mx = -INFINITY;
#pragma unroll
                    for (int kt = 0; kt < 4; ++kt)
#pragma unroll
                        for (int j = 0; j < 4; ++j) mx = fmaxf(mx, s[kt][j]);
                    mx = fmaxf(mx, __shfl_xor(mx, 16)); mx = fmaxf(mx, __shfl_xor(mx, 32));
                    const float mnew = fmaxf(mrun[qt], mx), alpha = __builtin_amdgcn_exp2f(mrun[qt] - mnew);
                    mrun[qt] = mnew;
                    float ls = 0.f;
#pragma unroll
                    for (int kt = 0; kt < 4; ++kt)
#pragma unroll
                        for (int j = 0; j < 4; ++j) { s[kt][j] = __builtin_amdgcn_exp2f(s[kt][j] - mnew); ls += s[kt][j]; }
                    lrun[qt] = lrun[qt] * alpha + ls;
#pragma unroll
                    for (int dt = 0; dt < 4; ++dt) Oa[dt][qt] = Oa[dt][qt] * alpha;
#pragma unroll
                    for (int k2 = 0; k2 < 2; ++k2) {
                        u32x4 pk; pk.x = cvt_pk_bf16(s[2 * k2][0], s[2 * k2][1]); pk.y = cvt_pk_bf16(s[2 * k2][2], s[2 * k2][3]);
                        pk.z = cvt_pk_bf16(s[2 * k2 + 1][0], s[2 * k2 + 1][1]); pk.w = cvt_pk_bf16(s[2 * k2 + 1][2], s[2 * k2 + 1][3]);
                        const bf16x8 pf = __builtin_bit_cast(bf16x8, pk);
#pragma unroll
                        for (int dt = 0; dt < 4; ++dt) {
                            const LAS bf16_t* vp = Vt + (hw * 64 + 16 * dt + fr) * VS + 32 * k2 + 4 * fq;
                            const u32x2 v0 = *(const LAS u32x2*)vp, v1 = *(const LAS u32x2*)(vp + 16);
                            u32x4 vv; vv.x = v0.x; vv.y = v0.y; vv.z = v1.x; vv.w = v1.y;
                            Oa[dt][qt] = __builtin_amdgcn_mfma_f32_16x16x32_bf16(__builtin_bit_cast(bf16x8, vv), pf, Oa[dt][qt], 0, 0, 0);
                        }
                    }
                }
            } else {
                const LAS float* rrow = rp + hw * 465 + ((rs + ti - 4) - r + 7) * 31;
#pragma unroll
                for (int qt = 0; qt < 2; ++qt) {
                    f32x4 s[2];
#pragma unroll
                    for (int i = 0; i < 2; ++i) {
                        const LAS bf16_t* kp = Ks + (kc0[qt] + 16 * i + fr) * KS + hw * 64 + 8 * fq;
                        f32x4 z = (f32x4){0.f, 0.f, 0.f, 0.f};
                        z = __builtin_amdgcn_mfma_f32_16x16x32_bf16(*(const LAS bf16x8*)kp, Qf[qt][0], z, 0, 0, 0);
                        s[i] = __builtin_amdgcn_mfma_f32_16x16x32_bf16(*(const LAS bf16x8*)(kp + 32), Qf[qt][1], z, 0, 0, 0);
                    }
                    const LAS float* bp = rrow + relb[qt];
                    float mx = -INFINITY;
#pragma unroll
                    for (int i = 0; i < 2; ++i)
#pragma unroll
                        for (int j = 0; j < 4; ++j) { const bool ok = (okm >> (qt * 8 + i * 4 + j)) & 1u; const float bv = bp[16 * i + j];
                            s[i][j] = ok ? s[i][j] + bv : -INFINITY; mx = fmaxf(mx, s[i][j]); }
                    mx = fmaxf(mx, __shfl_xor(mx, 16)); mx = fmaxf(mx, __shfl_xor(mx, 32));
                    const float mnew = fmaxf(mrun[qt], mx), alpha = __builtin_amdgcn_exp2f(mrun[qt] - mnew);
                    mrun[qt] = mnew;
                    float ls = 0.f;
#pragma unroll
                    for (int i = 0; i < 2; ++i)
#pragma unroll
                        for (int j = 0; j < 4; ++j) { s[i][j] = __builtin_amdgcn_exp2f(s[i][j] - mnew); ls += s[i][j]; }
                    lrun[qt] = lrun[qt] * alpha + ls;
                    u32x4 pk; pk.x = cvt_pk_bf16(s[0][0], s[0][1]); pk.y = cvt_pk_bf16(s[0][2], s[0][3]); pk.z = cvt_pk_bf16(s[1][0], s[1][1]); pk.w = cvt_pk_bf16(s[1][2], s[1][3]);
                    const bf16x8 pf = __builtin_bit_cast(bf16x8, pk);
#pragma unroll
                    for (int dt = 0; dt < 4; ++dt) {
                        const LAS bf16_t* vp = Vt + (hw * 64 + 16 * dt + fr) * VS + kc0[qt] + 4 * fq;
                        const u32x2 v0 = *(const LAS u32x2*)vp, v1 = *(const LAS u32x2*)(vp + 16);
                        u32x4 vv; vv.x = v0.x; vv.y = v0.y; vv.z = v1.x; vv.w = v1.y;
                        Oa[dt][qt] = __builtin_amdgcn_mfma_f32_16x16x32_bf16(__builtin_bit_cast(bf16x8, vv), pf, Oa[dt][qt] * alpha, 0, 0, 0);
                    }
                }
            }
        }
#undef NAT_LOAD
#pragma unroll
        for (int qt = 0; qt < 2; ++qt) {
            float l = lrun[qt]; l += __shfl_xor(l, 16); l += __shfl_xor(l, 32);
            const float inv = 1.0f / l;
            bf16_t* op = O + (size_t)(qrow0 + 16 * qt + fr) * D + h * 64 + 4 * fq;
#pragma unroll
            for (int dt = 0; dt < 4; ++dt) { const f32x4 o = Oa[dt][qt] * inv; u32x2 pk; pk.x = cvt_pk_bf16(o[0], o[1]); pk.y = cvt_pk_bf16(o[2], o[3]); *(u32x2*)(op + 16 * dt) = pk; }
        }
    }
}

struct RnnP { const bf16_t* GXR; const bf16_t* Wg; const float* gate_b; const float* lam; const float* conv_w; const float* conv_b; float* PE; float* CIN; bf16_t* Y; };

template <int DIR>
__device__ __forceinline__ void rnn_dir(const RnnP& P, const LAS bf16_t* xc, LAS float* hfl, LAS bf16_t* cat, int nb, int b, int cc, int w, int fr, int fq) {
    const int ch = nb * 128 + 16 * w + fr;
    bf16x8 Bf[2][4];
#pragma unroll
    for (int gt = 0; gt < 2; ++gt)
#pragma unroll
        for (int ks = 0; ks < 4; ++ks) Bf[gt][ks] = *(const bf16x8*)(P.Wg + ((size_t)((DIR * 2 + gt) * 12 + nb) * 128 + 16 * w + fr) * 128 + 32 * ks + 8 * fq);
    constexpr float LOG2E = 1.4426950408889634f;
    const float nbr = -LOG2E * P.gate_b[(DIR * 2 + 0) * DRNN + ch], nbi = -LOG2E * P.gate_b[(DIR * 2 + 1) * DRNN + ch];
    const float nlam = -P.lam[DIR * DRNN + ch];
    const float sp = nlam > 20.0f ? nlam : log1pf(expf(nlam));
    const float c_la = -8.0f * LOG2E * sp, c_x2 = -16.0f * sp;
    float hrun = 0.f, prun = 1.f;
#pragma unroll
    for (int step = 0; step < 8; ++step) {
        const int mt = DIR == 0 ? step : 7 - step;
        f32x4 zr = (f32x4){0.f, 0.f, 0.f, 0.f}, zi = zr;
#pragma unroll
        for (int ks = 0; ks < 4; ++ks) {
            const bf16x8 af = *(const LAS bf16x8*)(xc + (16 * mt + fr) * 136 + 32 * ks + 8 * fq);
            zr = __builtin_amdgcn_mfma_f32_16x16x32_bf16(af, Bf[0][ks], zr, 0, 0, 0);
            zi = __builtin_amdgcn_mfma_f32_16x16x32_bf16(af, Bf[1][ks], zi, 0, 0, 0);
        }
        f32x4 xv4, er, ei, rg, ig, av, om, bv;
#pragma unroll
        for (int j = 0; j < 4; ++j) xv4[j] = bf2f(xc[(16 * mt + 4 * fq + j) * 136 + 16 * w + fr]);
        const f32x4 tr_ = zr * (-LOG2E) + nbr, ti_ = zi * (-LOG2E) + nbi;
#pragma unroll
        for (int j = 0; j < 4; ++j) { er[j] = __builtin_amdgcn_exp2f(tr_[j]); ei[j] = __builtin_amdgcn_exp2f(ti_[j]); }
        er = er + 1.0f; ei = ei + 1.0f;
#pragma unroll
        for (int j = 0; j < 4; ++j) { rg[j] = __builtin_amdgcn_rcpf(er[j]); ig[j] = __builtin_amdgcn_rcpf(ei[j]); }
        const f32x4 la2 = rg * c_la, x2 = rg * c_x2;
#pragma unroll
        for (int j = 0; j < 4; ++j) av[j] = __builtin_amdgcn_exp2f(la2[j]);
        const f32x4 xk = __builtin_elementwise_max(x2, (f32x4){-0.1f, -0.1f, -0.1f, -0.1f});
        const f32x4 ser = -xk * (xk * 0.5f * (xk * (1.0f / 3.0f) * (xk * 0.25f * (xk * 0.2f + 1.0f) + 1.0f) + 1.0f) + 1.0f);
        const f32x4 big = 1.0f - av * av;
        const f32x4 omv = (x2 > -0.1f) ? ser : big;
#pragma unroll
        for (int j = 0; j < 4; ++j) om[j] = __builtin_amdgcn_sqrtf(omv[j]);
        bv = om * (ig * xv4);
        float cumA[4], hl[4];
        if (DIR == 0) { cumA[0] = av[0]; hl[0] = bv[0];
#pragma unroll
            for (int j = 1; j < 4; ++j) { hl[j] = av[j] * hl[j - 1] + bv[j]; cumA[j] = av[j] * cumA[j - 1]; }
        } else { cumA[3] = av[3]; hl[3] = bv[3];
#pragma unroll
            for (int j = 2; j >= 0; --j) { hl[j] = av[j] * hl[j + 1] + bv[j]; cumA[j] = av[j] * cumA[j + 1]; }
        }
        const float PAl = DIR == 0 ? cumA[3] : cumA[0], HBl = DIR == 0 ? hl[3] : hl[0];
        float cin = hrun, mycin = 0.f, mypp = 1.f;
#pragma unroll
        for (int qq = 0; qq < 4; ++qq) {
            const int q = DIR == 0 ? qq : 3 - qq;
            const float pa = __shfl(PAl, fr + 16 * q), hb = __shfl(HBl, fr + 16 * q);
            if (q == fq) { mycin = cin; mypp = prun; }
            cin = pa * cin + hb; prun *= pa;
        }
        hrun = cin;
#pragma unroll
        for (int j = 0; j < 4; ++j) {
            const int tok = 16 * mt + 4 * fq + j;
            const float hv = hl[j] + cumA[j] * mycin;
            const unsigned cq = (unsigned)(cumA[j] * mypp * 255.0f + 0.5f);
            LAS float* hp = hfl + tok * 132 + 16 * w + fr;
            LAS bf16_t* cp = cat + tok * 136 + 16 * w + fr;
            if (DIR == 0) { *hp = hv; *cp = (bf16_t)cq; }
            else { *(LAS unsigned*)hp = cvt_pk_bf16(*hp + hv, 0.f) & 0xffffu; *cp = (bf16_t)((unsigned)*cp | (cq << 8)); }
        }
    }
    if (fq == 0) { float* Pp = P.PE + (size_t)((b * 2 + DIR) * NCHUNK + cc) * DRNN + ch; Pp[0] = prun; Pp[PE_HALF] = hrun; }
}

__device__ __forceinline__ void phase_rnn_carry(const RnnP& P) {
    const int tid = opaque_tid();
    if (tid >= 192) return;
    const int seg = tid & 7, chain = blockIdx.x * 24 + (tid >> 3);
    const bool live = chain < 2 * 2 * DRNN;
    const int chn = live ? chain : 0;
    const int ch = chn % DRNN, bd = chn / DRNN, dir = bd & 1;
    const float* Pp = P.PE + (size_t)(bd * NCHUNK) * DRNN + ch; const float* Ep = Pp + PE_HALF;
    float* Cp = P.CIN + (size_t)(bd * NCHUNK) * DRNN + ch;
    float pv[17], ev[17];
#pragma unroll
    for (int k = 0; k < 17; ++k) { const int p = 17 * seg + k; const bool ok = p < NCHUNK; const int pc = ok ? p : 0;
        const int c2 = dir == 0 ? pc : (pc == 0 ? 1 : (pc == 1 ? 0 : 131 - pc));
        pv[k] = ok ? Pp[(size_t)c2 * DRNN] : 1.0f; ev[k] = ok ? Ep[(size_t)c2 * DRNN] : 0.0f; }
    float PA = 1.f, HB = 0.f;
#pragma unroll
    for (int k = 0; k < 17; ++k) { HB = pv[k] * HB + ev[k]; PA *= pv[k]; }
    const int base = (tid & 63) & ~7;
    float cin = 0.f, h = 0.f;
#pragma unroll
    for (int s = 0; s < 8; ++s) { const float pa = __shfl(PA, base + s), hb = __shfl(HB, base + s); if (s == seg) h = cin; cin = pa * cin + hb; }
    if (live) {
#pragma unroll
        for (int k = 0; k < 17; ++k) { const int p = 17 * seg + k;
            if (p < NCHUNK) { const int c2 = dir == 0 ? p : (p == 0 ? 1 : (p == 1 ? 0 : 131 - p)); Cp[(size_t)c2 * DRNN] = h; h = pv[k] * h + ev[k]; } }
    }
}

__device__ __forceinline__ void phase_rnn(LAS unsigned char* lds, const RnnP& P, bf16_t* HS, bf16_t* CA) {
    LAS bf16_t* xc = (LAS bf16_t*)lds;
    LAS float* hfl = (LAS float*)(lds + 34816);
    LAS bf16_t* cat = (LAS bf16_t*)(lds + 102400);
    const int tid = opaque_tid(), w = tid >> 6, lane = tid & 63, fr = lane & 15, fq = lane >> 4;
    const int cg = tid & 15, tr = tid >> 4;
    u32x4 nx[7];
#define RNN_FETCH(item_) do { const int _it = (item_); const int _nb = _it % 12, _c = _it / 12, _b = _c / NCHUNK, _cc = _c % NCHUNK; \
        const int _seq0 = _cc < 2 ? MX + _b * CTXL : _b * SEQ, _len = _cc < 2 ? CTXL : SEQ, _t0 = _cc < 2 ? _cc * 128 : (_cc - 2) * 128; \
        _Pragma("unroll") for (int _r = 0; _r < 7; ++_r) { const int _tt = _t0 + 4 * tr + _r - 1; \
            nx[_r] = (_tt >= 0 && _tt < _len) ? *(const u32x4*)(P.GXR + (size_t)(_seq0 + _tt) * 3072 + DRNN + _nb * 128 + 8 * cg) : (u32x4){0u, 0u, 0u, 0u}; } } while (0)
    if ((int)blockIdx.x < 2 * NCHUNK * 12) RNN_FETCH((int)blockIdx.x);
    for (int item = blockIdx.x; item < 2 * NCHUNK * 12; item += gridDim.x) {
        const int nb = item % 12, c = item / 12, b = c / NCHUNK, cc = c % NCHUNK;
        const int seq0 = cc < 2 ? MX + b * CTXL : b * SEQ, t0 = cc < 2 ? cc * 128 : (cc - 2) * 128;
        __syncthreads();
        {
            const int ch0 = nb * 128 + 8 * cg;
            float cw[4][8], cb[8];
#pragma unroll
            for (int k = 0; k < 4; ++k) { const f32x4 a0 = *(const f32x4*)(P.conv_w + k * DRNN + ch0), a1 = *(const f32x4*)(P.conv_w + k * DRNN + ch0 + 4);
#pragma unroll
                for (int e = 0; e < 4; ++e) { cw[k][e] = a0[e]; cw[k][4 + e] = a1[e]; } }
            { const f32x4 a0 = *(const f32x4*)(P.conv_b + ch0), a1 = *(const f32x4*)(P.conv_b + ch0 + 4);
#pragma unroll
                for (int e = 0; e < 4; ++e) { cb[e] = a0[e]; cb[4 + e] = a1[e]; } }
#pragma unroll
            for (int q = 0; q < 4; ++q) {
                float acc[8];
#pragma unroll
                for (int e = 0; e < 8; ++e) acc[e] = cb[e];
#pragma unroll
                for (int k = 0; k < 4; ++k) {
                    const u32x4 v = nx[q + k];
                    acc[0] += bflo(v.x) * cw[k][0]; acc[1] += bfhi(v.x) * cw[k][1]; acc[2] += bflo(v.y) * cw[k][2]; acc[3] += bfhi(v.y) * cw[k][3];
                    acc[4] += bflo(v.z) * cw[k][4]; acc[5] += bfhi(v.z) * cw[k][5]; acc[6] += bflo(v.w) * cw[k][6]; acc[7] += bfhi(v.w) * cw[k][7];
                }
                u32x4 o; o.x = cvt_pk_bf16(acc[0], acc[1]); o.y = cvt_pk_bf16(acc[2], acc[3]); o.z = cvt_pk_bf16(acc[4], acc[5]); o.w = cvt_pk_bf16(acc[6], acc[7]);
                *(LAS u32x4*)(xc + (4 * tr + q) * 136 + 8 * cg) = o;
            }
        }
        __syncthreads();
        if (item + (int)gridDim.x < 2 * NCHUNK * 12) RNN_FETCH(item + (int)gridDim.x);
        rnn_dir<0>(P, xc, hfl, cat, nb, b, cc, w, fr, fq);
        rnn_dir<1>(P, xc, hfl, cat, nb, b, cc, w, fr, fq);
        __syncthreads();
#pragma unroll
        for (int i = 0; i < 4; ++i) {
            const int cidx = tid + 512 * i, t = cidx >> 4, cg = cidx & 15;
            const size_t go = (size_t)(seq0 + t0 + t) * DRNN + nb * 128 + 8 * cg;
            const u32x4 h0 = *(const LAS u32x4*)(hfl + t * 132 + 8 * cg), h1 = *(const LAS u32x4*)(hfl + t * 132 + 8 * cg + 4);
            u32x4 o; o.x = (h0.x & 0xffffu) | (h0.y << 16); o.y = (h0.z & 0xffffu) | (h0.w << 16); o.z = (h1.x & 0xffffu) | (h1.y << 16); o.w = (h1.z & 0xffffu) | (h1.w << 16);
            *(u32x4*)(HS + go) = o;
            *(u32x4*)(CA + go) = *(const LAS u32x4*)(cat + t * 136 + 8 * cg);
        }
    }
}

#undef RNN_FETCH
__device__ __forceinline__ void phase_rnn_out(const RnnP& P, bf16_t* HS, const bf16_t* CA, bool need_ctx) {
    const int tid_ = opaque_tid(), lane = tid_ & 63, gw = blockIdx.x * 8 + (tid_ >> 6), NGW = gridDim.x * 8;
    const int nrows = need_ctx ? MT : MX;
    for (int row = gw; row < nrows; row += NGW) {
        int b, cc;
        if (row < MX) { b = row >> 14; cc = 2 + ((row & (SEQ - 1)) >> 7); } else { const int rc = row - MX; b = rc >> 8; cc = (rc & 255) >> 7; }
        const float* cf = P.CIN + (size_t)((b * 2 + 0) * NCHUNK + cc) * DRNN; const float* cbk = P.CIN + (size_t)((b * 2 + 1) * NCHUNK + cc) * DRNN;
#pragma unroll
        for (int k = 0; k < 3; ++k) {
            const int ch0 = 8 * (lane + 64 * k);
            const u32x4 hs = *(const u32x4*)(HS + (size_t)row * DRNN + ch0), ca = *(const u32x4*)(CA + (size_t)row * DRNN + ch0), gg = *(const u32x4*)(P.GXR + (size_t)row * 3072 + ch0);
            const f32x4 f0 = *(const f32x4*)(cf + ch0), f1 = *(const f32x4*)(cf + ch0 + 4), b0 = *(const f32x4*)(cbk + ch0), b1 = *(const f32x4*)(cbk + ch0 + 4);
            const unsigned hsw[4] = {hs.x, hs.y, hs.z, hs.w}, caw[4] = {ca.x, ca.y, ca.z, ca.w}, ggw[4] = {gg.x, gg.y, gg.z, gg.w};
            unsigned ow[4];
#pragma unroll
            for (int e = 0; e < 4; ++e) {
                const float cfl = e < 2 ? f0[2 * e] : f1[2 * e - 4], cfh = e < 2 ? f0[2 * e + 1] : f1[2 * e - 3];
                const float cbl = e < 2 ? b0[2 * e] : b1[2 * e - 4], cbh = e < 2 ? b0[2 * e + 1] : b1[2 * e - 3];
                const unsigned cw_ = caw[e];
                const float hl_ = bflo(hsw[e]) + (float)(cw_ & 0xffu) * (1.0f / 255.0f) * cfl + (float)((cw_ >> 8) & 0xffu) * (1.0f / 255.0f) * cbl;
                const float hh_ = bfhi(hsw[e]) + (float)((cw_ >> 16) & 0xffu) * (1.0f / 255.0f) * cfh + (float)(cw_ >> 24) * (1.0f / 255.0f) * cbh;
                const float gl = bflo(ggw[e]), gh = bfhi(ggw[e]);
                const float yl = hl_ * gl * __builtin_amdgcn_rcpf(1.0f + __builtin_amdgcn_exp2f(gl * (-2.302208198f - 0.1029432397f * gl * gl)));
                const float yh = hh_ * gh * __builtin_amdgcn_rcpf(1.0f + __builtin_amdgcn_exp2f(gh * (-2.302208198f - 0.1029432397f * gh * gh)));
                ow[e] = cvt_pk_bf16(yl, yh);
            }
            u32x4 o; o.x = ow[0]; o.y = ow[1]; o.z = ow[2]; o.w = ow[3];
            *(u32x4*)(HS + (size_t)row * DRNN + ch0) = o;
        }
    }
}

#ifndef DBL
#define DBL 0
#endif
#ifndef PHM
#define PHM 0xFFFF
#endif
enum { OP_SKIP = 0, OP_NORM, OP_GS, OP_GR, OP_GB, OP_GROPE, OP_RNN1, OP_RNN2, OP_RNN3, OP_ATT0, OP_ATT1 };

__global__ void __launch_bounds__(512, 2) fwd_megakernel(Args a) {
    extern __shared__ __attribute__((aligned(16))) unsigned char shm[];
    LAS unsigned char* lds = (LAS unsigned char*)shm;
    cg::grid_group grid = cg::this_grid();

    if (blockIdx.x == 0) { unsigned* bw = (unsigned*)(a.ws + WS_BAR); for (int e = threadIdx.x; e < XCD_BAR_WORDS; e += 512) bw[e] = 0u; }
    volatile LAS unsigned* xbst = (volatile LAS unsigned*)(lds + LDS_XB);
    if (threadIdx.x == 0) { xbst[0] = 0u; xbst[1] = 0u; xbst[2] = 0u; xbst[3] = 0u; }
#if PHM & 1
    for (int rep = 0; rep < ((DBL & 1) ? 2 : 1); ++rep) { phase_prep(a, lds); __syncthreads(); }
#endif
    grid.sync();
    const XcdBarrier xb = xcd_barrier_post((unsigned*)(a.ws + WS_BAR), xbst);
#pragma unroll 1
    for (int i = 0; i < NLAYER; ++i) {
        const int kind = i % 3, j = i / 3;
        const bool need_ctx = i < NLAYER - 1;
        const int MO = need_ctx ? MT : MX;
#pragma unroll 1
        for (int op = 0; op < 12; ++op) {
            unsigned char* ws = a.ws + opaque_zero();
            float* xs = (float*)(ws + WS_XS);
            bf16_t* HN = (bf16_t*)(ws + WS_HN);
            bf16_t* ACT = (bf16_t*)(ws + WS_ACT);
            const float* modl = (const float*)(ws + WS_MOD) + (size_t)i * 3 * 9216;
            int type;
            switch (op) {
                case 0: case 3: case 9: type = OP_NORM; break;
                case 1: case 10: type = OP_GS; break;
                case 2: case 8: case 11: type = OP_GR; break;
                case 4: type = kind == 1 ? OP_GROPE : OP_GB; break;
                case 5: type = kind == 0 ? OP_RNN1 : (kind == 1 ? OP_ATT0 : OP_ATT1); break;
                case 6: type = kind == 0 ? OP_RNN2 : OP_SKIP; break;
                default: type = kind == 0 ? OP_RNN3 : OP_SKIP; break;
            }
            if (type == OP_SKIP) continue;
            if (type == OP_NORM) {
                const int sub = op == 0 ? 0 : (op == 3 ? 1 : 2);
#if PHM & 2
                for (int rep = 0; rep < ((DBL & 2) ? 2 : 1); ++rep) phase_norm(a, i, sub, (i == 0) && (op == 0), op == 9 ? MO : MT, !((i == 0) && (op == 0)), op == 9 ? (kind == 0 ? 6 : 4) : 11);
#endif
            } else if (type == OP_GS || type == OP_GR || type == OP_GB || type == OP_GROPE) {
                pg8::Gemm g; EpiAny E;
                E.e0.out = ACT;
                E.e1.slab = (float*)(ws + WS_SLAB); E.e1.y = (bf16_t*)(ws + WS_EXTRA); E.e1.gate = modl; E.e1.coef = 0.5f;
                E.e2.out = ACT; E.e2.ldc = 3072; E.e2.qcols = kind == 0 ? 0 : 1024; E.e2.qscale = 0.125f * 1.4426950408889634f; E.e2.vt = kind == 2 ? (bf16_t*)(ws + WS_EXTRA) : (bf16_t*)nullptr;
                E.e3.out = ACT; E.e3.rope = (const float*)(ws + WS_ROPE);
                if (type == OP_GS) {
                    const int which = op == 1 ? 0 : 1;
                    E.mode = 0; g.A = HN; g.Bt = (const bf16_t*)(ws + WS_WGU) + (size_t)(i * 2 + which) * 5632 * 1024; g.M = which == 0 ? MT : MO; g.N = 5632; g.K = 1024;
                } else if (type == OP_GR) {
                    E.mode = 1;
                    if (op == 8) {
                        g.A = HN; g.M = MO; g.N = 1024; g.K = kind == 0 ? 1536 : 1024;
                        g.Bt = kind == 0 ? (const bf16_t*)(ws + WS_WAOUT) + (size_t)j * 1024 * 1536 : (kind == 1 ? (const bf16_t*)(ws + WS_WBO) : (const bf16_t*)(ws + WS_WCO));
                        E.e1.gate = modl + (1 * 3 + 2) * 1024; E.e1.coef = 1.0f;
                    } else {
                        const int which = op == 2 ? 0 : 1;
                        g.A = ACT; g.M = which == 0 ? MT : MO; g.N = 1024; g.K = 2816;
                        g.Bt = (const bf16_t*)(ws + WS_WDN) + (size_t)(i * 2 + which) * 1024 * 2816;
                        E.e1.gate = modl + ((which == 0 ? 0 : 2) * 3 + 2) * 1024; E.e1.coef = 0.5f;
                    }
                } else if (type == OP_GB) {
                    E.mode = 2; g.A = HN; g.Bt = kind == 0 ? (const bf16_t*)(ws + WS_WAIN) + (size_t)j * 3072 * 1024 : (const bf16_t*)(ws + WS_WCQKV); g.M = MT; g.N = 3072; g.K = 1024;
                } else {
                    E.mode = 3; g.A = HN; g.Bt = (const bf16_t*)(ws + WS_WBQKV); g.M = MT; g.N = 1536; g.K = 1024;
                }
                pg8::StaticOrder S; S.init(g.M, g.N, g.K, (int)gridDim.x, (int)blockIdx.x, type == OP_GR);
#if PHM & 64
                { const int nrep = ((DBL & 64) || ((DBL & 256) && type == OP_GR) || ((DBL & 512) && type == OP_GS)) ? 2 : 1; const float coef_real = E.e1.coef;
                  for (int rep = 0; rep < nrep; ++rep) { E.e1.coef = rep == nrep - 1 ? coef_real : 0.f; pg8::gemm_phase(lds, g, S, E); } }
#endif
            } else if (type == OP_RNN1 || type == OP_RNN2 || type == OP_RNN3) {
                RnnP P{ACT, (const bf16_t*)(ws + WS_WAG) + (size_t)j * 48 * 128 * 128, a.in[I_AGATEB] + (size_t)j * 4 * DRNN, a.in[I_ALAM] + (size_t)j * 2 * DRNN,
                       a.in[I_ACONVW] + (size_t)j * 4 * DRNN, a.in[I_ACONVB] + (size_t)j * DRNN, (float*)(ws + WS_PE), (float*)(ws + WS_CIN), HN};
                if (type == OP_RNN2) phase_rnn_carry(P);
#if PHM & 4
                for (int rep = 0; rep < ((DBL & 4) ? 2 : 1); ++rep) if (type == OP_RNN1) phase_rnn(lds, P, HN, (bf16_t*)(ws + WS_EXTRA));
#endif
#if PHM & 8
                if (type == OP_RNN3) phase_rnn_out(P, HN, (const bf16_t*)(ws + WS_EXTRA), need_ctx);
#endif
            } else if (type == OP_ATT0) {
#if PHM & 16
                for (int rep = 0; rep < ((DBL & 16) ? 2 : 1); ++rep) phase_swa(lds, ACT, HN, a.in[I_BSINKS] + (size_t)j * 16, need_ctx);
#endif
            } else {
#if PHM & 32
                for (int rep = 0; rep < ((DBL & 32) ? 2 : 1); ++rep) phase_nat(lds, ACT, (const bf16_t*)(ws + WS_EXTRA), HN, a.in[I_CRPB] + (size_t)j * 16 * 465, need_ctx);
#endif
            }
            xcd_barrier(xb);
#if DBL & 128
            xcd_barrier(xb);
#endif
        }
    }
#if PHM & 2
    phase_final(a);
#endif
}

extern "C" void kernel_launch(void* const* d_in, const int* in_sizes, int n_in, void* d_out, int out_size, void* d_ws, size_t ws_size, hipStream_t stream) {
    static int grid_blocks = 0;
    if (grid_blocks == 0) {
        if (n_in != 23 || ws_size < WS_END) { fprintf(stderr, "kernel_launch: unexpected n_in %d or ws_size %zu (need %zu)\n", n_in, ws_size, (size_t)WS_END); grid_blocks = -1; return; }
        int dev = 0, cus = 0, per_cu = 0;
        (void)hipGetDevice(&dev);
        (void)hipDeviceGetAttribute(&cus, hipDeviceAttributeMultiprocessorCount, dev);
        if (hipFuncSetAttribute((const void*)fwd_megakernel, hipFuncAttributeMaxDynamicSharedMemorySize, LDS_BYTES) != hipSuccess) fprintf(stderr, "kernel_launch: hipFuncSetAttribute failed\n");
        (void)hipOccupancyMaxActiveBlocksPerMultiprocessor(&per_cu, (const void*)fwd_megakernel, 512, LDS_BYTES);
        (void)hipGetLastError();
        if (per_cu < 1) per_cu = 1;
        grid_blocks = cus * 1;
    }
    if (grid_blocks < 0) return;
    Args a{};
    for (int i = 0; i < 23; ++i) a.in[i] = (const float*)d_in[i];
    a.out = (float*)d_out; a.ws = (unsigned char*)d_ws;
    void* args[] = {&a};
    hipError_t e = hipLaunchCooperativeKernel((const void*)fwd_megakernel, dim3(grid_blocks), dim3(512), args, LDS_BYTES, stream);
    if (e != hipSuccess) fprintf(stderr, "cooperative launch failed: %s (grid %d)\n", hipGetErrorString(e), grid_blocks);
}
```
